# Optimizing an MI355X kernel written in HIP

```python
import jax
import jax.numpy as jnp
from jax import lax
import numpy as np

D_MODEL = 1024
BATCH = 4
SEQ = 4096
DEPTH = 2

N_META = 16
D_MIX = D_MODEL
POOL_WIDTH = D_MIX // 2
POOL_WINDOWS = (2, 4, 8, 16)
N_POOL_GROUPS = len(POOL_WINDOWS)
POOL_GROUP_DIM = POOL_WIDTH // N_POOL_GROUPS
MLA_HEADS = 8
QK_NOPE_DIM = 64
QK_ROPE_DIM = 32
QK_HEAD_DIM = QK_NOPE_DIM + QK_ROPE_DIM
V_HEAD_DIM = (D_MIX - POOL_WIDTH) // MLA_HEADS
Q_LORA_RANK = 384
KV_LORA_RANK = 256
IN_WIDTH = POOL_WIDTH + Q_LORA_RANK + KV_LORA_RANK + QK_ROPE_DIM
D_FF = -(-8 * D_MODEL // (3 * 256)) * 256
ROPE_THETA = 10000.0
RMS_EPS = 1e-6
Q_BLOCK = 128

kernel_name = "hymba_pool_mla_hybrid"


def rms_norm(x, g):
    xf = x.astype(jnp.float32)
    y = xf * lax.rsqrt(jnp.mean(xf * xf, axis=-1, keepdims=True) + RMS_EPS)
    return (y * g.astype(jnp.float32)).astype(x.dtype)


def rope_tables(length):
    inv = 1.0 / (ROPE_THETA ** (jnp.arange(0, QK_ROPE_DIM, 2, dtype=jnp.float32) / QK_ROPE_DIM))
    ang = jnp.arange(length, dtype=jnp.float32)[:, None] * inv[None, :]
    return jnp.cos(ang), jnp.sin(ang)


def apply_rope(x, cos, sin):
    x1, x2 = jnp.split(x, 2, axis=-1)
    c = cos.astype(x.dtype)
    s = sin.astype(x.dtype)
    return jnp.concatenate([x1 * c - x2 * s, x1 * s + x2 * c], axis=-1)


def multiscale_pool(u, w_pool, pool_scale):
    B, L, _ = u.shape
    uf = u.astype(jnp.float32)
    cs = jnp.concatenate([jnp.zeros((B, 1, POOL_WIDTH), jnp.float32), lax.cumsum(uf, axis=1)], axis=1)
    t = jnp.arange(L)
    outs = []
    for g, w in enumerate(POOL_WINDOWS):
        sl = slice(g * POOL_GROUP_DIM, (g + 1) * POOL_GROUP_DIM)
        csg = cs[:, :, sl]
        start = jnp.maximum(t + 1 - w, 0)
        count = (t + 1 - start).astype(jnp.float32)
        mean = (csg[:, 1:] - csg[:, start]) / count[None, :, None]
        outs.append(mean - uf[:, :, sl])
    p = jnp.stack(outs, axis=2).astype(u.dtype)
    y = jnp.einsum('blgc,gcd->blgd', p, w_pool).reshape(B, L, POOL_WIDTH)
    return y * pool_scale.astype(y.dtype)


def causal_mla_attention(q_nope, q_rope, k_nope, k_rope, v):
    B, L, H, _ = q_nope.shape
    n_blocks = -(-L // Q_BLOCK)
    Lp = n_blocks * Q_BLOCK
    pad = Lp - L

    def padl(a):
        return jnp.pad(a, [(0, 0), (0, pad)] + [(0, 0)] * (a.ndim - 2))

    q_nope, q_rope, k_nope, k_rope, v = (padl(a) for a in (q_nope, q_rope, k_nope, k_rope, v))

    def blocks(a):
        return jnp.moveaxis(a.reshape(B, n_blocks, Q_BLOCK, *a.shape[2:]), 1, 0)

    qn_b, qr_b = blocks(q_nope), blocks(q_rope)
    key_pos = jnp.arange(Lp)
    scale = QK_HEAD_DIM ** -0.5

    def one_block(args):
        i, qn, qr = args
        s = (jnp.einsum('bqhd,bkhd->bhqk', qn, k_nope)
             + jnp.einsum('bqhr,bkr->bhqk', qr, k_rope)).astype(jnp.float32) * scale
        q_pos = i * Q_BLOCK + jnp.arange(Q_BLOCK)
        mask = key_pos[None, :] <= q_pos[:, None]
        s = jnp.where(mask[None, None], s, -jnp.inf)
        p = jax.nn.softmax(s, axis=-1).astype(v.dtype)
        return jnp.einsum('bhqk,bkhd->bqhd', p, v)

    out = lax.map(one_block, (jnp.arange(n_blocks), qn_b, qr_b))
    return jnp.moveaxis(out, 0, 1).reshape(B, Lp, H, V_HEAD_DIM)[:, :L]


def mla_group(c_q, c_kv, k_rope_raw, cos, sin, q_a_norm_g, w_q_b, kv_a_norm_g, w_kv_b, q_norm_g, k_norm_g):
    B, L, _ = c_q.shape
    q = (rms_norm(c_q, q_a_norm_g) @ w_q_b).reshape(B, L, MLA_HEADS, QK_HEAD_DIM)
    kv = (rms_norm(c_kv, kv_a_norm_g) @ w_kv_b).reshape(B, L, MLA_HEADS, QK_NOPE_DIM + V_HEAD_DIM)
    q_nope, q_rope = q[..., :QK_NOPE_DIM], q[..., QK_NOPE_DIM:]
    k_nope, v = kv[..., :QK_NOPE_DIM], kv[..., QK_NOPE_DIM:]
    q_nope = rms_norm(q_nope, q_norm_g[:QK_NOPE_DIM])
    q_rope = rms_norm(q_rope, q_norm_g[QK_NOPE_DIM:])
    k_nope = rms_norm(k_nope, k_norm_g[:QK_NOPE_DIM])
    k_rope = rms_norm(k_rope_raw, k_norm_g[QK_NOPE_DIM:])
    q_rope = apply_rope(q_rope, cos[:, None, :], sin[:, None, :])
    k_rope = apply_rope(k_rope, cos, sin)
    o = causal_mla_attention(q_nope, q_rope, k_nope, k_rope, v)
    return o.reshape(B, L, MLA_HEADS * V_HEAD_DIM)


def setup_inputs(seed: int = 0) -> dict:
    key = jax.random.key(seed)
    ks = jax.random.split(key, 18)
    f32 = jnp.float32
    nl = DEPTH

    def nrm(k, shape, scale):
        return jax.random.normal(k, shape, f32) * scale

    def gain(k, shape):
        return 1.0 + 0.05 * jax.random.normal(k, shape, f32)

    return {
        'x': nrm(ks[0], (BATCH, SEQ, D_MODEL), 1.0),
        'meta_tokens': nrm(ks[1], (N_META, D_MODEL), 1.0),
        'attn_norm_g': gain(ks[2], (nl, D_MODEL)),
        'w_in': nrm(ks[3], (nl, D_MODEL, IN_WIDTH), D_MODEL ** -0.5),
        'w_pool': nrm(ks[4], (nl, N_POOL_GROUPS, POOL_GROUP_DIM, POOL_GROUP_DIM), POOL_GROUP_DIM ** -0.5),
        'pool_scale': gain(ks[5], (nl, POOL_WIDTH)),
        'q_a_norm_g': gain(ks[6], (nl, Q_LORA_RANK)),
        'w_q_b': nrm(ks[7], (nl, Q_LORA_RANK, MLA_HEADS * QK_HEAD_DIM), Q_LORA_RANK ** -0.5),
        'kv_a_norm_g': gain(ks[8], (nl, KV_LORA_RANK)),
        'w_kv_b': nrm(ks[9], (nl, KV_LORA_RANK, MLA_HEADS * (QK_NOPE_DIM + V_HEAD_DIM)), KV_LORA_RANK ** -0.5),
        'q_norm_g': gain(ks[10], (nl, QK_HEAD_DIM)),
        'k_norm_g': gain(ks[11], (nl, QK_HEAD_DIM)),
        'w_out': nrm(ks[12], (nl, D_MIX, D_MODEL), D_MIX ** -0.5),
        'ffn_norm_g': gain(ks[13], (nl, D_MODEL)),
        'w_gate': nrm(ks[14], (nl, D_MODEL, D_FF), D_MODEL ** -0.5),
        'w_up': nrm(ks[15], (nl, D_MODEL, D_FF), D_MODEL ** -0.5),
        'w_down': nrm(ks[16], (nl, D_FF, D_MODEL), D_FF ** -0.5),
    }


def reference(x, meta_tokens, attn_norm_g, w_in, w_pool, pool_scale, q_a_norm_g, w_q_b,
              kv_a_norm_g, w_kv_b, q_norm_g, k_norm_g, w_out, ffn_norm_g, w_gate, w_up, w_down):
    B = x.shape[0]
    meta = jnp.broadcast_to(meta_tokens.astype(x.dtype)[None], (B, N_META, D_MODEL))
    h = jnp.concatenate([meta, x], axis=1)
    L = h.shape[1]
    cos, sin = rope_tables(L)
    s1 = POOL_WIDTH
    s2 = s1 + Q_LORA_RANK
    s3 = s2 + KV_LORA_RANK
    for l in range(DEPTH):
        z = rms_norm(h, attn_norm_g[l]) @ w_in[l]
        u_pool, c_q, c_kv, k_rope = jnp.split(z, [s1, s2, s3], axis=-1)
        y_pool = multiscale_pool(u_pool, w_pool[l], pool_scale[l])
        y_mla = mla_group(c_q, c_kv, k_rope, cos, sin, q_a_norm_g[l], w_q_b[l],
                          kv_a_norm_g[l], w_kv_b[l], q_norm_g[l], k_norm_g[l])
        h = h + jnp.concatenate([y_pool, y_mla], axis=-1) @ w_out[l]
        g = rms_norm(h, ffn_norm_g[l])
        h = h + (jax.nn.silu(g @ w_gate[l]) * (g @ w_up[l])) @ w_down[l]
    return h[:, N_META:]
```

```cpp
#include <hip/hip_runtime.h>
#include <cstdint>
#include <cstdio>

namespace {
constexpr int D = 1024, BATCH = 4, SEQ = 4096, DEPTH = 2, NMETA = 16, L = SEQ + NMETA;
constexpr int R = BATCH * L;
constexpr int RA = R + 256;
constexpr int POOLW = 512, QLR = 384, KVLR = 256, ROPE = 32, NOPE = 64, QKD = 96, VD = 64, NH = 8;
constexpr int INW = POOLW + QLR + KVLR + ROPE;
constexpr int FF = 2816;
constexpr float EPS = 1e-6f;
constexpr float QSCALE = 0.10206207261596577f * 1.4426950408889634f;

typedef unsigned short bf16;
constexpr size_t MiB = 1u << 20;
constexpr size_t WS_ROPE = 1 * MiB, WS_HM = 2 * MiB, WS_W = 4 * MiB, WS_XN = 52 * MiB, WS_Y = 85 * MiB, WS_SSQH = 118 * MiB;
constexpr size_t WS_Z = 119 * MiB, WS_SSQZ = 157 * MiB, WS_P = 160 * MiB, WS_Q = 177 * MiB, WS_K = 202 * MiB, WS_V = 227 * MiB, WS_ACT = 119 * MiB, WS_END = 244 * MiB;
static_assert(WS_XN + (size_t)RA * D * 2 <= WS_Y && WS_Y + (size_t)RA * D * 2 <= WS_SSQH && WS_Z + (size_t)RA * INW * 2 <= WS_SSQZ && WS_SSQZ + (size_t)RA * 40 * 4 <= WS_P &&
              WS_P + (size_t)RA * 512 * 2 <= WS_Q && WS_Q + (size_t)RA * 768 * 2 <= WS_K && WS_K + (size_t)RA * 768 * 2 <= WS_V && WS_V + (size_t)RA * 512 * 2 <= WS_END &&
              WS_ACT + (size_t)RA * FF * 2 <= WS_END, "ws map");

__device__ __forceinline__ float bf2f(bf16 v) { return __uint_as_float((unsigned)v << 16); }
__device__ __forceinline__ bf16 f2bf(float f) { unsigned u = __float_as_uint(f); return (bf16)((u + 0x7fffu + ((u >> 16) & 1u)) >> 16); }

struct P {
    const float *x, *meta, *attn_g, *w_in, *w_pool, *pool_scale, *qa_g, *w_q_b, *kva_g, *w_kv_b, *qn_g, *kn_g, *w_out, *ffn_g, *w_gate, *w_up, *w_down;
    float* out; unsigned char* ws;
};
__device__ __forceinline__ float* hptr(const P& p, int krow) {
    const int b = krow / L, pos = krow % L;
    return pos < NMETA ? (float*)(p.ws + WS_HM) + (size_t)(b * NMETA + pos) * D : p.out + (size_t)(b * SEQ + pos - NMETA) * D;
}

__global__ void k_rope_table(P p) {
    const int i = blockIdx.x * blockDim.x + threadIdx.x; if (i >= L * 16) return;
    const int pos = i / 16, j = i % 16;
    const float inv = 1.0f / powf(10000.0f, (float)(2 * j) / 32.0f);
    const float ang = (float)pos * inv;
    float* t = (float*)(p.ws + WS_ROPE) + (size_t)pos * 32;
    t[j] = cosf(ang); t[16 + j] = sinf(ang);
}
__global__ void k_h0(P p) {
    const int krow = blockIdx.x; const int b = krow / L, pos = krow % L;
    const float* src = pos < NMETA ? p.meta + (size_t)pos * D : p.x + (size_t)(b * SEQ + pos - NMETA) * D;
    float* dst = hptr(p, krow);
    for (int c = threadIdx.x; c < D; c += blockDim.x) dst[c] = src[c];
}
__global__ void k_norm(P p, const float* gain) {
    const int krow = blockIdx.x; const float* h = hptr(p, krow);
    __shared__ float red[256];
    float s = 0.f;
    bf16* xn = (bf16*)(p.ws + WS_XN) + (size_t)krow * D;
    for (int c = threadIdx.x; c < D; c += 256) { const float v = h[c]; s += v * v; xn[c] = f2bf(v * gain[c]); }
    red[threadIdx.x] = s; __syncthreads();
    for (int o = 128; o > 0; o >>= 1) { if (threadIdx.x < o) red[threadIdx.x] += red[threadIdx.x + o]; __syncthreads(); }
    if (threadIdx.x == 0) { float* q = (float*)(p.ws + WS_SSQH) + (size_t)krow * 4; q[0] = red[0]; q[1] = 0.f; q[2] = 0.f; q[3] = 0.f; }
}
__device__ __forceinline__ float rstd_h(const P& p, int krow) {
    const float* q = (const float*)(p.ws + WS_SSQH) + (size_t)krow * 4;
    return rsqrtf((q[0] + q[1] + q[2] + q[3]) * (1.0f / D) + EPS);
}

template <class F, bool DUAL> __global__ void __launch_bounds__(256) ngemm(F f, int M, int N, int K) {
    __shared__ float As[16][65], Bs[16][65], Bs2[16][65];
    const int tx = threadIdx.x & 15, ty = threadIdx.x >> 4;
    const int row0 = blockIdx.y * 64, col0 = blockIdx.x * 64;
    float acc[4][4], acc2[4][4];
#pragma unroll
    for (int i = 0; i < 4; ++i)
#pragma unroll
        for (int j = 0; j < 4; ++j) { acc[i][j] = 0.f; acc2[i][j] = 0.f; }
    for (int k0 = 0; k0 < K; k0 += 16) {
#pragma unroll
        for (int i = 0; i < 4; ++i) {
            const int idx = threadIdx.x + 256 * i;
            { const int r = idx >> 4, kk = idx & 15; As[kk][r] = (row0 + r < M) ? f.a(row0 + r, k0 + kk) : 0.f; }
            { const int kk = idx >> 6, c = idx & 63; const bool ok = col0 + c < N; Bs[kk][c] = ok ? f.b(k0 + kk, col0 + c) : 0.f; if (DUAL) Bs2[kk][c] = ok ? f.b2(k0 + kk, col0 + c) : 0.f; }
        }
        __syncthreads();
#pragma unroll
        for (int kk = 0; kk < 16; ++kk) {
            float a[4], b[4], b2[4];
#pragma unroll
            for (int i = 0; i < 4; ++i) { a[i] = As[kk][ty * 4 + i]; b[i] = Bs[kk][tx * 4 + i]; b2[i] = DUAL ? Bs2[kk][tx * 4 + i] : 0.f; }
#pragma unroll
            for (int i = 0; i < 4; ++i)
#pragma unroll
                for (int j = 0; j < 4; ++j) { acc[i][j] += a[i] * b[j]; if (DUAL) acc2[i][j] += a[i] * b2[j]; }
        }
        __syncthreads();
    }
#pragma unroll
    for (int i = 0; i < 4; ++i)
#pragma unroll
        for (int j = 0; j < 4; ++j) { const int r = row0 + ty * 4 + i, c = col0 + tx * 4 + j; if (r < M && c < N) f.store(r, c, acc[i][j], acc2[i][j]); }
}

struct F1 {
    P p; const float* w; const float* qa; const float* kva;
    __device__ float a(int r, int k) const { return bf2f(((const bf16*)(p.ws + WS_XN))[(size_t)r * D + k]); }
    __device__ float b(int k, int c) const { return w[(size_t)k * INW + c]; }
    __device__ float b2(int, int) const { return 0.f; }
    __device__ void store(int r, int c, float acc, float) const {
        const float z = acc * rstd_h(p, r);
        ((float*)(p.ws + WS_P))[(size_t)r * INW + c] = z;
        float g = 1.f; if (c >= POOLW && c < POOLW + QLR) g = qa[c - POOLW]; else if (c >= POOLW + QLR && c < POOLW + QLR + KVLR) g = kva[c - POOLW - QLR];
        ((bf16*)(p.ws + WS_Z))[(size_t)r * INW + c] = f2bf(z * g);
    }
};
__global__ void k_ssqz(P p) {
    const int i = blockIdx.x * blockDim.x + threadIdx.x; if (i >= R * 37) return;
    const int r = i / 37, ch = i % 37;
    const float* z = (const float*)(p.ws + WS_P) + (size_t)r * INW + ch * 32; float s = 0.f;
    for (int j = 0; j < 32; ++j) s += z[j] * z[j];
    ((float*)(p.ws + WS_SSQZ))[(size_t)r * 40 + ch] = s;
}
__global__ void k_poolp(P p) {
    const int krow = blockIdx.x; const int pos = krow % L;
    const bf16* Z = (const bf16*)(p.ws + WS_Z);
    for (int c = threadIdx.x; c < POOLW; c += blockDim.x) {
        const int g = c >> 7, w = 2 << g; const int cnt = pos + 1 < w ? pos + 1 : w;
        float s = 0.f; for (int i = 0; i < cnt; ++i) s += bf2f(Z[(size_t)(krow - i) * INW + c]);
        ((bf16*)(p.ws + WS_P))[(size_t)krow * 512 + c] = f2bf(s / (float)cnt - bf2f(Z[(size_t)krow * INW + c]));
    }
}
__global__ void __launch_bounds__(256) k_poolgemm(P p, const float* w, const float* sc) {
    const int krow = blockIdx.x, c = threadIdx.x + blockIdx.y * 256;
    const int g = c >> 7, cc = c & 127;
    const bf16* pr = (const bf16*)(p.ws + WS_P) + (size_t)krow * 512 + g * 128;
    float acc = 0.f;
    for (int k = 0; k < 128; ++k) acc += bf2f(pr[k]) * w[((size_t)g * 128 + k) * 128 + cc];
    ((bf16*)(p.ws + WS_Y))[(size_t)krow * D + c] = f2bf(acc * sc[c]);
}
__global__ void __launch_bounds__(256) k_q(P p, const float* w, const float* qn) {
    const int krow = blockIdx.x * 256 + threadIdx.x, h = blockIdx.y; if (krow >= R) return;
    const bf16* z = (const bf16*)(p.ws + WS_Z) + (size_t)krow * INW + POOLW;
    float acc[QKD];
#pragma unroll
    for (int j = 0; j < QKD; ++j) acc[j] = 0.f;
    for (int k = 0; k < QLR; ++k) { const float a = bf2f(z[k]); const float* wr = w + (size_t)k * (NH * QKD) + h * QKD;
#pragma unroll
        for (int j = 0; j < QKD; ++j) acc[j] += a * wr[j]; }
    const float* sq = (const float*)(p.ws + WS_SSQZ) + (size_t)krow * 40; float s = 0.f; for (int c = 16; c < 28; ++c) s += sq[c];
    const float rq = rsqrtf(s / QLR + EPS);
    float s1 = 0.f, s2 = 0.f;
#pragma unroll
    for (int j = 0; j < QKD; ++j) { acc[j] *= rq; if (j < NOPE) s1 += acc[j] * acc[j]; else s2 += acc[j] * acc[j]; }
    const float r1 = rsqrtf(s1 / NOPE + EPS), r2 = rsqrtf(s2 / ROPE + EPS);
    bf16* q = (bf16*)(p.ws + WS_Q) + (size_t)krow * 768 + h * QKD;
#pragma unroll
    for (int j = 0; j < NOPE; ++j) q[j] = f2bf(acc[j] * r1 * qn[j] * QSCALE);
    const float* t = (const float*)(p.ws + WS_ROPE) + (size_t)(krow % L) * 32;
#pragma unroll
    for (int j = 0; j < 16; ++j) { const float x1 = acc[NOPE + j] * r2 * qn[NOPE + j], x2 = acc[NOPE + 16 + j] * r2 * qn[NOPE + 16 + j], c = t[j], sn = t[16 + j];
        q[NOPE + j] = f2bf((x1 * c - x2 * sn) * QSCALE); q[NOPE + 16 + j] = f2bf((x1 * sn + x2 * c) * QSCALE); }
}
__global__ void __launch_bounds__(256) k_kv(P p, const float* w, const float* kn) {
    const int krow = blockIdx.x * 256 + threadIdx.x, h = blockIdx.y; if (krow >= R) return;
    const bf16* z = (const bf16*)(p.ws + WS_Z) + (size_t)krow * INW + POOLW + QLR;
    float acc[128];
#pragma unroll
    for (int j = 0; j < 128; ++j) acc[j] = 0.f;
    for (int k = 0; k < KVLR; ++k) { const float a = bf2f(z[k]); const float* wr = w + (size_t)k * (NH * 128) + h * 128;
#pragma unroll
        for (int j = 0; j < 128; ++j) acc[j] += a * wr[j]; }
    const float* sq = (const float*)(p.ws + WS_SSQZ) + (size_t)krow * 40; float s = 0.f; for (int c = 28; c < 36; ++c) s += sq[c];
    const float rk = rsqrtf(s / KVLR + EPS);
    float s1 = 0.f;
#pragma unroll
    for (int j = 0; j < 128; ++j) { acc[j] *= rk; if (j < NOPE) s1 += acc[j] * acc[j]; }
    const float r1 = rsqrtf(s1 / NOPE + EPS);
    bf16* kk = (bf16*)(p.ws + WS_K) + (size_t)krow * 768 + h * QKD; bf16* vv = (bf16*)(p.ws + WS_V) + (size_t)krow * 512 + h * VD;
#pragma unroll
    for (int j = 0; j < NOPE; ++j) { kk[j] = f2bf(acc[j] * r1 * kn[j]); vv[j] = f2bf(acc[NOPE + j]); }
    const bf16* zr = (const bf16*)(p.ws + WS_Z) + (size_t)krow * INW + POOLW + QLR + KVLR;
    const float r2 = rsqrtf(sq[36] / ROPE + EPS);
    const float* t = (const float*)(p.ws + WS_ROPE) + (size_t)(krow % L) * 32;
#pragma unroll
    for (int j = 0; j < 16; ++j) { const float x1 = bf2f(zr[j]) * r2 * kn[NOPE + j], x2 = bf2f(zr[16 + j]) * r2 * kn[NOPE + 16 + j], c = t[j], sn = t[16 + j];
        kk[NOPE + j] = f2bf(x1 * c - x2 * sn); kk[NOPE + 16 + j] = f2bf(x1 * sn + x2 * c); }
}
__global__ void __launch_bounds__(64) k_attn(P p) {
    const int h = blockIdx.y; const int b = blockIdx.z; const int pos = blockIdx.x * 64 + threadIdx.x; if (pos >= L) return;
    const int krow = b * L + pos;
    const bf16* q = (const bf16*)(p.ws + WS_Q) + (size_t)krow * 768 + h * QKD;
    float qv[QKD], o[VD];
#pragma unroll
    for (int j = 0; j < QKD; ++j) qv[j] = bf2f(q[j]);
#pragma unroll
    for (int j = 0; j < VD; ++j) o[j] = 0.f;
    float m = -INFINITY, l = 0.f;
    for (int j = 0; j <= pos; ++j) {
        const bf16* kk = (const bf16*)(p.ws + WS_K) + (size_t)(b * L + j) * 768 + h * QKD; const bf16* vv = (const bf16*)(p.ws + WS_V) + (size_t)(b * L + j) * 512 + h * VD;
        float s = 0.f;
#pragma unroll
        for (int d = 0; d < QKD; ++d) s += qv[d] * bf2f(kk[d]);
        const float mn = fmaxf(m, s), f = exp2f(m - mn), pp = exp2f(s - mn);
        l = l * f + pp;
#pragma unroll
        for (int d = 0; d < VD; ++d) o[d] = o[d] * f + pp * bf2f(vv[d]);
        m = mn;
    }
    bf16* y = (bf16*)(p.ws + WS_Y) + (size_t)krow * D + POOLW + h * VD; const float il = 1.f / l;
#pragma unroll
    for (int d = 0; d < VD; ++d) y[d] = f2bf(o[d] * il);
}
struct F4 {
    P p; const float* w;
    __device__ float a(int r, int k) const { return bf2f(((const bf16*)(p.ws + WS_Y))[(size_t)r * D + k]); }
    __device__ float b(int k, int c) const { return w[(size_t)k * D + c]; }
    __device__ float b2(int, int) const { return 0.f; }
    __device__ void store(int r, int c, float acc, float) const { float* h = hptr(p, r); h[c] += acc; }
};
struct F5 {
    P p; const float* wg; const float* wu;
    __device__ float a(int r, int k) const { return bf2f(((const bf16*)(p.ws + WS_XN))[(size_t)r * D + k]); }
    __device__ float b(int k, int c) const { return wg[(size_t)k * FF + c]; }
    __device__ float b2(int k, int c) const { return wu[(size_t)k * FF + c]; }
    __device__ void store(int r, int c, float g, float u) const { const float rs = rstd_h(p, r); g *= rs; u *= rs; ((bf16*)(p.ws + WS_ACT))[(size_t)r * FF + c] = f2bf(g / (1.f + __expf(-g)) * u); }
};
struct F6 {
    P p; const float* w;
    __device__ float a(int r, int k) const { return bf2f(((const bf16*)(p.ws + WS_ACT))[(size_t)r * FF + k]); }
    __device__ float b(int k, int c) const { return w[(size_t)k * D + c]; }
    __device__ float b2(int, int) const { return 0.f; }
    __device__ void store(int r, int c, float acc, float) const { float* h = hptr(p, r); h[c] += acc; }
};
}

extern "C" void kernel_launch(void* const* d_in, const int* in_sizes, int n_in, void* d_out, int out_size, void* d_ws, size_t ws_size, hipStream_t stream) {
    if (n_in != 17 || ws_size < WS_END) { fprintf(stderr, "kernel_launch: unexpected n_in %d / ws %zu\n", n_in, ws_size); return; }
    P p{}; const float** f = &p.x; for (int i = 0; i < 17; ++i) f[i] = (const float*)d_in[i];
    p.out = (float*)d_out; p.ws = (unsigned char*)d_ws;
    hipMemsetAsync((char*)d_ws + WS_Z, 0, WS_END - WS_Z, stream);
    k_rope_table<<<(L * 16 + 255) / 256, 256, 0, stream>>>(p);
    k_h0<<<R, 256, 0, stream>>>(p);
    for (int l = 0; l < DEPTH; ++l) {
        const float* attn_g = p.attn_g + (size_t)l * D; const float* w_in = p.w_in + (size_t)l * D * INW; const float* w_pool = p.w_pool + (size_t)l * 4 * 128 * 128;
        const float* pool_scale = p.pool_scale + (size_t)l * POOLW; const float* qa = p.qa_g + (size_t)l * QLR; const float* wq = p.w_q_b + (size_t)l * QLR * NH * QKD;
        const float* kva = p.kva_g + (size_t)l * KVLR; const float* wkv = p.w_kv_b + (size_t)l * KVLR * NH * 128; const float* qn = p.qn_g + (size_t)l * QKD; const float* kn = p.kn_g + (size_t)l * QKD;
        const float* w_out = p.w_out + (size_t)l * D * D; const float* ffn_g = p.ffn_g + (size_t)l * D; const float* wg = p.w_gate + (size_t)l * D * FF; const float* wu = p.w_up + (size_t)l * D * FF;
        const float* wd = p.w_down + (size_t)l * FF * D;
        k_norm<<<R, 256, 0, stream>>>(p, attn_g);
        ngemm<F1, false><<<dim3((INW + 63) / 64, (R + 63) / 64), 256, 0, stream>>>(F1{p, w_in, qa, kva}, R, INW, D);
        k_ssqz<<<(R * 37 + 255) / 256, 256, 0, stream>>>(p);
        k_poolp<<<R, 256, 0, stream>>>(p);
        k_poolgemm<<<dim3(R, 2), 256, 0, stream>>>(p, w_pool, pool_scale);
        k_q<<<dim3((R + 255) / 256, NH), 256, 0, stream>>>(p, wq, qn);
        k_kv<<<dim3((R + 255) / 256, NH), 256, 0, stream>>>(p, wkv, kn);
        k_attn<<<dim3((L + 63) / 64, NH, BATCH), 64, 0, stream>>>(p);
        ngemm<F4, false><<<dim3(D / 64, (R + 63) / 64), 256, 0, stream>>>(F4{p, w_out}, R, D, D);
        k_norm<<<R, 256, 0, stream>>>(p, ffn_g);
        ngemm<F5, true><<<dim3(FF / 64, (R + 63) / 64), 256, 0, stream>>>(F5{p, wg, wu}, R, FF, D);
        ngemm<F6, false><<<dim3(D / 64, (R + 63) / 64), 256, 0, stream>>>(F6{p, wd}, R, D, FF);
    }
}
```

```cpp
#include <hip/hip_runtime.h>
#include <cstdint>
#include <cstdio>

#ifndef MK_DEV
#define MK_DEV 0
#endif
#ifndef MK_OPT_MASK
#define MK_OPT_MASK 0x7e
#endif
#define MK_OPT(k) (((MK_OPT_MASK) >> (k)) & 1)
#ifndef MK_MINI
#define MK_MINI 1
#endif

constexpr int D = 1024, BATCH = 4, SEQ = 4096, DEPTH = 2, NMETA = 16, L = SEQ + NMETA;
constexpr int R = BATCH * L;
constexpr int RA = R + 256;
constexpr int MR = BATCH * SEQ;
constexpr int POOLW = 512, QLR = 384, KVLR = 256, ROPE = 32, NOPE = 64, QKD = 96, VD = 64, NH = 8;
constexpr int INW = POOLW + QLR + KVLR + ROPE;
constexpr int INWP = 1280;
constexpr int FF = 2816;
constexpr float EPS = 1e-6f;
constexpr float QSCALE = 0.10206207261596577f * 1.4426950408889634f;
constexpr int QP = NH * QKD, KP = NH * QKD, VP = NH * VD, YP = D, ZP = INW, SZ = 40;

typedef unsigned short bf16;
#define GAS __attribute__((address_space(1)))
#define LAS __attribute__((address_space(3)))
constexpr size_t MiB = 1u << 20;
constexpr size_t WS_CTL = 0, CTL_ZERO_BYTES = 1 * MiB;
constexpr size_t WS_ROPE = 1 * MiB, WS_MINI = 2 * MiB, WS_W = 4 * MiB, WL_BYTES = 24 * MiB;
constexpr size_t WO_IN = 0, WO_Q = 2560 * 1024, WO_KV = 3328 * 1024, WO_P = 3840 * 1024, WO_OUT = 4 * MiB, WO_GU = 6 * MiB, WO_D = 17 * MiB;
constexpr size_t MN_HM = 0, MN_ZM = 256 * 1024, MN_YM = 384 * 1024, MN_ACT = 512 * 1024;
constexpr size_t WS_XN = 52 * MiB, WS_Y = 85 * MiB, WS_SSQH = 118 * MiB;
constexpr size_t WS_Z = 119 * MiB, WS_SSQZ = 157 * MiB, WS_Q = 160 * MiB, WS_K = 185 * MiB, WS_V = 210 * MiB, WS_PNAIVE = 227 * MiB, WS_ACT = 119 * MiB, WS_END = 244 * MiB;
static_assert(WO_IN + (size_t)INWP * D * 2 <= WO_Q && WO_Q + (size_t)768 * QLR * 2 <= WO_KV && WO_KV + (size_t)1024 * KVLR * 2 <= WO_P && WO_P + (size_t)4 * 128 * 128 * 2 <= WO_OUT &&
              WO_OUT + (size_t)D * D * 2 <= WO_GU && WO_GU + (size_t)2 * FF * D * 2 <= WO_D && WO_D + (size_t)D * FF * 2 <= WL_BYTES && WS_W + 2 * WL_BYTES <= WS_XN, "weight map");
static_assert(WS_XN + (size_t)RA * D * 2 <= WS_Y && WS_Y + (size_t)RA * D * 2 <= WS_SSQH && WS_SSQH + (size_t)RA * 16 <= WS_Z && WS_Z + (size_t)RA * INW * 2 <= WS_SSQZ && WS_SSQZ + (size_t)RA * SZ * 4 <= WS_Q &&
              WS_Q + (size_t)RA * QP * 2 <= WS_K && WS_K + (size_t)RA * KP * 2 <= WS_V && WS_V + (size_t)RA * VP * 2 <= WS_PNAIVE && WS_PNAIVE + (size_t)RA * 512 * 2 <= WS_END &&
              WS_ACT + (size_t)RA * FF * 2 <= WS_K + (size_t)R * KP * 2, "ws map");

__host__ __device__ __forceinline__ int rowbase(int pm) { return (pm >> 4) * L + NMETA + ((pm & 15) << 8); }
__device__ __forceinline__ float bf2f(bf16 v) { return __uint_as_float((unsigned)v << 16); }
__device__ __forceinline__ bf16 f2bf(float f) { unsigned u = __float_as_uint(f); return (bf16)((u + 0x7fffu + ((u >> 16) & 1u)) >> 16); }

struct P {
    const float *x, *meta, *attn_g, *w_in, *w_pool, *pool_scale, *qa_g, *w_q_b, *kva_g, *w_kv_b, *qn_g, *kn_g, *w_out, *ffn_g, *w_gate, *w_up, *w_down;
    float* out; unsigned char* ws;
};

namespace nv {
__device__ __forceinline__ int kmap(int v, long long mo) { return mo ? (v >> 4) * L + (v & 15) : v; }
__device__ __forceinline__ float* hptr(const P& p, int krow) {
    const int b = krow / L, pos = krow % L;
    return pos < NMETA ? (float*)(p.ws + WS_MINI) + (size_t)(b * NMETA + pos) * D : p.out + (size_t)(b * SEQ + pos - NMETA) * D;
}
__global__ void k_rope_table(P p) {
    const int i = blockIdx.x * blockDim.x + threadIdx.x; if (i >= L * 16) return;
    const int pos = i / 16, j = i % 16;
    const float inv = 1.0f / powf(10000.0f, (float)(2 * j) / 32.0f);
    const float ang = (float)pos * inv;
    float* t = (float*)(p.ws + WS_ROPE) + (size_t)pos * 32;
    t[j] = cosf(ang); t[16 + j] = sinf(ang);
}
__global__ void k_h0(P p) {
    const int krow = blockIdx.x; const int b = krow / L, pos = krow % L;
    const float* src = pos < NMETA ? p.meta + (size_t)pos * D : p.x + (size_t)(b * SEQ + pos - NMETA) * D;
    float* dst = hptr(p, krow);
    for (int c = threadIdx.x; c < D; c += blockDim.x) dst[c] = src[c];
}
__global__ void k_norm(P p, const float* gain, int mo) {
    const int krow = kmap(blockIdx.x, mo); const float* h = hptr(p, krow);
    __shared__ float red[256];
    float s = 0.f;
    bf16* xn = (bf16*)(p.ws + WS_XN) + (size_t)krow * D;
    for (int c = threadIdx.x; c < D; c += 256) { const float v = h[c]; s += v * v; xn[c] = f2bf(v * gain[c]); }
    red[threadIdx.x] = s; __syncthreads();
    for (int o = 128; o > 0; o >>= 1) { if (threadIdx.x < o) red[threadIdx.x] += red[threadIdx.x + o]; __syncthreads(); }
    if (threadIdx.x == 0) { float* q = (float*)(p.ws + WS_SSQH) + (size_t)krow * 4; q[0] = red[0]; q[1] = 0.f; q[2] = 0.f; q[3] = 0.f; }
}
__device__ __forceinline__ float rstd_h(const P& p, int krow) {
    const float* q = (const float*)(p.ws + WS_SSQH) + (size_t)krow * 4;
    return rsqrtf((q[0] + q[1] + q[2] + q[3]) * (1.0f / D) + EPS);
}
template <class F, bool DUAL> __global__ void __launch_bounds__(256) ngemm(F f, int M, int N, int K) {
    __shared__ float As[16][65], Bs[16][65], Bs2[16][65];
    const int tx = threadIdx.x & 15, ty = threadIdx.x >> 4;
    const int row0 = blockIdx.y * 64, col0 = blockIdx.x * 64;
    float acc[4][4], acc2[4][4];
#pragma unroll
    for (int i = 0; i < 4; ++i)
#pragma unroll
        for (int j = 0; j < 4; ++j) { acc[i][j] = 0.f; acc2[i][j] = 0.f; }
    for (int k0 = 0; k0 < K; k0 += 16) {
#pragma unroll
        for (int i = 0; i < 4; ++i) {
            const int idx = threadIdx.x + 256 * i;
            { const int r = idx >> 4, kk = idx & 15; As[kk][r] = (row0 + r < M) ? f.a(row0 + r, k0 + kk) : 0.f; }
            { const int kk = idx >> 6, c = idx & 63; const bool ok = col0 + c < N; Bs[kk][c] = ok ? f.b(k0 + kk, col0 + c) : 0.f; if (DUAL) Bs2[kk][c] = ok ? f.b2(k0 + kk, col0 + c) : 0.f; }
        }
        __syncthreads();
#pragma unroll
        for (int kk = 0; kk < 16; ++kk) {
            float a[4], b[4], b2[4];
#pragma unroll
            for (int i = 0; i < 4; ++i) { a[i] = As[kk][ty * 4 + i]; b[i] = Bs[kk][tx * 4 + i]; b2[i] = DUAL ? Bs2[kk][tx * 4 + i] : 0.f; }
#pragma unroll
            for (int i = 0; i < 4; ++i)
#pragma unroll
                for (int j = 0; j < 4; ++j) { acc[i][j] += a[i] * b[j]; if (DUAL) acc2[i][j] += a[i] * b2[j]; }
        }
        __syncthreads();
    }
#pragma unroll
    for (int i = 0; i < 4; ++i)
#pragma unroll
        for (int j = 0; j < 4; ++j) { const int r = row0 + ty * 4 + i, c = col0 + tx * 4 + j; if (r < M && c < N) f.store(r, c, acc[i][j], acc2[i][j]); }
}
__global__ void __launch_bounds__(256) k_z(P p, const float* w, const float* qa, const float* kva, int nrows, int mo) {
    const int v = blockIdx.x * 256 + threadIdx.x, ch = blockIdx.y; if (v >= nrows) return;
    const int krow = kmap(v, mo);
    const bf16* xn = (const bf16*)(p.ws + WS_XN) + (size_t)krow * D;
    float acc[32];
#pragma unroll
    for (int j = 0; j < 32; ++j) acc[j] = 0.f;
    for (int k = 0; k < D; ++k) { const float a = bf2f(xn[k]); const float* wr = w + (size_t)k * INW + ch * 32;
#pragma unroll
        for (int j = 0; j < 32; ++j) acc[j] += a * wr[j]; }
    const float rs = rstd_h(p, krow); float ss = 0.f;
    bf16* z = (bf16*)(p.ws + WS_Z) + (size_t)krow * ZP + ch * 32;
#pragma unroll
    for (int j = 0; j < 32; ++j) { const float zz = acc[j] * rs; ss += zz * zz; const int c = ch * 32 + j;
        float g = 1.f; if (c >= POOLW && c < POOLW + QLR) g = qa[c - POOLW]; else if (c >= POOLW + QLR && c < POOLW + QLR + KVLR) g = kva[c - POOLW - QLR];
        z[j] = f2bf(zz * g); }
    ((float*)(p.ws + WS_SSQZ))[(size_t)krow * SZ + ch] = ss;
}
__global__ void k_poolp(P p, int mo) {
    const int krow = kmap(blockIdx.x, mo); const int pos = krow % L;
    const bf16* Z = (const bf16*)(p.ws + WS_Z);
    for (int c = threadIdx.x; c < POOLW; c += blockDim.x) {
        const int g = c >> 7, w = 2 << g; const int cnt = pos + 1 < w ? pos + 1 : w;
        float s = 0.f; for (int i = 0; i < cnt; ++i) s += bf2f(Z[(size_t)(krow - i) * ZP + c]);
        ((bf16*)(p.ws + WS_PNAIVE))[(size_t)krow * 512 + c] = f2bf(s / (float)cnt - bf2f(Z[(size_t)krow * ZP + c]));
    }
}
__global__ void __launch_bounds__(256) k_poolgemm(P p, const float* w, const float* sc, int mo) {
    const int krow = kmap(blockIdx.x, mo), c = threadIdx.x + blockIdx.y * 256;
    const int g = c >> 7, cc = c & 127;
    const bf16* pr = (const bf16*)(p.ws + WS_PNAIVE) + (size_t)krow * 512 + g * 128;
    float acc = 0.f;
    for (int k = 0; k < 128; ++k) acc += bf2f(pr[k]) * w[((size_t)g * 128 + k) * 128 + cc];
    ((bf16*)(p.ws + WS_Y))[(size_t)krow * YP + c] = f2bf(acc * sc[c]);
}
__global__ void __launch_bounds__(256) k_q(P p, const float* w, const float* qn, int nrows, int mo) {
    const int v = blockIdx.x * 256 + threadIdx.x, h = blockIdx.y; if (v >= nrows) return;
    const int krow = kmap(v, mo);
    const bf16* z = (const bf16*)(p.ws + WS_Z) + (size_t)krow * ZP + POOLW;
    float acc[QKD];
#pragma unroll
    for (int j = 0; j < QKD; ++j) acc[j] = 0.f;
    for (int k = 0; k < QLR; ++k) { const float a = bf2f(z[k]); const float* wr = w + (size_t)k * (NH * QKD) + h * QKD;
#pragma unroll
        for (int j = 0; j < QKD; ++j) acc[j] += a * wr[j]; }
    const float* sq = (const float*)(p.ws + WS_SSQZ) + (size_t)krow * SZ; float s = 0.f; for (int c = 16; c < 28; ++c) s += sq[c];
    const float rq = rsqrtf(s / QLR + EPS);
    float s1 = 0.f, s2 = 0.f;
#pragma unroll
    for (int j = 0; j < QKD; ++j) { acc[j] *= rq; if (j < NOPE) s1 += acc[j] * acc[j]; else s2 += acc[j] * acc[j]; }
    const float r1 = rsqrtf(s1 / NOPE + EPS), r2 = rsqrtf(s2 / ROPE + EPS);
    bf16* q = (bf16*)(p.ws + WS_Q) + (size_t)krow * QP + h * QKD;
#pragma unroll
    for (int j = 0; j < NOPE; ++j) q[j] = f2bf(acc[j] * r1 * qn[j] * QSCALE);
    const float* t = (const float*)(p.ws + WS_ROPE) + (size_t)(krow % L) * 32;
#pragma unroll
    for (int j = 0; j < 16; ++j) { const float x1 = acc[NOPE + j] * r2 * qn[NOPE + j], x2 = acc[NOPE + 16 + j] * r2 * qn[NOPE + 16 + j], c = t[j], sn = t[16 + j];
        q[NOPE + j] = f2bf((x1 * c - x2 * sn) * QSCALE); q[NOPE + 16 + j] = f2bf((x1 * sn + x2 * c) * QSCALE); }
}
__global__ void __launch_bounds__(256) k_kv(P p, const float* w, const float* kn, int nrows, int mo) {
    const int v = blockIdx.x * 256 + threadIdx.x, h = blockIdx.y; if (v >= nrows) return;
    const int krow = kmap(v, mo);
    const bf16* z = (const bf16*)(p.ws + WS_Z) + (size_t)krow * ZP + POOLW + QLR;
    float acc[128];
#pragma unroll
    for (int j = 0; j < 128; ++j) acc[j] = 0.f;
    for (int k = 0; k < KVLR; ++k) { const float a = bf2f(z[k]); const float* wr = w + (size_t)k * (NH * 128) + h * 128;
#pragma unroll
        for (int j = 0; j < 128; ++j) acc[j] += a * wr[j]; }
    const float* sq = (const float*)(p.ws + WS_SSQZ) + (size_t)krow * SZ; float s = 0.f; for (int c = 28; c < 36; ++c) s += sq[c];
    const float rk = rsqrtf(s / KVLR + EPS);
    float s1 = 0.f;
#pragma unroll
    for (int j = 0; j < 128; ++j) { acc[j] *= rk; if (j < NOPE) s1 += acc[j] * acc[j]; }
    const float r1 = rsqrtf(s1 / NOPE + EPS);
    bf16* kk = (bf16*)(p.ws + WS_K) + (size_t)krow * KP + h * QKD; bf16* vv = (bf16*)(p.ws + WS_V) + (size_t)krow * VP + h * VD;
#pragma unroll
    for (int j = 0; j < NOPE; ++j) { kk[j] = f2bf(acc[j] * r1 * kn[j]); vv[j] = f2bf(acc[NOPE + j]); }
    const bf16* zr = (const bf16*)(p.ws + WS_Z) + (size_t)krow * ZP + POOLW + QLR + KVLR;
    const float r2 = rsqrtf(sq[36] / ROPE + EPS);
    const float* t = (const float*)(p.ws + WS_ROPE) + (size_t)(krow % L) * 32;
#pragma unroll
    for (int j = 0; j < 16; ++j) { const float x1 = bf2f(zr[j]) * r2 * kn[NOPE + j], x2 = bf2f(zr[16 + j]) * r2 * kn[NOPE + 16 + j], c = t[j], sn = t[16 + j];
        kk[NOPE + j] = f2bf(x1 * c - x2 * sn); kk[NOPE + 16 + j] = f2bf(x1 * sn + x2 * c); }
}
__global__ void __launch_bounds__(64) k_attn(P p, int npos) {
    const int h = blockIdx.y; const int b = blockIdx.z; const int pos = blockIdx.x * 64 + threadIdx.x; if (pos >= npos) return;
    const int krow = b * L + pos;
    const bf16* q = (const bf16*)(p.ws + WS_Q) + (size_t)krow * QP + h * QKD;
    float qv[QKD], o[VD];
#pragma unroll
    for (int j = 0; j < QKD; ++j) qv[j] = bf2f(q[j]);
#pragma unroll
    for (int j = 0; j < VD; ++j) o[j] = 0.f;
    float m = -INFINITY, l = 0.f;
    for (int j = 0; j <= pos; ++j) {
        const bf16* kk = (const bf16*)(p.ws + WS_K) + (size_t)(b * L + j) * KP + h * QKD; const bf16* vv = (const bf16*)(p.ws + WS_V) + (size_t)(b * L + j) * VP + h * VD;
        float s = 0.f;
#pragma unroll
        for (int d = 0; d < QKD; ++d) s += qv[d] * bf2f(kk[d]);
        const float mn = fmaxf(m, s), f = exp2f(m - mn), pp = exp2f(s - mn);
        l = l * f + pp;
#pragma unroll
        for (int d = 0; d < VD; ++d) o[d] = o[d] * f + pp * bf2f(vv[d]);
        m = mn;
    }
    bf16* y = (bf16*)(p.ws + WS_Y) + (size_t)krow * YP + POOLW + h * VD; const float il = 1.f / l;
#pragma unroll
    for (int d = 0; d < VD; ++d) y[d] = f2bf(o[d] * il);
}
struct F4 { P p; const float* w; long long mo;
    __device__ float a(int r, int k) const { return bf2f(((const bf16*)(p.ws + WS_Y))[(size_t)kmap(r, mo) * YP + k]); }
    __device__ float b(int k, int c) const { return w[(size_t)k * D + c]; }
    __device__ float b2(int, int) const { return 0.f; }
    __device__ void store(int r, int c, float acc, float) const { float* h = hptr(p, kmap(r, mo)); h[c] += acc; } };
struct F5 { P p; const float* wg; const float* wu; long long mo;
    __device__ float a(int r, int k) const { return bf2f(((const bf16*)(p.ws + WS_XN))[(size_t)kmap(r, mo) * D + k]); }
    __device__ float b(int k, int c) const { return wg[(size_t)k * FF + c]; }
    __device__ float b2(int k, int c) const { return wu[(size_t)k * FF + c]; }
    __device__ void store(int r, int c, float g, float u) const { const int kr = kmap(r, mo); const float rs = rstd_h(p, kr); g *= rs; u *= rs; ((bf16*)(p.ws + WS_ACT))[(size_t)kr * FF + c] = f2bf(g / (1.f + __expf(-g)) * u); } };
struct F6 { P p; const float* w; long long mo;
    __device__ float a(int r, int k) const { return bf2f(((const bf16*)(p.ws + WS_ACT))[(size_t)kmap(r, mo) * FF + k]); }
    __device__ float b(int k, int c) const { return w[(size_t)k * D + c]; }
    __device__ float b2(int, int) const { return 0.f; }
    __device__ void store(int r, int c, float acc, float) const { float* h = hptr(p, kmap(r, mo)); h[c] += acc; } };
}

namespace pg8 {
#define PG8_LAS __attribute__((address_space(3)))
typedef unsigned short bf16_t;
typedef short bf16x8 __attribute__((ext_vector_type(8)));
typedef float f32x4 __attribute__((ext_vector_type(4)));
typedef unsigned u32x4 __attribute__((ext_vector_type(4)));
typedef unsigned u32x2 __attribute__((ext_vector_type(2)));
constexpr int BM = 256, BK = 64, HALF = 128, HTB = HALF * BK * 2, STAGE_BYTES = 8 * HTB, NXCD = 8, WGM = 8;
__host__ __device__ __forceinline__ int lds_byte(int r, int c) { const int st = (r >> 4) * 2 + (c >> 5), rr = r & 15, cc = c & 31, ob = rr * 64 + cc * 2; return st * 1024 + (ob ^ (((ob >> 9) & 1) << 5)); }
__host__ __device__ __forceinline__ void stage_rc(int b, int& R_, int& C) { const int st = b / 1024, sb = b % 1024, swz = sb ^ (((sb >> 9) & 1) << 5); R_ = (st >> 1) * 16 + swz / 64; C = (st & 1) * 32 + (swz % 64) / 2; }
__host__ __device__ __forceinline__ int perm32(int rho) { const int n = rho >> 4, i = rho & 15; return 8 * (i >> 2) + 4 * n + (i & 3); }
struct Unit { int pm, pn; };
struct Gemm { const bf16_t* A; int lda; int acolstep; const bf16_t* Bt; int K; };
struct StaticOrder {
    int nM, nN, nwg, G, c;
    __host__ __device__ void init(int nM_, int nN_, int G_, int c_) { nM = nM_; nN = nN_; nwg = nM * nN; G = G_; c = c_; }
    __host__ __device__ bool next(int i, Unit& u) const {
        const long Lx = (long)i * G + c; if (Lx >= nwg) return false;
        int wgid = (int)Lx; { const int q = nwg / NXCD, r = nwg % NXCD, xcd = wgid % NXCD, off = wgid / NXCD; wgid = (xcd < r ? xcd * (q + 1) : r * (q + 1) + (xcd - r) * q) + off; }
        const int nig = WGM * nN, gid = wgid / nig, fm = gid * WGM, gsz = (nM - fm) < WGM ? (nM - fm) : WGM;
        u.pm = fm + ((wgid % nig) % gsz); u.pn = (wgid % nig) / gsz; return true;
    }
    __device__ __forceinline__ void a_ready(const Unit&) const {}
    __device__ __forceinline__ void done(const Unit&) const {}
};
__device__ __forceinline__ unsigned cvt_pk_bf16(float lo, float hi) { unsigned r; asm volatile("v_cvt_pk_bf16_f32 %0, %1, %2" : "=v"(r) : "v"(lo), "v"(hi)); return r; }
__device__ __forceinline__ float hsum4(f32x4 v) { return (v[0] * v[0] + v[1] * v[1]) + (v[2] * v[2] + v[3] * v[3]); }

__device__ __forceinline__ void fresh_lane(int& fr, int& fq) { unsigned m1 = ~0u; asm volatile("" : "+s"(m1)); const int lane = (int)__builtin_amdgcn_mbcnt_hi(m1, __builtin_amdgcn_mbcnt_lo(m1, 0u)); fr = lane & 15; fq = lane >> 4; }
struct EpiZ {
    static constexpr bool PERM = true, AFTER_DRAIN = false;
    bf16_t* Z; float* ssqz; const float* ssqh; const float* qa; const float* kva;
    __device__ __forceinline__ void operator()(const f32x4 (&acc)[2][2][4][2], const Unit& u, int wr, int wc, int, int) const {
        int fr, fq; fresh_lane(fr, fq);
        const int kr0 = rowbase(u.pm) + wr * 64 + fr;
        f32x4 g[2][2]; bool valid[2];
#pragma unroll
        for (int bj = 0; bj < 2; ++bj) { const int cb = u.pn * BM + bj * HALF + wc * 32; valid[bj] = cb < INW; const int c0 = cb + 8 * fq;
            const float* gp = (cb >= POOLW && cb < POOLW + QLR) ? qa + (c0 - POOLW) : (cb >= POOLW + QLR && cb < POOLW + QLR + KVLR) ? kva + (c0 - POOLW - QLR) : nullptr;
            g[bj][0] = gp ? *(const f32x4*)gp : (f32x4){1.f, 1.f, 1.f, 1.f}; g[bj][1] = gp ? *(const f32x4*)(gp + 4) : (f32x4){1.f, 1.f, 1.f, 1.f}; }
#pragma unroll
        for (int ai = 0; ai < 2; ++ai)
#pragma unroll
            for (int m = 0; m < 4; ++m) { const int krow = kr0 + ai * HALF + m * 16;
                const f32x4 sq = *(const GAS f32x4*)(ssqh + (size_t)krow * 4); const float rs = rsqrtf(((sq[0] + sq[1]) + (sq[2] + sq[3])) * (1.0f / D) + EPS);
#pragma unroll
                for (int bj = 0; bj < 2; ++bj) { if (!valid[bj]) continue;
                    const f32x4 v0 = acc[ai][bj][m][0] * rs, v1 = acc[ai][bj][m][1] * rs;
                    float ss = hsum4(v0) + hsum4(v1); ss += __shfl_xor(ss, 16); ss += __shfl_xor(ss, 32);
                    if (fq == 0) ((GAS float*)ssqz)[(size_t)krow * SZ + u.pn * 8 + bj * 4 + wc] = ss;
                    const f32x4 o0 = v0 * g[bj][0], o1 = v1 * g[bj][1];
                    u32x4 w; w.x = cvt_pk_bf16(o0[0], o0[1]); w.y = cvt_pk_bf16(o0[2], o0[3]); w.z = cvt_pk_bf16(o1[0], o1[1]); w.w = cvt_pk_bf16(o1[2], o1[3]);
                    *(GAS u32x4*)(Z + (size_t)krow * ZP + u.pn * BM + bj * HALF + wc * 32 + 8 * fq) = w; } }
    }
};

struct EpiQ {
    static constexpr bool PERM = false, AFTER_DRAIN = false;
    bf16_t* Q; const float* ssqz; const float* qn; const float* rope;
    __device__ __forceinline__ void operator()(const f32x4 (&acc)[2][2][4][2], const Unit& u, int wr, int wc, int, int) const {
        int fr, fq; fresh_lane(fr, fq);
        const int kr0 = rowbase(u.pm) + wr * 64 + fr, pos0 = NMETA + ((u.pm & 15) << 8) + wr * 64 + fr;
        if (u.pn < 2) {
            const int head = 4 * u.pn + wc; f32x4 gq[2][2];
#pragma unroll
            for (int bj = 0; bj < 2; ++bj)
#pragma unroll
                for (int n = 0; n < 2; ++n) gq[bj][n] = *(const f32x4*)(qn + 32 * bj + 16 * n + 4 * fq);
#pragma unroll
            for (int ai = 0; ai < 2; ++ai)
#pragma unroll
                for (int m = 0; m < 4; ++m) { const int krow = kr0 + ai * HALF + m * 16; const GAS f32x4* sq = (const GAS f32x4*)(ssqz + (size_t)krow * SZ + 16);
                    const f32x4 t = sq[0] + sq[1] + sq[2]; const float rq = rsqrtf(((t[0] + t[1]) + (t[2] + t[3])) * (1.0f / QLR) + EPS);
                    f32x4 v[2][2]; float ss = 0.f;
#pragma unroll
                    for (int bj = 0; bj < 2; ++bj)
#pragma unroll
                        for (int n = 0; n < 2; ++n) { v[bj][n] = acc[ai][bj][m][n] * rq; ss += hsum4(v[bj][n]); }
                    ss += __shfl_xor(ss, 16); ss += __shfl_xor(ss, 32);
                    const float r1 = rsqrtf(ss * (1.0f / NOPE) + EPS) * QSCALE;
                    bf16_t* qp = Q + (size_t)krow * QP + head * QKD + 4 * fq;
#pragma unroll
                    for (int bj = 0; bj < 2; ++bj)
#pragma unroll
                        for (int n = 0; n < 2; ++n) { const f32x4 o = v[bj][n] * r1 * gq[bj][n]; u32x2 w; w.x = cvt_pk_bf16(o[0], o[1]); w.y = cvt_pk_bf16(o[2], o[3]); *(GAS u32x2*)(qp + 32 * bj + 16 * n) = w; }
                    asm volatile("" ::: "memory"); }
        } else {
            const f32x4 g1 = *(const f32x4*)(qn + NOPE + 4 * fq), g2 = *(const f32x4*)(qn + NOPE + 16 + 4 * fq);
#pragma unroll
            for (int ai = 0; ai < 2; ++ai)
#pragma unroll
                for (int m = 0; m < 4; ++m) { const int krow = kr0 + ai * HALF + m * 16, pos = pos0 + ai * HALF + m * 16; const GAS f32x4* sq = (const GAS f32x4*)(ssqz + (size_t)krow * SZ + 16);
                    const f32x4 t = sq[0] + sq[1] + sq[2]; const float rq = rsqrtf(((t[0] + t[1]) + (t[2] + t[3])) * (1.0f / QLR) + EPS);
                    const f32x4 c4 = *(const GAS f32x4*)(rope + (size_t)pos * 32 + 4 * fq), s4 = *(const GAS f32x4*)(rope + (size_t)pos * 32 + 16 + 4 * fq);
#pragma unroll
                    for (int bj = 0; bj < 2; ++bj) { const int head = 4 * bj + wc; const f32x4 v0 = acc[ai][bj][m][0] * rq, v1 = acc[ai][bj][m][1] * rq;
                        float ss = hsum4(v0) + hsum4(v1); ss += __shfl_xor(ss, 16); ss += __shfl_xor(ss, 32);
                        const float r2 = rsqrtf(ss * (1.0f / ROPE) + EPS) * QSCALE;
                        const f32x4 x1 = v0 * r2 * g1, x2 = v1 * r2 * g2, o1 = x1 * c4 - x2 * s4, o2 = x1 * s4 + x2 * c4;
                        bf16_t* qp = Q + (size_t)krow * QP + head * QKD + NOPE + 4 * fq; u32x2 w;
                        w.x = cvt_pk_bf16(o1[0], o1[1]); w.y = cvt_pk_bf16(o1[2], o1[3]); *(GAS u32x2*)qp = w;
                        w.x = cvt_pk_bf16(o2[0], o2[1]); w.y = cvt_pk_bf16(o2[2], o2[3]); *(GAS u32x2*)(qp + 16) = w; }
                    asm volatile("" ::: "memory"); }
        }
    }
};
struct EpiKV {
    static constexpr bool PERM = false, AFTER_DRAIN = false;
    bf16_t* Kb; bf16_t* Vb; const float* ssqz; const float* kn;
    __device__ __forceinline__ void operator()(const f32x4 (&acc)[2][2][4][2], const Unit& u, int wr, int wc, int, int) const {
        int fr, fq; fresh_lane(fr, fq);
        const int kr0 = rowbase(u.pm) + wr * 64 + fr; const bool isk = u.pn < 2; const int head = 4 * (u.pn & 1) + wc;
        f32x4 gk[2][2];
#pragma unroll
        for (int bj = 0; bj < 2; ++bj)
#pragma unroll
            for (int n = 0; n < 2; ++n) gk[bj][n] = isk ? *(const f32x4*)(kn + 32 * bj + 16 * n + 4 * fq) : (f32x4){1.f, 1.f, 1.f, 1.f};
#pragma unroll
        for (int ai = 0; ai < 2; ++ai)
#pragma unroll
            for (int m = 0; m < 4; ++m) { const int krow = kr0 + ai * HALF + m * 16; const GAS f32x4* sq = (const GAS f32x4*)(ssqz + (size_t)krow * SZ + 28);
                const f32x4 t = sq[0] + sq[1]; const float rk = rsqrtf(((t[0] + t[1]) + (t[2] + t[3])) * (1.0f / KVLR) + EPS);
                f32x4 v[2][2]; float ss = 0.f;
#pragma unroll
                for (int bj = 0; bj < 2; ++bj)
#pragma unroll
                    for (int n = 0; n < 2; ++n) { v[bj][n] = acc[ai][bj][m][n] * rk; ss += hsum4(v[bj][n]); }
                ss += __shfl_xor(ss, 16); ss += __shfl_xor(ss, 32);
                const float r1 = isk ? rsqrtf(ss * (1.0f / NOPE) + EPS) : 1.0f;
                bf16_t* op = isk ? Kb + (size_t)krow * KP + head * QKD + 4 * fq : Vb + (size_t)krow * VP + head * VD + 4 * fq;
#pragma unroll
                for (int bj = 0; bj < 2; ++bj)
#pragma unroll
                    for (int n = 0; n < 2; ++n) { const f32x4 o = v[bj][n] * r1 * gk[bj][n]; u32x2 w; w.x = cvt_pk_bf16(o[0], o[1]); w.y = cvt_pk_bf16(o[2], o[3]); *(GAS u32x2*)(op + 32 * bj + 16 * n) = w; }
                asm volatile("" ::: "memory"); }
    }
};

struct EpiRes {
    static constexpr bool PERM = false, AFTER_DRAIN = true;
    const float* base; float* out; bf16_t* xn; float* ssqh; const float* gain;
    __device__ __forceinline__ void fused(const f32x4 (&acc)[2][2][4][2], const Unit& u, int wr, int wc, int, int, PG8_LAS unsigned char* lds, int wid, int) const {
        int fr, fq; fresh_lane(fr, fq);
        const int col0 = u.pn * BM + wc * 32 + 4 * fq; const bool nrm = gain != nullptr;
        f32x4 gv[2][2];
#pragma unroll
        for (int bj = 0; bj < 2; ++bj)
#pragma unroll
            for (int n = 0; n < 2; ++n) gv[bj][n] = nrm ? *(const f32x4*)(gain + col0 + bj * HALF + n * 16) : (f32x4){0.f, 0.f, 0.f, 0.f};
        PG8_LAS float* Pp = (PG8_LAS float*)lds;
#pragma unroll
        for (int ai = 0; ai < 2; ++ai)
#pragma unroll
            for (int m = 0; m < 4; ++m) { const int r = ai * HALF + wr * 64 + m * 16 + fr; const size_t off = (size_t)(u.pm * BM + r) * D + col0; const size_t xoff = (size_t)(rowbase(u.pm) + r) * D + col0;
                float ss = 0.f;
#pragma unroll
                for (int bj = 0; bj < 2; ++bj)
#pragma unroll
                    for (int n = 0; n < 2; ++n) { const f32x4 o = *(const GAS f32x4*)(base + off + bj * HALF + n * 16) + acc[ai][bj][m][n]; *(GAS f32x4*)(out + off + bj * HALF + n * 16) = o;
                        if (nrm) { ss += hsum4(o); const f32x4 x = o * gv[bj][n]; u32x2 w; w.x = cvt_pk_bf16(x[0], x[1]); w.y = cvt_pk_bf16(x[2], x[3]); *(GAS u32x2*)(xn + xoff + bj * HALF + n * 16) = w; } }
                if (nrm) { ss += __shfl_xor(ss, 16); ss += __shfl_xor(ss, 32); if (fq == 0) Pp[r * 4 + wc] = ss; }
                asm volatile("" ::: "memory"); }
        if (nrm) {
            asm volatile("s_waitcnt lgkmcnt(0)" ::: "memory"); __builtin_amdgcn_s_barrier(); asm volatile("" ::: "memory");
            const int t = wid * 64 + fq * 16 + fr;
            if (t < 256) { const f32x4 q = *(const PG8_LAS f32x4*)(Pp + t * 4); ((GAS float*)ssqh)[(size_t)(rowbase(u.pm) + t) * 4 + u.pn] = (q[0] + q[1]) + (q[2] + q[3]); }
        }
    }
};
struct EpiSwiGLU {
    static constexpr bool PERM = true, AFTER_DRAIN = false;
    bf16_t* act; const float* ssqh;
    __device__ __forceinline__ void operator()(const f32x4 (&acc)[2][2][4][2], const Unit& u, int wr, int wc, int, int) const {
        int fr, fq; fresh_lane(fr, fq);
        const int kr0 = rowbase(u.pm) + wr * 64 + fr;
#pragma unroll
        for (int ai = 0; ai < 2; ++ai)
#pragma unroll
            for (int m = 0; m < 4; ++m) { const int krow = kr0 + ai * HALF + m * 16;
                const f32x4 sq = *(const GAS f32x4*)(ssqh + (size_t)krow * 4); const float rs = rsqrtf(((sq[0] + sq[1]) + (sq[2] + sq[3])) * (1.0f / D) + EPS);
                f32x4 a[2];
#pragma unroll
                for (int n = 0; n < 2; ++n) { const f32x4 g = acc[ai][0][m][n] * rs, uu = acc[ai][1][m][n] * rs;
#pragma unroll
                    for (int e = 0; e < 4; ++e) a[n][e] = g[e] * __builtin_amdgcn_rcpf(1.0f + __expf(-g[e])) * uu[e]; }
                u32x4 w; w.x = cvt_pk_bf16(a[0][0], a[0][1]); w.y = cvt_pk_bf16(a[0][2], a[0][3]); w.z = cvt_pk_bf16(a[1][0], a[1][1]); w.w = cvt_pk_bf16(a[1][2], a[1][3]);
                *(GAS u32x4*)(act + (size_t)krow * FF + u.pn * HALF + wc * 32 + 8 * fq) = w; }
    }
};

template <class Epi, class Sched, bool ALIGN_EPI = false, bool SP2 = false>
__device__ __forceinline__ void gemm_phase(PG8_LAS unsigned char* lds, const Gemm g, const Sched& S, const Epi& E, const int wid) {
    int fr_, fq_; fresh_lane(fr_, fq_);
    const int lane = fq_ * 16 + fr_, tid = wid * 64 + lane, wr = wid >> 2, wc = wid & 3, fr = lane & 15, fq = lane >> 4;
    const int K = g.K, nt = K / BK, lda = g.lda;
    unsigned voffA[2], voffB[2];
#pragma unroll
    for (int i = 0; i < 2; ++i) { int R_, C; stage_rc(tid * 16 + i * 8192, R_, C); const int Rb = Epi::PERM ? ((R_ & ~31) + perm32(R_ & 31)) : R_;
        voffA[i] = (unsigned)(R_ * lda + C) * 2u; voffB[i] = (unsigned)(Rb * K + C) * 2u; }
    const size_t kstep = (size_t)(BK * 2);
    const size_t hstepA = (size_t)HALF * lda * 2, hstepB = (size_t)HALF * K * 2, tstepB = 2 * hstepB;
    const unsigned ldsw = (unsigned)wid * 1024u;
    const int aoff = lds_byte(wr * 64 + fr, fq * 8), boff = lds_byte(wc * 32 + fr, fq * 8);
#define PG8_SA(b, h) (((b) * 2 + (h)) * HTB)
#define PG8_SB(b, h) ((4 + (b) * 2 + (h)) * HTB)
#define PG8_STAGE(bufoff, gbase, voff) do { _Pragma("unroll") for (int _i = 0; _i < 2; ++_i) \
        __builtin_amdgcn_global_load_lds((const unsigned*)((const char*)(gbase) + (voff)[_i]), (PG8_LAS unsigned*)(lds + (bufoff) + ldsw + _i * 8192), 16, 0, 0); } while (0)
#define PG8_LDA(dst, b, h) do { _Pragma("unroll") for (int m = 0; m < 4; ++m) _Pragma("unroll") for (int k = 0; k < 2; ++k) dst[m][k] = *(const PG8_LAS bf16x8*)(lds + PG8_SA(b, h) + aoff + m * 2048 + k * 1024); } while (0)
#define PG8_LDB(dst, b, h) do { _Pragma("unroll") for (int n = 0; n < 2; ++n) _Pragma("unroll") for (int k = 0; k < 2; ++k) dst[n][k] = *(const PG8_LAS bf16x8*)(lds + PG8_SB(b, h) + boff + n * 2048 + k * 1024); } while (0)
#define PG8_MMA(ai, bj, At, Bt) do { __builtin_amdgcn_s_setprio(1); _Pragma("unroll") for (int m = 0; m < 4; ++m) _Pragma("unroll") for (int n = 0; n < 2; ++n) _Pragma("unroll") for (int k = 0; k < 2; ++k) \
        acc[ai][bj][m][n] = __builtin_amdgcn_mfma_f32_16x16x32_bf16(Bt[n][k], At[m][k], acc[ai][bj][m][n], 0, 0, 0); __builtin_amdgcn_s_setprio(0); } while (0)
#define PG8_WAIT_V(n) asm volatile("s_waitcnt vmcnt(" #n ")" ::: "memory")
#define PG8_WAIT_L(n) asm volatile("s_waitcnt lgkmcnt(" #n ")" ::: "memory")
#define PG8_BAR __builtin_amdgcn_s_barrier()
#define PG8_SCHED __builtin_amdgcn_sched_barrier(0)
#define PG8_APTR(u_) ((const char*)g.A + ((size_t)rowbase((u_).pm) * lda + (size_t)(u_).pn * g.acolstep) * 2)
#define PG8_BPTR(u_) ((const char*)g.Bt + (size_t)(u_).pn * tstepB)
    Unit cur, nxt; int ui = 0;
    if (!S.next(0, cur)) return;
    f32x4 acc[2][2][4][2];
#pragma unroll
    for (int a = 0; a < 2; ++a)
#pragma unroll
        for (int b = 0; b < 2; ++b)
#pragma unroll
            for (int m = 0; m < 4; ++m)
#pragma unroll
                for (int n = 0; n < 2; ++n) acc[a][b][m][n] = (f32x4){0.f, 0.f, 0.f, 0.f};
    bf16x8 At[4][2], B0[2][2], B1[2][2];
    const char* cA = PG8_APTR(cur); const char* cB = PG8_BPTR(cur);
    S.a_ready(cur);
    if constexpr (SP2) {
        PG8_STAGE(PG8_SB(0, 0), cB, voffB); PG8_STAGE(PG8_SB(0, 1), cB + hstepB, voffB); PG8_STAGE(PG8_SA(0, 0), cA, voffA); PG8_STAGE(PG8_SA(0, 1), cA + hstepA, voffA);
        if (wr == 1) PG8_BAR;
        PG8_WAIT_V(2); PG8_BAR;
        PG8_STAGE(PG8_SB(1, 0), cB + kstep, voffB); PG8_STAGE(PG8_SA(1, 0), cA + kstep, voffA); PG8_STAGE(PG8_SB(1, 1), cB + hstepB + kstep, voffB);
        PG8_WAIT_V(6); PG8_BAR;
    } else {
        PG8_STAGE(PG8_SB(0, 0), cB, voffB); PG8_STAGE(PG8_SA(0, 0), cA, voffA); PG8_STAGE(PG8_SB(0, 1), cB + hstepB, voffB); PG8_STAGE(PG8_SA(0, 1), cA + hstepA, voffA);
        if (wr == 1) PG8_BAR;
        PG8_WAIT_V(4); PG8_BAR;
        PG8_STAGE(PG8_SB(1, 0), cB + kstep, voffB); PG8_STAGE(PG8_SA(1, 0), cA + kstep, voffA); PG8_STAGE(PG8_SB(1, 1), cB + hstepB + kstep, voffB);
        PG8_WAIT_V(6); PG8_BAR;
    }
    for (;;) {
        const bool has_next = S.next(ui + 1, nxt);
        const char* nA = has_next ? PG8_APTR(nxt) : cA; const char* nB = has_next ? PG8_BPTR(nxt) : cB;
#pragma unroll 1
        for (int t = 0; t < nt; t += 2) {
            const bool last = (t == nt - 2);
            const char* a1 = cA + (size_t)(t + 1) * kstep;
            const char* a2 = last ? nA : cA + (size_t)(t + 2) * kstep; const char* b2 = last ? nB : cB + (size_t)(t + 2) * kstep;
            const char* a3 = a2 + kstep; const char* b3 = b2 + kstep;
            if (last && has_next) S.a_ready(nxt);
            if constexpr (SP2) {
            PG8_LDB(B0, 0, 0); PG8_LDB(B1, 0, 1); PG8_SCHED; PG8_LDA(At, 0, 0); PG8_STAGE(PG8_SA(1, 1), a1 + hstepA, voffA);
            PG8_WAIT_V(8); PG8_WAIT_L(0); PG8_BAR; PG8_MMA(0, 0, At, B0); PG8_MMA(0, 1, At, B1); PG8_BAR; PG8_SCHED;
            PG8_LDA(At, 0, 1); PG8_STAGE(PG8_SB(0, 0), b2, voffB); PG8_STAGE(PG8_SB(0, 1), b2 + hstepB, voffB); PG8_STAGE(PG8_SA(0, 0), a2, voffA);
            PG8_WAIT_V(8); PG8_WAIT_L(0); PG8_BAR; PG8_MMA(1, 0, At, B0); PG8_MMA(1, 1, At, B1); PG8_BAR; PG8_SCHED;
            PG8_LDB(B0, 1, 0); PG8_LDB(B1, 1, 1); PG8_SCHED; PG8_LDA(At, 1, 0); PG8_STAGE(PG8_SA(0, 1), a2 + hstepA, voffA);
            PG8_WAIT_V(8); PG8_WAIT_L(0); PG8_BAR; PG8_MMA(0, 0, At, B0); PG8_MMA(0, 1, At, B1); PG8_BAR; PG8_SCHED;
            PG8_LDA(At, 1, 1); PG8_STAGE(PG8_SB(1, 0), b3, voffB); PG8_STAGE(PG8_SB(1, 1), b3 + hstepB, voffB); PG8_STAGE(PG8_SA(1, 0), a3, voffA);
            PG8_WAIT_V(8); PG8_WAIT_L(0); PG8_BAR; PG8_MMA(1, 0, At, B0); PG8_MMA(1, 1, At, B1); PG8_BAR; PG8_SCHED;
            } else {
            PG8_LDB(B0, 0, 0); PG8_SCHED; PG8_LDA(At, 0, 0); PG8_STAGE(PG8_SA(1, 1), a1 + hstepA, voffA);
            PG8_WAIT_L(8); PG8_BAR; PG8_WAIT_L(0); PG8_MMA(0, 0, At, B0); PG8_BAR; PG8_SCHED;
            PG8_LDB(B1, 0, 1); PG8_STAGE(PG8_SB(0, 0), b2, voffB);
            PG8_BAR; PG8_WAIT_L(0); PG8_MMA(0, 1, At, B1); PG8_BAR;
            PG8_LDA(At, 0, 1); PG8_STAGE(PG8_SA(0, 0), a2, voffA);
            PG8_BAR; PG8_WAIT_L(0); PG8_MMA(1, 0, At, B0); PG8_BAR; PG8_SCHED;
            PG8_STAGE(PG8_SB(0, 1), b2 + hstepB, voffB);
            PG8_WAIT_V(6); PG8_BAR; PG8_MMA(1, 1, At, B1); PG8_BAR;
            PG8_LDB(B0, 1, 0); PG8_SCHED; PG8_LDA(At, 1, 0); PG8_STAGE(PG8_SA(0, 1), a2 + hstepA, voffA);
            PG8_WAIT_L(8); PG8_BAR; PG8_WAIT_L(0); PG8_MMA(0, 0, At, B0); PG8_BAR; PG8_SCHED;
            PG8_LDB(B1, 1, 1); PG8_STAGE(PG8_SB(1, 0), b3, voffB);
            PG8_BAR; PG8_WAIT_L(0); PG8_MMA(0, 1, At, B1); PG8_BAR;
            PG8_LDA(At, 1, 1); PG8_STAGE(PG8_SA(1, 0), a3, voffA);
            PG8_BAR; PG8_WAIT_L(0); PG8_MMA(1, 0, At, B0); PG8_BAR; PG8_SCHED;
            PG8_STAGE(PG8_SB(1, 1), b3 + hstepB, voffB);
            PG8_WAIT_V(6); PG8_BAR; PG8_MMA(1, 1, At, B1); PG8_BAR;
            }
        }
        if constexpr (ALIGN_EPI) { if (wr == 0) PG8_BAR; }
        if constexpr (!Epi::AFTER_DRAIN) { E(acc, cur, wr, wc, fr, fq); S.done(cur); }
        if (!has_next) break;
#pragma unroll
        for (int a = 0; a < 2; ++a)
#pragma unroll
            for (int b = 0; b < 2; ++b)
#pragma unroll
                for (int m = 0; m < 4; ++m)
#pragma unroll
                    for (int n = 0; n < 2; ++n) acc[a][b][m][n] = (f32x4){0.f, 0.f, 0.f, 0.f};
        cur = nxt; cA = nA; cB = nB; ++ui;
        if constexpr (ALIGN_EPI) { if (wr == 1) PG8_BAR; }
    }
    PG8_WAIT_V(0);
    if constexpr (!ALIGN_EPI) { if (wr == 0) PG8_BAR; }
    PG8_BAR;
    if constexpr (Epi::AFTER_DRAIN) { E.fused(acc, cur, wr, wc, fr, fq, lds, wid, lane); S.done(cur); }
#undef PG8_SA
#undef PG8_SB
#undef PG8_STAGE
#undef PG8_LDA
#undef PG8_LDB
#undef PG8_MMA
#undef PG8_WAIT_V
#undef PG8_WAIT_L
#undef PG8_BAR
#undef PG8_SCHED
#undef PG8_APTR
#undef PG8_BPTR
}
}
#define PG8_SP2 true
#define PG8_ALIGN true

__device__ __forceinline__ int fresh_lane_id() { unsigned m1 = ~0u; asm volatile("" : "+s"(m1)); return (int)__builtin_amdgcn_mbcnt_hi(m1, __builtin_amdgcn_mbcnt_lo(m1, 0u)); }
namespace attn {
using bf16x8 = __attribute__((ext_vector_type(8))) short;
using s16x4 = __attribute__((ext_vector_type(4))) short;
using f32x16 = __attribute__((ext_vector_type(16))) float;
using u32x4 = __attribute__((ext_vector_type(4))) unsigned;
constexpr int NW = 8, QBLK = 32, QB = 256, KVBLK = 64;
constexpr int KSLOT = 12288, VSLOT = 8192, NSLOT = 3;
constexpr int LDS_K = 0, LDS_V = NSLOT * KSLOT, LDS_WS = LDS_V + NSLOT * VSLOT, LDS_QF = LDS_WS + NW * 64 * 4, QF_BYTES = 6144, LDS_BYTES = LDS_QF + NW * QF_BYTES;
__device__ __forceinline__ int crow(int r, int hi) { return (r & 3) + 8 * (r >> 2) + 4 * hi; }
#define SBAR() __builtin_amdgcn_sched_barrier(0)
__device__ __forceinline__ void cmask(f32x16& p0, f32x16& p1, int jb, int qrel, int hi) {
    const float NEG = -INFINITY; const int kb = 64 * jb - NMETA + 4 * hi;
#pragma unroll
    for (int r = 0; r < 16; ++r) { const int kv = kb + (r & 3) + 8 * (r >> 2); if (kv > qrel) p0[r] = NEG; if (kv + 32 > qrel) p1[r] = NEG; }
}
__device__ __forceinline__ void glds16(const void* gsrc, unsigned lds_dst) { unsigned keep;
    asm volatile("s_mov_b32 %0, m0\n\ts_mov_b32 m0, %2\n\ts_nop 0\n\tglobal_load_lds_dwordx4 %1, off\n\ts_mov_b32 m0, %0" : "=&s"(keep) : "v"(gsrc), "s"(lds_dst) : "memory"); }
__device__ __forceinline__ float max3f(float a, float b, float c) { float r; asm("v_max3_f32 %0, %1, %2, %3" : "=v"(r) : "v"(a), "v"(b), "v"(c)); return r; }
__device__ __forceinline__ float max2f(float a, float b) { float r; asm("v_max_f32_e32 %0, %1, %2" : "=v"(r) : "v"(a), "v"(b)); return r; }
__device__ __forceinline__ float fadd_s(float a, float b) { float r; asm("v_add_f32_e32 %0, %1, %2" : "=v"(r) : "v"(a), "v"(b)); return r; }
__device__ __forceinline__ float fsub_s(float a, float b) { float r; asm("v_sub_f32_e32 %0, %1, %2" : "=v"(r) : "v"(a), "v"(b)); return r; }
typedef float f32x2_t __attribute__((ext_vector_type(2))); typedef __bf16 bf16x2_t __attribute__((ext_vector_type(2)));
__device__ __forceinline__ unsigned cvtpk_s(float lo, float hi) { f32x2_t v = {lo, hi}; bf16x2_t b = __builtin_convertvector(v, bf16x2_t); return __builtin_bit_cast(unsigned, b); }
template <int N> __device__ __forceinline__ void wait_bar() { asm volatile("s_waitcnt vmcnt(%0) lgkmcnt(0)\n\ts_barrier" :: "n"(N) : "memory"); }
#define WAITB(nk, nv) do { if (w2) wait_bar<2 * (nk) + (nv)>(); else wait_bar<(nk) + (nv)>(); } while (0)
typedef __attribute__((address_space(3))) const char* lds_cptr;
typedef short v4i16_t __attribute__((ext_vector_type(4)));
#define LDSV(p) (*(const __attribute__((address_space(3))) bf16x8*)(p))
__device__ __forceinline__ void kload12(bf16x8* kf, lds_cptr kp) {
#pragma unroll
    for (int j = 0; j < 6; ++j) { kf[2 * j] = LDSV(kp + j * 2048); kf[2 * j + 1] = LDSV(kp + j * 2048 + 512); }
}
__device__ __forceinline__ void kload2(bf16x8* kf, lds_cptr kp, int j) { kf[2 * j] = LDSV(kp + j * 2048); kf[2 * j + 1] = LDSV(kp + j * 2048 + 512); }
__device__ __forceinline__ s16x4 vtr(lds_cptr p) { return __builtin_bit_cast(s16x4, __builtin_amdgcn_ds_read_tr16_b64_v4i16((__attribute__((address_space(3))) v4i16_t*)p)); }
__device__ __forceinline__ float rowmax(const f32x16& p0, const f32x16& p1) {
    float a = max3f(p0[0], p0[1], p1[0]), b = max3f(p0[2], p0[3], p1[1]); a = max3f(a, p1[2], p1[3]);
#pragma unroll
    for (int r = 4; r < 16; r += 4) { a = max3f(a, p0[r], p0[r + 1]); b = max3f(b, p0[r + 2], p0[r + 3]); a = max3f(a, p1[r], p1[r + 1]); b = max3f(b, p1[r + 2], p1[r + 3]); }
    const float m = max2f(a, b);
    auto rr = __builtin_amdgcn_permlane32_swap(__float_as_uint(m), __float_as_uint(m), false, false);
    return max2f(__uint_as_float(rr[0]), __uint_as_float(rr[1]));
}
__device__ __forceinline__ void pv(f32x16* o, int vb, bf16x8 pa0, bf16x8 pa1, bf16x8 pa2, bf16x8 pa3) {
#pragma unroll
    for (int d0 = 0; d0 < 2; ++d0) { s16x4 lo[4], hi[4];
#pragma unroll
        for (int ks = 0; ks < 4; ++ks) {
            asm volatile("ds_read_b64_tr_b16 %0,%1 offset:%c2" : "=&v"(lo[ks]) : "v"(vb), "i"(d0 * 4096 + ks * 1024) : "memory");
            asm volatile("ds_read_b64_tr_b16 %0,%1 offset:%c2" : "=&v"(hi[ks]) : "v"(vb), "i"(d0 * 4096 + ks * 1024 + 512) : "memory"); }
        asm volatile("s_waitcnt lgkmcnt(0)" ::: "memory"); SBAR();
#define PK(k) (bf16x8){lo[k][0], lo[k][1], lo[k][2], lo[k][3], hi[k][0], hi[k][1], hi[k][2], hi[k][3]}
        o[d0] = __builtin_amdgcn_mfma_f32_32x32x16_bf16(pa0, PK(0), o[d0], 0, 0, 0);
        o[d0] = __builtin_amdgcn_mfma_f32_32x32x16_bf16(pa1, PK(1), o[d0], 0, 0, 0);
        o[d0] = __builtin_amdgcn_mfma_f32_32x32x16_bf16(pa2, PK(2), o[d0], 0, 0, 0);
        o[d0] = __builtin_amdgcn_mfma_f32_32x32x16_bf16(pa3, PK(3), o[d0], 0, 0, 0);
#undef PK
    }
}
template <int THRL> __device__ __forceinline__ void attn_unit(int b, int h, int qb, const bf16* Q, const bf16* __restrict__ K, const bf16* __restrict__ V, bf16* Y, char* shm, const int wid) {
    const int lane = fresh_lane_id(), r32 = lane & 31, hi = lane >> 5;
    const long krow0 = (long)b * L; const int q0 = NMETA + qb * QB;
    const bf16* Qw = Q + (krow0 + q0 + wid * QBLK) * QP + h * QKD;
    const bf16* Kh = K + krow0 * KP + h * QKD, *Vh = V + krow0 * VP + h * VD;
    const unsigned lds0 = (unsigned)(uintptr_t)shm;
    float* wsf = (float*)(shm + LDS_WS) + wid * 64;
    const bool w2 = wid < 4;
    const bf16* ksrc = Kh + (long)lane * KP + wid * 8;
    const bf16* vsrc = Vh + (long)(16 * (wid & 3) + (lane >> 2)) * VP + (wid >> 2) * 32 + (lane & 3) * 8;
    const unsigned kdst = lds0 + LDS_K + wid * 1024, vdst = lds0 + LDS_V + wid * 1024;
#define KS(sl) ((sl) + ((sl) >> 1))
#define DMA_K(t, sl) do { glds16(ksrc + (long)(t) * KVBLK * KP, (unsigned)__builtin_amdgcn_readfirstlane(kdst + KS(sl))); \
        if (w2) glds16(ksrc + 64 + (long)(t) * KVBLK * KP, (unsigned)__builtin_amdgcn_readfirstlane(kdst + 8192 + KS(sl))); } while (0)
#define DMA_V(t, sl) glds16(vsrc + (long)(t) * KVBLK * VP, (unsigned)__builtin_amdgcn_readfirstlane(vdst + (sl)))
    const int vb0 = (int)(lds0 + LDS_V) + ((lane >> 4) & 1) * 32 + (lane & 3) * 8 + (4 * hi + ((lane & 15) >> 2)) * 64;
    const char* Kbase = shm + LDS_K; bf16x8 kf[12];
    const lds_cptr shm3 = (lds_cptr)shm; const lds_cptr kp0 = shm3 + LDS_K + hi * 1024 + r32 * 16; const lds_cptr vp0 = shm3 + LDS_V + ((lane >> 4) & 1) * 32 + (lane & 3) * 8 + (4 * hi + ((lane & 15) >> 2)) * 64;
    const lds_cptr qfp = shm3 + LDS_QF + wid * QF_BYTES + lane * 16;
#define QF(d0) LDSV(qfp + (d0) * 1024)
    const int NT = 4 * qb + 6;
    DMA_K(0, 0); DMA_V(0, 0); DMA_K(1, VSLOT);
    {
        bf16x8 qt[6];
#pragma unroll
        for (int d0 = 0; d0 < 6; ++d0) qt[d0] = *(const GAS bf16x8*)(&Qw[(long)r32 * QP + d0 * 16 + hi * 8]);
#pragma unroll
        for (int d0 = 0; d0 < 6; ++d0) *(__attribute__((address_space(3))) bf16x8*)(shm3 + LDS_QF + wid * QF_BYTES + lane * 16 + d0 * 1024) = qt[d0];
    }
    float mhat = 0.f, l_reg = 0.f; f32x16 o[2]; o[0] = f32x16{}; o[1] = f32x16{}; f32x16 negm = f32x16{}; asm volatile("" : "+v"(negm));
    const int qrel = wid * QBLK + r32;
#define CMASK(P0, P1, t) do { int jb_ = (t) - (NT - 6); if (jb_ >= 0) cmask(P0, P1, jb_, qrel, hi); } while (0)
    bool resc = false;
#define START(P0, P1) do { const float rm = rowmax(P0, P1); resc = false; \
    { const float dl = rm; mhat = fadd_s(mhat, dl); \
      _Pragma("unroll") for (int r = 0; r < 16; ++r) { P0[r] = fsub_s(P0[r], dl); P1[r] = fsub_s(P1[r], dl); } \
      _Pragma("unroll") for (int r = 0; r < 16; ++r) negm[r] = -mhat; asm volatile("" : "+v"(negm)); } \
    _Pragma("unroll") for (int r = 0; r < 16; ++r) P0[r] = __builtin_amdgcn_exp2f(P0[r]); } while (0)
#define RESC() do { if (resc) { asm volatile("s_waitcnt lgkmcnt(0)" ::: "memory"); \
      _Pragma("unroll") for (int d_ = 0; d_ < 2; ++d_) _Pragma("unroll") for (int r = 0; r < 16; ++r) o[d_][r] *= wsf[crow(r, hi)]; } } while (0)
    f32x16 pA0, pA1, pB0, pB1;
    int sl_prev = 0, sl_cur = 0, sl_next = VSLOT;
#define ROT() do { sl_prev = sl_cur; sl_cur = sl_next; sl_next = (sl_next == (NSLOT - 1) * VSLOT) ? 0 : sl_next + VSLOT; } while (0)
    DMA_K(2, 2 * VSLOT);
    WAITB(2, 1);
    {
        const char* kb = Kbase + hi * 1024 + r32 * 16;
#pragma unroll
        for (int d0 = 0; d0 < 6; ++d0) { const bf16x8 b0 = *reinterpret_cast<const bf16x8*>(kb + d0 * 2048), b1 = *reinterpret_cast<const bf16x8*>(kb + d0 * 2048 + 512); const bf16x8 qv = QF(d0);
            if (d0 == 0) { pA0 = __builtin_amdgcn_mfma_f32_32x32x16_bf16(b0, qv, negm, 0, 0, 0); pA1 = __builtin_amdgcn_mfma_f32_32x32x16_bf16(b1, qv, negm, 0, 0, 0); }
            else { pA0 = __builtin_amdgcn_mfma_f32_32x32x16_bf16(b0, qv, pA0, 0, 0, 0); pA1 = __builtin_amdgcn_mfma_f32_32x32x16_bf16(b1, qv, pA1, 0, 0, 0); } }
    }
    asm volatile("s_nop 15\n\ts_nop 7" : "+v"(pA0), "+v"(pA1)); CMASK(pA0, pA1, 0);
    START(pA0, pA1);
    _Pragma("unroll") for (int r = 0; r < 16; ++r) pA1[r] = __builtin_amdgcn_exp2f(pA1[r]);
    WAITB(0, 0);
    DMA_K(3, 0); DMA_V(1, VSLOT);
    ROT();
    kload12(kf, kp0 + KS(sl_cur));
    WAITB(1, 1);
    s16x4 vlo[8], vhi[8]; u32x4 pw0, pw1, pw2, pw3; bf16x8 qa, qb_;
#define PKW(P, B) cvtpk_s(P[B], P[B + 1])
#define PAF(k) __builtin_bit_cast(bf16x8, pw##k)
#define VFR(i) (bf16x8){vlo[i][0], vlo[i][1], vlo[i][2], vlo[i][3], vhi[i][0], vhi[i][1], vhi[i][2], vhi[i][3]}
#define PIN(x) asm volatile("" : "+v"(x))
#define MX3(a, b, c) __builtin_fmaxf(__builtin_fmaxf((a), (b)), (c))
#define MF(c, a, b, cc) c = __builtin_amdgcn_mfma_f32_32x32x16_bf16(a, b, cc, 0, 0, 0)
#define GAPA(MFS, A0, A1, A2, A3, W0, W1, PW) do { MFS; sacc += A0; sacc += A1; sacc += A2; sacc += A3; PIN(sacc); W0; W1; PIN(PW); SBAR(); } while (0)
#define GAPM(MFS) do { MFS; SBAR(); } while (0)
#define EX(v) __builtin_amdgcn_exp2f(v)
#define GAPB(MFS, X, B) do { MFS; X[B] = EX(X[B]); X[B + 1] = EX(X[B + 1]); X[B + 2] = EX(X[B + 2]); X[B + 3] = EX(X[B + 3]); PIN(X); SBAR(); } while (0)
#define VRD(i) do { vlo[i] = vtr(vp_ + (((i) >> 2) * 4096 + ((i) & 3) * 1024)); vhi[i] = vtr(vp_ + (((i) >> 2) * 4096 + ((i) & 3) * 1024 + 512)); } while (0)
#define KRD(G, j) do { if (G) { kload2(kf, kp0 + KS(sl_next), j); SBAR(); } } while (0)
#define STEP(C0, C1, P0, P1, t, GK, GV, GL) do { SBAR(); \
    const lds_cptr vp_ = vp0 + sl_prev; \
    qa = QF(0); qb_ = QF(1); \
    VRD(0); SBAR(); float sacc = (P0[0] + P0[1]); \
    GAPA(MF(C0, kf[0], qa, negm), P0[2], P0[3], P0[4], P0[5],     pw0[0] = PKW(P0, 0), pw0[1] = PKW(P0, 2), pw0); \
    VRD(4); SBAR(); GAPA(MF(C1, kf[1], qa, negm), P0[6], P0[7], P0[8], P0[9],     pw0[2] = PKW(P0, 4), pw0[3] = PKW(P0, 6), pw0); \
    qa = QF(2); \
    VRD(1); SBAR(); GAPA(MF(C0, kf[2], qb_, C0),  P0[10], P0[11], P0[12], P0[13], pw1[0] = PKW(P0, 8), pw1[1] = PKW(P0, 10), pw1); \
    VRD(5); SBAR(); GAPA(MF(C1, kf[3], qb_, C1),  P0[14], P0[15], P1[0], P1[1],   pw1[2] = PKW(P0, 12), pw1[3] = PKW(P0, 14), pw1); \
    qb_ = QF(3); \
    VRD(2); SBAR(); GAPA(MF(C0, kf[4], qa, C0),   P1[2], P1[3], P1[4], P1[5],     pw2[0] = PKW(P1, 0), pw2[1] = PKW(P1, 2), pw2); \
    VRD(6); SBAR(); GAPA(MF(C1, kf[5], qa, C1),   P1[6], P1[7], P1[8], P1[9],     pw2[2] = PKW(P1, 4), pw2[3] = PKW(P1, 6), pw2); \
    qa = QF(4); \
    VRD(3); SBAR(); GAPA(MF(C0, kf[6], qb_, C0),  P1[10], P1[11], P1[12], P1[13], pw3[0] = PKW(P1, 8), pw3[1] = PKW(P1, 10), pw3); \
    VRD(7); SBAR(); GAPA(MF(C1, kf[7], qb_, C1),  P1[14], P1[15], 0.f, 0.f,       pw3[2] = PKW(P1, 12), pw3[3] = PKW(P1, 14), pw3); \
    qb_ = QF(5); \
    GAPM(MF(C0, kf[8], qa, C0)); GAPM(MF(C1, kf[9], qa, C1)); GAPM(MF(C0, kf[10], qb_, C0)); GAPM(MF(C1, kf[11], qb_, C1)); \
    l_reg += sacc; \
    if (GK) { DMA_K((t) + 3, sl_cur); } if (GV) { DMA_V((t) + 1, sl_next); } \
    CMASK(C0, C1, t); \
    { float a = MX3(C0[0], C0[1], C1[0]), b = MX3(C0[2], C0[3], C1[1]); a = MX3(a, C1[2], C1[3]); \
      _Pragma("unroll") for (int r = 4; r < 16; r += 4) { a = MX3(a, C0[r], C0[r + 1]); b = MX3(b, C0[r + 2], C0[r + 3]); a = MX3(a, C1[r], C1[r + 1]); b = MX3(b, C1[r + 2], C1[r + 3]); } \
      float rm = __builtin_fmaxf(a, b); { auto rr = __builtin_amdgcn_permlane32_swap(__float_as_uint(rm), __float_as_uint(rm), false, false); rm = __builtin_fmaxf(__uint_as_float(rr[0]), __uint_as_float(rr[1])); } \
      resc = false; \
      if (__builtin_expect(__any(rm > (float)THRL), 0)) { const float dl = __builtin_fmaxf(rm, 0.f); mhat += dl; \
        _Pragma("unroll") for (int r = 0; r < 16; ++r) { C0[r] -= dl; C1[r] -= dl; } \
        _Pragma("unroll") for (int r = 0; r < 16; ++r) negm[r] = -mhat; asm volatile("" : "+v"(negm)); \
        const float f = __builtin_amdgcn_exp2f(-dl); l_reg *= f; if (hi == 0) wsf[r32] = f; resc = true; } } \
    SBAR(); \
    GAPB(MF(o[0], PAF(0), VFR(0), o[0]), C0, 0); \
    KRD(GL, 0); GAPB(MF(o[1], PAF(0), VFR(4), o[1]), C0, 4); \
    KRD(GL, 1); GAPB(MF(o[0], PAF(1), VFR(1), o[0]), C0, 8); \
    KRD(GL, 2); GAPB(MF(o[1], PAF(1), VFR(5), o[1]), C0, 12); \
    KRD(GL, 3); GAPB(MF(o[0], PAF(2), VFR(2), o[0]), C1, 0); \
    KRD(GL, 4); GAPB(MF(o[1], PAF(2), VFR(6), o[1]), C1, 4); \
    KRD(GL, 5); GAPB(MF(o[0], PAF(3), VFR(3), o[0]), C1, 8); \
    GAPB(MF(o[1], PAF(3), VFR(7), o[1]), C1, 12); \
    } while (0)
    int t = 1;
#undef CMASK
#define CMASK(P0, P1, t) do {} while (0)
    for (; t + 7 < NT; t += 2) {
        STEP(pB0, pB1, pA0, pA1, t, true, true, true);     WAITB(1, 1); RESC(); ROT();
        STEP(pA0, pA1, pB0, pB1, t + 1, true, true, true); WAITB(1, 1); RESC(); ROT();
    }
#undef CMASK
#define CMASK(P0, P1, t) do { int jb_ = (t) - (NT - 6); if (jb_ >= 0) cmask(P0, P1, jb_, qrel, hi); } while (0)
#define ENDW(tt) do { if ((tt) + 3 < NT) { WAITB(1, 1); } else if ((tt) + 2 < NT) { WAITB(0, 1); } else { WAITB(0, 0); } } while (0)
    for (; t + 1 < NT; t += 2) {
        STEP(pB0, pB1, pA0, pA1, t, (t + 3 < NT), (t + 1 < NT), (t + 1 < NT));       ENDW(t);     RESC(); ROT();
        STEP(pA0, pA1, pB0, pB1, t + 1, (t + 4 < NT), (t + 2 < NT), (t + 2 < NT));   ENDW(t + 1); RESC(); ROT();
    }
    STEP(pB0, pB1, pA0, pA1, NT - 1, false, false, false); RESC();
    {
        float sacc = pB0[0] + pB0[1]; _Pragma("unroll") for (int r = 2; r < 16; ++r) sacc += pB0[r]; _Pragma("unroll") for (int r = 0; r < 16; ++r) sacc += pB1[r]; l_reg += sacc;
        pw0 = (u32x4){PKW(pB0, 0), PKW(pB0, 2), PKW(pB0, 4), PKW(pB0, 6)}; pw1 = (u32x4){PKW(pB0, 8), PKW(pB0, 10), PKW(pB0, 12), PKW(pB0, 14)};
        pw2 = (u32x4){PKW(pB1, 0), PKW(pB1, 2), PKW(pB1, 4), PKW(pB1, 6)}; pw3 = (u32x4){PKW(pB1, 8), PKW(pB1, 10), PKW(pB1, 12), PKW(pB1, 14)};
        SBAR(); pv(o, vb0 + sl_cur, PAF(0), PAF(1), PAF(2), PAF(3));
    }
#undef PKW
#undef PAF
#undef VFR
#undef PIN
#undef MX3
#undef MF
#undef GAPA
#undef GAPM
#undef GAPB
#undef EX
#undef VRD
#undef KRD
#undef STEP
#undef ENDW
    { auto rr = __builtin_amdgcn_permlane32_swap(__float_as_uint(l_reg), __float_as_uint(l_reg), false, false); l_reg = __uint_as_float(rr[0]) + __uint_as_float(rr[1]); }
    if (hi == 0) wsf[32 + r32] = l_reg; asm volatile("s_waitcnt lgkmcnt(0)" ::: "memory");
    float rli[16];
#pragma unroll
    for (int r = 0; r < 16; ++r) rli[r] = __builtin_amdgcn_rcpf(wsf[32 + crow(r, hi)]);
    bf16* Ow = Y + (krow0 + q0 + wid * QBLK) * YP + POOLW + h * VD;
    { bf16* stg = (bf16*)(shm + LDS_QF + wid * QF_BYTES);
#pragma unroll
      for (int r = 0; r < 16; ++r) { const int orow = crow(r, hi);
#pragma unroll
          for (int d0 = 0; d0 < 2; ++d0) stg[orow * 64 + d0 * 32 + r32] = f2bf(o[d0][r] * rli[r]); }
      asm volatile("s_waitcnt lgkmcnt(0)" ::: "memory");
#pragma unroll
      for (int i = 0; i < 4; ++i) { const int row = i * 8 + (lane >> 3), ch = lane & 7; const u32x4 v = *(const u32x4*)(stg + row * 64 + ch * 8); *(GAS u32x4*)(Ow + (long)row * YP + ch * 8) = v; } }
    asm volatile("s_waitcnt lgkmcnt(0)\n\ts_barrier" ::: "memory");
#undef DMA_K
#undef DMA_V
#undef KS
#undef QF
#undef CMASK
#undef START
#undef RESC
#undef ROT
}
#undef SBAR
#undef WAITB
#undef LDSV
}

constexpr int NWAVES = 8;
constexpr int NPHASE = 1 + 6 * DEPTH;
constexpr int CW_TMO = 0, CW_CODE = 1, CW_BAR = 4096;
constexpr int RING_OFF = 0, RING_BYTES = 131072, LDSCTL_OFF = RING_BYTES, MISC_OFF = LDSCTL_OFF + 320, LDS_BYTES = 147456;
typedef unsigned v4u __attribute__((ext_vector_type(4)));
typedef float f32x4 __attribute__((ext_vector_type(4)));
typedef GAS unsigned gu32;
#define RLX_AGENT __ATOMIC_RELAXED, __HIP_MEMORY_SCOPE_AGENT
#define LDS_WAIT() asm volatile("s_waitcnt lgkmcnt(0)" ::: "memory")
#define VM_WAIT() asm volatile("s_waitcnt vmcnt(0)" ::: "memory")
__device__ __forceinline__ unsigned pk2(float lo, float hi) { return (unsigned)f2bf(lo) | ((unsigned)f2bf(hi) << 16); }

#define XB_TMO      128
#define XB_XCNT(j)  (256  + 64 * (j))
#define XB_XSUB(j)  (1280 + 64 * (j))
#define XB_XGEN(j)  (2304 + 64 * (j))
#define XB_TOP      3328
#define XB_TOPGEN   3392
#define XCD_BAR_WORDS 3456
#define XB_SPIN_CAP (1u << 18)
__device__ __forceinline__ unsigned xb_ld(unsigned* p)              { return __hip_atomic_load((GAS unsigned*)p, __ATOMIC_RELAXED, __HIP_MEMORY_SCOPE_AGENT); }
__device__ __forceinline__ unsigned xb_add(unsigned* p, unsigned v) { return __hip_atomic_fetch_add((GAS unsigned*)p, v, __ATOMIC_RELAXED, __HIP_MEMORY_SCOPE_AGENT); }
__device__ __forceinline__ unsigned xb_xcc_id() { return (unsigned)__builtin_amdgcn_s_getreg((3 << 11) | 20) & 0xFu; }
#define XB_SPIN(cond, bar) do { unsigned _sp = 0; while (cond) { __builtin_amdgcn_s_sleep(1); \
    if ((++_sp & 255u) == 0u) { if (xb_ld(&(bar)[XB_TMO])) break; if (_sp > XB_SPIN_CAP) { xb_add(&(bar)[XB_TMO], 1u); break; } } } } while (0)
struct XcdBarrier { unsigned* bar; unsigned x; volatile LAS unsigned* st; };
__device__ __forceinline__ XcdBarrier xcd_barrier_post(unsigned* bar, volatile LAS unsigned* st) {
    XcdBarrier b; b.bar = bar; b.x = xb_xcc_id(); b.st = st;
    if (threadIdx.x == 0) (void)xb_add(&bar[XB_XCNT(b.x)], 1u);
    return b;
}
__device__ __forceinline__ void xcd_barrier_complete(unsigned* bar, unsigned x, unsigned& nloc, unsigned& nx) {
    const unsigned G = gridDim.x * gridDim.y * gridDim.z;
    unsigned sum, cnt, mine, sp = 0u;
    for (;;) {
        sum = 0u; cnt = 0u; mine = 0u;
#pragma unroll
        for (unsigned j = 0; j < 16; ++j) { const unsigned c = xb_ld(&bar[XB_XCNT(j)]); sum += c; cnt += (c > 0u) ? 1u : 0u; mine = (j == x) ? c : mine; }
        if (sum == G) break;
        __builtin_amdgcn_s_sleep(1);
        if ((++sp & 255u) == 0u) { if (xb_ld(&bar[XB_TMO])) break; if (sp > XB_SPIN_CAP) { xb_add(&bar[XB_TMO], 1u); break; } }
    }
    nloc = mine > 0u ? mine : 1u; nx = cnt > 0u ? cnt : 1u;
}
__device__ __forceinline__ void xcd_barrier(const XcdBarrier& b) {
    asm volatile("s_waitcnt vmcnt(0)" ::: "memory");
    __syncthreads();
    if (threadIdx.x == 0) {
        unsigned* bar = b.bar; unsigned bx = b.x; asm volatile("" : "+s"(bar), "+s"(bx));
        __builtin_amdgcn_s_waitcnt(0);
        unsigned nloc = b.st[0], nx = b.st[1];
        if (nloc == 0u) { xcd_barrier_complete(bar, bx, nloc, nx); b.st[0] = nloc; b.st[1] = nx; }
        const unsigned old = xb_add(&bar[XB_XSUB(bx)], 1u);
        const unsigned gen = old / nloc;
        if (old + 1u == (gen + 1u) * nloc) {
            __builtin_amdgcn_fence(__ATOMIC_RELEASE, "agent");
            asm volatile("s_waitcnt vmcnt(0)" ::: "memory");
            const unsigned og = xb_add(&bar[XB_TOP], 1u);
            const unsigned tg = og / nx;
            if (og + 1u == (tg + 1u) * nx) xb_add(&bar[XB_TOPGEN], 1u);
            else XB_SPIN(xb_ld(&bar[XB_TOPGEN]) == tg, bar);
            __builtin_amdgcn_fence(__ATOMIC_ACQUIRE, "agent");
            xb_add(&bar[XB_XGEN(bx)], 1u);
            asm volatile("s_waitcnt vmcnt(0)" ::: "memory");
        } else {
            XB_SPIN(xb_ld(&bar[XB_XGEN(bx)]) == gen, bar);
            __builtin_amdgcn_fence(__ATOMIC_ACQUIRE, "agent");
            asm volatile("s_waitcnt vmcnt(0)" ::: "memory");
        }
    }
    __syncthreads();
}

struct Frame {
    LAS unsigned char* lds; volatile LAS unsigned* MISC; gu32* ctl;
    int wave, vcu, G;
    const P& p;
    __device__ __forceinline__ int lane() const { return fresh_lane_id(); }
    __device__ __forceinline__ int tid() const { return wave * 64 + fresh_lane_id(); }
};
__device__ __forceinline__ float wave_sum(float v) {
#pragma unroll
    for (int o = 1; o < 64; o <<= 1) v += __shfl_xor(v, o);
    return v;
}
__device__ __forceinline__ void transpose_item(const float* W, int ldw, int k0, int n0, bf16* dst, int ldt, LAS float* scr, int lane) {
#pragma unroll 8
    for (int i = 0; i < 32; ++i) { const int kk = 2 * i + (lane >> 5); scr[kk * 33 + (lane & 31)] = W[(size_t)(k0 + kk) * ldw + n0 + (lane & 31)]; }
    LDS_WAIT(); asm volatile("" ::: "memory");
    const int c = lane & 7;
#pragma unroll
    for (int j = 0; j < 4; ++j) { const int n = (lane >> 3) + 8 * j; const LAS float* s = scr + (8 * c) * 33 + n;
        v4u o; o.x = pk2(s[0 * 33], s[1 * 33]); o.y = pk2(s[2 * 33], s[3 * 33]); o.z = pk2(s[4 * 33], s[5 * 33]); o.w = pk2(s[6 * 33], s[7 * 33]);
        *(GAS v4u*)(dst + (size_t)n * ldt + 8 * c) = o; }
    LDS_WAIT(); asm volatile("" ::: "memory");
}
__device__ __forceinline__ int rowmap_q(int n0)  { const int head = n0 / 96, e0 = n0 % 96; return e0 < 64 ? 256 * (head >> 2) + 128 * (e0 >> 5) + 32 * (head & 3) : 512 + 128 * (head >> 2) + 32 * (head & 3); }
__device__ __forceinline__ int rowmap_kv(int n0) { const int head = n0 >> 7, e0 = n0 & 127; return e0 < 64 ? 256 * (head >> 2) + 128 * (e0 >> 5) + 32 * (head & 3) : 512 + 256 * (head >> 2) + 128 * ((e0 - 64) >> 5) + 32 * (head & 3); }
constexpr int IT_IN = 16 * 37, IT_Q = 6 * 24, IT_KV = 4 * 32, IT_P = 4 * 8, IT_OUT = 16 * 32, IT_G = 16 * 88, IT_D = 44 * 32;
constexpr int IT_LAYER = IT_IN + IT_Q + IT_KV + IT_P + IT_OUT + 2 * IT_G + IT_D;
__device__ __forceinline__ void p0_prologue(Frame& F) {
    const P& p = F.p;
    LAS float* scr = (LAS float*)(F.lds + RING_OFF + F.wave * 16384);
    const int gw = F.vcu * NWAVES + F.wave, NGW = F.G * NWAVES, lane = F.lane();
    for (int it = gw; it < DEPTH * IT_LAYER; it += NGW) {
        const int l = it / IT_LAYER; int r = it % IT_LAYER; unsigned char* wl = p.ws + WS_W + (size_t)l * WL_BYTES;
        if (r < IT_IN) { const int kb = r / 37, nb = r % 37; transpose_item(p.w_in + (size_t)l * D * INW, INW, 64 * kb, 32 * nb, (bf16*)(wl + WO_IN) + (size_t)(32 * nb) * D + 64 * kb, D, scr, lane); continue; } r -= IT_IN;
        if (r < IT_Q) { const int kb = r / 24, nb = r % 24; transpose_item(p.w_q_b + (size_t)l * QLR * 768, 768, 64 * kb, 32 * nb, (bf16*)(wl + WO_Q) + (size_t)rowmap_q(32 * nb) * QLR + 64 * kb, QLR, scr, lane); continue; } r -= IT_Q;
        if (r < IT_KV) { const int kb = r / 32, nb = r % 32; transpose_item(p.w_kv_b + (size_t)l * KVLR * 1024, 1024, 64 * kb, 32 * nb, (bf16*)(wl + WO_KV) + (size_t)rowmap_kv(32 * nb) * KVLR + 64 * kb, KVLR, scr, lane); continue; } r -= IT_KV;
        if (r < IT_P) { const int g = r >> 3, kb = (r >> 2) & 1, nb = r & 3; transpose_item(p.w_pool + ((size_t)l * 4 + g) * 128 * 128, 128, 64 * kb, 32 * nb, (bf16*)(wl + WO_P) + (size_t)(g * 128 + 32 * nb) * 128 + 64 * kb, 128, scr, lane); continue; } r -= IT_P;
        if (r < IT_OUT) { const int kb = r / 32, nb = r % 32; transpose_item(p.w_out + (size_t)l * D * D, D, 64 * kb, 32 * nb, (bf16*)(wl + WO_OUT) + (size_t)(32 * nb) * D + 64 * kb, D, scr, lane); continue; } r -= IT_OUT;
        if (r < 2 * IT_G) { const int up = r >= IT_G; if (up) r -= IT_G; const int kb = r / 88, nb = r % 88, f0 = 32 * nb;
            transpose_item((up ? p.w_up : p.w_gate) + (size_t)l * D * FF, FF, 64 * kb, f0, (bf16*)(wl + WO_GU) + (size_t)(256 * (f0 >> 7) + 128 * up + (f0 & 127)) * D + 64 * kb, D, scr, lane); continue; } r -= 2 * IT_G;
        { const int kb = r / 32, nb = r % 32; transpose_item(p.w_down + (size_t)l * FF * D, D, 64 * kb, 32 * nb, (bf16*)(wl + WO_D) + (size_t)(32 * nb) * FF + 64 * kb, FF, scr, lane); }
    }
    { const int gt = gw * 64 + lane, NGT = NGW * 64; const v4u z4 = {0u, 0u, 0u, 0u};
      for (int i = gt; i < DEPTH * 96 * D / 8; i += NGT) { const int l = i / (96 * D / 8), o = i % (96 * D / 8); *((GAS v4u*)(p.ws + WS_W + (size_t)l * WL_BYTES + WO_IN + (size_t)INW * D * 2) + o) = z4; }
      for (int i = gt; i < 256 * KP / 8; i += NGT) *((GAS v4u*)(p.ws + WS_K + (size_t)R * KP * 2) + i) = z4;
      for (int i = gt; i < 256 * VP / 8; i += NGT) *((GAS v4u*)(p.ws + WS_V + (size_t)R * VP * 2) + i) = z4;
      for (int i = gt; i < L * 16; i += NGT) { const int pos = i >> 4, j = i & 15; const float inv = 1.0f / powf(10000.0f, (float)(2 * j) / 32.0f); const float ang = (float)pos * inv;
          float* t = (float*)(p.ws + WS_ROPE) + (size_t)pos * 32; t[j] = cosf(ang); t[16 + j] = sinf(ang); } }
    for (int i = gw * 64 + lane; i < NMETA * D; i += NGW * 64) ((GAS float*)(p.ws + WS_MINI + MN_HM))[i] = p.meta[i];
    for (int m = gw; m < MR; m += NGW) {
        const int krow = rowbase(m >> 8) + (m & 255);
        const GAS f32x4* xr = (const GAS f32x4*)(p.x + (size_t)m * D) + lane; const f32x4* gr = (const f32x4*)p.attn_g + lane;
        f32x4 v[4]; float s = 0.f;
#pragma unroll
        for (int j = 0; j < 4; ++j) { v[j] = xr[64 * j]; s += (v[j].x * v[j].x + v[j].y * v[j].y) + (v[j].z * v[j].z + v[j].w * v[j].w); }
        s = wave_sum(s);
        GAS unsigned long long* o8 = (GAS unsigned long long*)(p.ws + WS_XN + (size_t)krow * D * 2) + lane;
#pragma unroll
        for (int j = 0; j < 4; ++j) { const f32x4 g = gr[64 * j]; o8[64 * j] = (unsigned long long)pk2(v[j].x * g.x, v[j].y * g.y) | ((unsigned long long)pk2(v[j].z * g.z, v[j].w * g.w) << 32); }
        if (lane == 0) *(GAS f32x4*)(p.ws + WS_SSQH + (size_t)krow * 16) = (f32x4){s, 0.f, 0.f, 0.f};
    }
}

__device__ __forceinline__ void krope_row(unsigned char* ws, const float* kn, int m) {
    const int krow = rowbase(m >> 8) + (m & 255), pos = NMETA + (((m >> 8) & 15) << 8) + (m & 255);
    const GAS v4u* zr = (const GAS v4u*)(ws + WS_Z + ((size_t)krow * ZP + POOLW + QLR + KVLR) * 2);
    const float r2 = rsqrtf(((const GAS float*)(ws + WS_SSQZ))[(size_t)krow * SZ + 36] * (1.0f / ROPE) + EPS);
    const GAS float* t = (const GAS float*)(ws + WS_ROPE) + (size_t)pos * 32;
    float x[32];
#pragma unroll
    for (int i = 0; i < 4; ++i) { const v4u w = zr[i];
#pragma unroll
        for (int e = 0; e < 4; ++e) { const unsigned ww = w[e]; x[8 * i + 2 * e] = __uint_as_float(ww << 16) * r2 * kn[8 * i + 2 * e]; x[8 * i + 2 * e + 1] = __uint_as_float(ww & 0xffff0000u) * r2 * kn[8 * i + 2 * e + 1]; } }
    float o[32];
#pragma unroll
    for (int j = 0; j < 16; ++j) { const float c = t[j], sn = t[16 + j]; o[j] = x[j] * c - x[16 + j] * sn; o[16 + j] = x[j] * sn + x[16 + j] * c; }
    v4u ow[4];
#pragma unroll
    for (int i = 0; i < 4; ++i) { ow[i].x = pk2(o[8 * i], o[8 * i + 1]); ow[i].y = pk2(o[8 * i + 2], o[8 * i + 3]); ow[i].z = pk2(o[8 * i + 4], o[8 * i + 5]); ow[i].w = pk2(o[8 * i + 6], o[8 * i + 7]); }
#pragma unroll
    for (int h = 0; h < NH; ++h) { GAS v4u* kp = (GAS v4u*)(ws + WS_K + ((size_t)krow * KP + h * QKD + NOPE) * 2);
#pragma unroll
        for (int i = 0; i < 4; ++i) kp[i] = ow[i]; }
}
typedef short bf16x8_t __attribute__((ext_vector_type(8)));
typedef float f32x16 __attribute__((ext_vector_type(16)));
constexpr int PU_PITCH = 272, PU_B = 272 * PU_PITCH;
__device__ __forceinline__ void pool_unit(LAS unsigned char* lds, unsigned char* ws, unsigned char* wl, const float* pscale, const int wid, int pm, int g) {
    const int lane = fresh_lane_id(), tid = wid * 64 + lane, r32 = lane & 31, hi = lane >> 5;
    const int krow0 = rowbase(pm), w = 2 << g;
    const GAS unsigned char* zb = (const GAS unsigned char*)(ws + WS_Z) + ((size_t)(krow0 - 16) * ZP + 128 * g) * 2;
    for (int i = tid; i < 272 * 16; i += NWAVES * 64) { const int row = i >> 4, ch = i & 15; *(LAS v4u*)(lds + row * PU_PITCH + ch * 16) = *(const GAS v4u*)(zb + (size_t)row * ZP * 2 + ch * 16); }
    const GAS unsigned char* wb = (const GAS unsigned char*)(wl + WO_P) + (size_t)g * 128 * 128 * 2;
    for (int i = tid; i < 128 * 16; i += NWAVES * 64) { const int n = i >> 4, ch = i & 15; *(LAS v4u*)(lds + PU_B + n * PU_PITCH + ch * 16) = *(const GAS v4u*)(wb + (size_t)n * 256 + ch * 16); }
    __syncthreads();
    {
        const float invw = 1.0f / (float)w; float s0 = 0.f, s1 = 0.f;
        const LAS unsigned* ub = (const LAS unsigned*)(lds + (16 + 32 * wid) * PU_PITCH) + lane;
#pragma unroll 1
        for (int i = 1; i < w; ++i) { const unsigned uu = ub[-(i * (PU_PITCH / 4))]; s0 += __uint_as_float(uu << 16); s1 += __uint_as_float(uu & 0xffff0000u); }
        unsigned pk[32];
#pragma unroll
        for (int j = 0; j < 32; ++j) { const unsigned uu = ub[j * (PU_PITCH / 4)]; const float a0 = __uint_as_float(uu << 16), a1 = __uint_as_float(uu & 0xffff0000u);
            s0 += a0; s1 += a1; pk[j] = pk2(s0 * invw - a0, s1 * invw - a1);
            const unsigned uo = ub[(j - (w - 1)) * (PU_PITCH / 4)]; s0 -= __uint_as_float(uo << 16); s1 -= __uint_as_float(uo & 0xffff0000u); }
        __syncthreads();
        LAS unsigned* uw = (LAS unsigned*)(lds + (16 + 32 * wid) * PU_PITCH) + lane;
#pragma unroll
        for (int j = 0; j < 32; ++j) uw[j * (PU_PITCH / 4)] = pk[j];
    }
    __syncthreads();
    f32x16 acc[4];
#pragma unroll
    for (int nb = 0; nb < 4; ++nb)
#pragma unroll
        for (int r = 0; r < 16; ++r) acc[nb][r] = 0.f;
    const LAS unsigned char* pa = lds + (16 + 32 * wid + r32) * PU_PITCH + hi * 16; const LAS unsigned char* wa = lds + PU_B + r32 * PU_PITCH + hi * 16;
#pragma unroll
    for (int s = 0; s < 8; ++s) { const bf16x8_t bfr = *(const LAS bf16x8_t*)(pa + s * 32);
#pragma unroll
        for (int nb = 0; nb < 4; ++nb) { const bf16x8_t afr = *(const LAS bf16x8_t*)(wa + nb * 32 * PU_PITCH + s * 32); acc[nb] = __builtin_amdgcn_mfma_f32_32x32x16_bf16(afr, bfr, acc[nb], 0, 0, 0); } }
    const float* ps = pscale + 128 * g + 4 * hi;
    GAS unsigned char* yb = (GAS unsigned char*)(ws + WS_Y) + ((size_t)(krow0 + 32 * wid + r32) * YP + 128 * g + 4 * hi) * 2;
#pragma unroll
    for (int nb = 0; nb < 4; ++nb)
#pragma unroll
        for (int k4 = 0; k4 < 4; ++k4) { const f32x4 sc = *(const f32x4*)(ps + 32 * nb + 8 * k4);
            pg8::u32x2 o; o.x = pk2(acc[nb][4 * k4] * sc[0], acc[nb][4 * k4 + 1] * sc[1]); o.y = pk2(acc[nb][4 * k4 + 2] * sc[2], acc[nb][4 * k4 + 3] * sc[3]);
            *(GAS pg8::u32x2*)(yb + (32 * nb + 8 * k4) * 2) = o; }
    __syncthreads();
}

namespace mini {
typedef short bf16x8 __attribute__((ext_vector_type(8)));
typedef float f32x4 __attribute__((ext_vector_type(4)));
__device__ __forceinline__ float hs4(f32x4 v) { return (v[0] * v[0] + v[1] * v[1]) + (v[2] * v[2] + v[3] * v[3]); }
__device__ __forceinline__ bf16x8 pack8(f32x4 a0, f32x4 a1) { v4u w; w.x = pk2(a0[0], a0[1]); w.y = pk2(a0[2], a0[3]); w.z = pk2(a1[0], a1[1]); w.w = pk2(a1[2], a1[3]); return __builtin_bit_cast(bf16x8, w); }
template <int NB> __device__ __forceinline__ void acc_steps(const GAS float* A, int lda, const float* gain, const GAS bf16* const (&Bt)[NB], int ldb, int K, int s0, int sstep, int lane, f32x4 (&acc)[NB], float& ssq) {
    const int r = lane & 15, q = lane >> 4;
    for (int s_ = s0; s_ < K / 32; s_ += sstep) { const int k = 32 * s_ + 8 * q;
        f32x4 a0 = *(const GAS f32x4*)(A + (size_t)r * lda + k), a1 = *(const GAS f32x4*)(A + (size_t)r * lda + k + 4);
        ssq += hs4(a0) + hs4(a1);
        if (gain) { a0 = a0 * *(const f32x4*)(gain + k); a1 = a1 * *(const f32x4*)(gain + k + 4); }
        const bf16x8 af = pack8(a0, a1);
#pragma unroll
        for (int nb = 0; nb < NB; ++nb) { const bf16x8 bfr = *(const GAS bf16x8*)(Bt[nb] + (size_t)r * ldb + k); acc[nb] = __builtin_amdgcn_mfma_f32_16x16x32_bf16(af, bfr, acc[nb], 0, 0, 0); } }
}
template <int NB, bool NORM> __device__ __forceinline__ void chunk_wg(LAS unsigned char* lds, const GAS float* A, int lda, const float* gain, const GAS bf16* const (&Bt)[NB], int ldb, int K, int wid, int lane, f32x4 (&out)[NB]) {
    f32x4 acc[NB]; float ssq = 0.f;
#pragma unroll
    for (int nb = 0; nb < NB; ++nb) acc[nb] = (f32x4){0.f, 0.f, 0.f, 0.f};
    acc_steps<NB>(A, lda, gain, Bt, ldb, K, wid, 8, lane, acc, ssq);
    LAS f32x4* red = (LAS f32x4*)lds; LAS float* sq = (LAS float*)(lds + 8 * NB * 64 * 16);
#pragma unroll
    for (int nb = 0; nb < NB; ++nb) red[(wid * NB + nb) * 64 + lane] = acc[nb];
    sq[wid * 64 + lane] = ssq;
    __syncthreads();
    if (wid == 0) {
#pragma unroll
        for (int nb = 0; nb < NB; ++nb) { f32x4 t = red[nb * 64 + lane];
#pragma unroll
            for (int w = 1; w < 8; ++w) t = t + red[(w * NB + nb) * 64 + lane];
            out[nb] = t; }
        if (NORM) { float tot = 0.f;
#pragma unroll
            for (int w = 0; w < 8; ++w)
#pragma unroll
                for (int qq = 0; qq < 4; ++qq) tot += sq[w * 64 + (lane & 15) + 16 * qq];
            const float rs = rsqrtf(tot / (float)K + EPS);
#pragma unroll
            for (int reg = 0; reg < 4; ++reg) { const float rr = __shfl(rs, 4 * (lane >> 4) + reg);
#pragma unroll
                for (int nb = 0; nb < NB; ++nb) out[nb][reg] *= rr; } }
    }
    __syncthreads();
}
__device__ __forceinline__ void p1_chunk(LAS unsigned char* lds, unsigned char* ws, unsigned char* wl, const float* attn_g, int chunk, int wid, int lane) {
    const GAS float* HM = (const GAS float*)(ws + WS_MINI + MN_HM); GAS float* ZM = (GAS float*)(ws + WS_MINI + MN_ZM);
    const GAS bf16* const Bt[1] = {(const GAS bf16*)(wl + WO_IN) + (size_t)(16 * chunk) * D}; f32x4 o[1];
    chunk_wg<1, true>(lds, HM, D, attn_g, Bt, D, D, wid, lane, o);
    if (wid == 0) { const int col = 16 * chunk + (lane & 15);
#pragma unroll
        for (int reg = 0; reg < 4; ++reg) { const int r = 4 * (lane >> 4) + reg; ZM[(size_t)r * INW + col] = o[0][reg];
            if (col < POOLW) { const bf16 zb = f2bf(o[0][reg]);
#pragma unroll
                for (int b = 0; b < BATCH; ++b) ((GAS bf16*)(ws + WS_Z))[(size_t)(b * L + r) * ZP + col] = zb; } } }
}
__device__ __forceinline__ void res_chunk(LAS unsigned char* lds, unsigned char* ws, const GAS float* A, int K, const GAS bf16* Btw, int chunk, int wid, int lane) {
    GAS float* HM = (GAS float*)(ws + WS_MINI + MN_HM);
    const GAS bf16* const Bt[1] = {Btw + (size_t)(16 * chunk) * K}; f32x4 o[1];
    chunk_wg<1, false>(lds, A, K, nullptr, Bt, K, K, wid, lane, o);
    if (wid == 0) { const int col = 16 * chunk + (lane & 15);
#pragma unroll
        for (int reg = 0; reg < 4; ++reg) { const int r = 4 * (lane >> 4) + reg; HM[(size_t)r * D + col] += o[0][reg]; } }
}
__device__ __forceinline__ void ffn_chunk(LAS unsigned char* lds, unsigned char* ws, unsigned char* wl, const float* ffn_g, int chunk, int wid, int lane) {
    const GAS float* HM = (const GAS float*)(ws + WS_MINI + MN_HM); GAS float* AM = (GAS float*)(ws + WS_MINI + MN_ACT);
    const int f0 = 16 * chunk, row0 = 256 * (f0 >> 7) + (f0 & 127);
    const GAS bf16* const Bt[2] = {(const GAS bf16*)(wl + WO_GU) + (size_t)row0 * D, (const GAS bf16*)(wl + WO_GU) + (size_t)(row0 + 128) * D}; f32x4 o[2];
    chunk_wg<2, true>(lds, HM, D, ffn_g, Bt, D, D, wid, lane, o);
    if (wid == 0) { const int col = f0 + (lane & 15);
#pragma unroll
        for (int reg = 0; reg < 4; ++reg) { const int r = 4 * (lane >> 4) + reg; const float g = o[0][reg]; AM[(size_t)r * FF + col] = g / (1.0f + __expf(-g)) * o[1][reg]; } }
}
__device__ __forceinline__ void head_task(LAS unsigned char* lds, unsigned char* ws, unsigned char* wl, const float* qa, const float* kva, const float* qn, const float* kn, int h, bool need_q, int wid, int lane) {
    const GAS float* ZM = (const GAS float*)(ws + WS_MINI + MN_ZM); const GAS float* rope = (const GAS float*)(ws + WS_ROPE);
    LAS float* QT = (LAS float*)lds; LAS float* KVT = QT + 16 * 96; LAS float* KR = KVT + 16 * 128; LAS float* ST = KR + 16 * 32; LAS float* S = ST + 64;
    const int tid = wid * 64 + lane, r = lane & 15, q = lane >> 4;
    if (need_q && wid < 6) {
        const int e0 = 16 * wid, drow = e0 < 64 ? 256 * (h >> 2) + 128 * (e0 >> 5) + 32 * (h & 3) + (e0 & 31) : 512 + 128 * (h >> 2) + 32 * (h & 3) + (e0 - 64);
        const GAS bf16* const Bt[1] = {(const GAS bf16*)(wl + WO_Q) + (size_t)drow * QLR}; f32x4 acc[1] = {(f32x4){0.f, 0.f, 0.f, 0.f}}; float ssq = 0.f;
        acc_steps<1>(ZM + POOLW, INW, qa, Bt, QLR, QLR, 0, 1, lane, acc, ssq);
        ssq += __shfl_xor(ssq, 16); ssq += __shfl_xor(ssq, 32); const float rs = rsqrtf(ssq / (float)QLR + EPS);
#pragma unroll
        for (int reg = 0; reg < 4; ++reg) QT[(4 * q + reg) * 96 + e0 + r] = acc[0][reg] * __shfl(rs, 4 * q + reg);
    }
    {
        const int e0 = 16 * wid, drow = e0 < 64 ? 256 * (h >> 2) + 128 * (e0 >> 5) + 32 * (h & 3) + (e0 & 31) : 512 + 256 * (h >> 2) + 128 * ((e0 - 64) >> 5) + 32 * (h & 3) + ((e0 - 64) & 31);
        const GAS bf16* const Bt[1] = {(const GAS bf16*)(wl + WO_KV) + (size_t)drow * KVLR}; f32x4 acc[1] = {(f32x4){0.f, 0.f, 0.f, 0.f}}; float ssq = 0.f;
        acc_steps<1>(ZM + POOLW + QLR, INW, kva, Bt, KVLR, KVLR, 0, 1, lane, acc, ssq);
        ssq += __shfl_xor(ssq, 16); ssq += __shfl_xor(ssq, 32); const float rs = rsqrtf(ssq / (float)KVLR + EPS);
#pragma unroll
        for (int reg = 0; reg < 4; ++reg) KVT[(4 * q + reg) * 128 + e0 + r] = acc[0][reg] * __shfl(rs, 4 * q + reg);
    }
    {
        const int rr = tid >> 5, e = tid & 31; KR[rr * 32 + e] = ZM[(size_t)rr * INW + POOLW + QLR + KVLR + e]; }
    __syncthreads();
    if (tid < 64) { const int rr = tid & 15, which = tid >> 4; float s2 = 0.f;
        if (which == 0) { for (int e = 0; e < 64; ++e) { const float v = QT[rr * 96 + e]; s2 += v * v; } s2 = rsqrtf(s2 / 64.f + EPS); }
        else if (which == 1) { for (int e = 64; e < 96; ++e) { const float v = QT[rr * 96 + e]; s2 += v * v; } s2 = rsqrtf(s2 / 32.f + EPS); }
        else if (which == 2) { for (int e = 0; e < 64; ++e) { const float v = KVT[rr * 128 + e]; s2 += v * v; } s2 = rsqrtf(s2 / 64.f + EPS); }
        else { for (int e = 0; e < 32; ++e) { const float v = KR[rr * 32 + e]; s2 += v * v; } s2 = rsqrtf(s2 / 32.f + EPS); }
        ST[rr * 4 + which] = s2; }
    __syncthreads();
    float qv[3], kvv[3];
    { const int rr = tid >> 5, e = tid & 31; const GAS float* t = rope + (size_t)rr * 32;
      qv[0] = QT[rr * 96 + e] * ST[rr * 4 + 0] * qn[e] * QSCALE; qv[1] = QT[rr * 96 + 32 + e] * ST[rr * 4 + 0] * qn[32 + e] * QSCALE;
      kvv[0] = KVT[rr * 128 + e] * ST[rr * 4 + 2] * kn[e]; kvv[1] = KVT[rr * 128 + 32 + e] * ST[rr * 4 + 2] * kn[32 + e];
      const int j = e & 15; const float c = t[j], sn = t[16 + j];
      const float q1 = QT[rr * 96 + 64 + j] * ST[rr * 4 + 1] * qn[64 + j], q2 = QT[rr * 96 + 80 + j] * ST[rr * 4 + 1] * qn[80 + j];
      const float k1 = KR[rr * 32 + j] * ST[rr * 4 + 3] * kn[64 + j], k2 = KR[rr * 32 + 16 + j] * ST[rr * 4 + 3] * kn[80 + j];
      qv[2] = (e < 16 ? q1 * c - q2 * sn : q1 * sn + q2 * c) * QSCALE; kvv[2] = e < 16 ? k1 * c - k2 * sn : k1 * sn + k2 * c; }
    __syncthreads();
    { const int rr = tid >> 5, e = tid & 31;
#pragma unroll
      for (int i = 0; i < 3; ++i) { QT[rr * 96 + 32 * i + e] = qv[i]; const bf16 kb = f2bf(kvv[i]);
          if (i < 2) KVT[rr * 128 + 32 * i + e] = kvv[i]; else KR[rr * 32 + e] = kvv[2];
#pragma unroll
          for (int b = 0; b < BATCH; ++b) ((GAS bf16*)(ws + WS_K))[(size_t)(b * L + rr) * KP + h * QKD + 32 * i + e] = kb; }
#pragma unroll
      for (int i = 0; i < 2; ++i) { const bf16 vb = f2bf(KVT[rr * 128 + 64 + 32 * i + e]);
#pragma unroll
          for (int b = 0; b < BATCH; ++b) ((GAS bf16*)(ws + WS_V))[(size_t)(b * L + rr) * VP + h * VD + 32 * i + e] = vb; } }
    __syncthreads();
    if (need_q) {
        if (tid < 256) { const int rr = tid >> 4, j = tid & 15; float sc = 0.f;
            for (int e = 0; e < 64; ++e) sc += QT[rr * 96 + e] * KVT[j * 128 + e];
            for (int e = 0; e < 32; ++e) sc += QT[rr * 96 + 64 + e] * KR[j * 32 + e];
            S[rr * 16 + j] = j <= rr ? sc : -INFINITY; }
        __syncthreads();
        float pj = 0.f;
        if (tid < 256) { const int rr = tid >> 4, j = tid & 15; float m = -INFINITY; for (int jj = 0; jj < 16; ++jj) m = fmaxf(m, S[rr * 16 + jj]);
            float l = 0.f; for (int jj = 0; jj < 16; ++jj) l += exp2f(S[rr * 16 + jj] - m);
            pj = exp2f(S[rr * 16 + j] - m) / l; }
        __syncthreads();
        if (tid < 256) S[tid] = pj;
        __syncthreads();
        { GAS float* YM = (GAS float*)(ws + WS_MINI + MN_YM);
#pragma unroll
          for (int i = 0; i < 2; ++i) { const int idx = tid + 512 * i, rr = idx >> 6, d = idx & 63; float o = 0.f;
              for (int j = 0; j < 16; ++j) o += S[rr * 16 + j] * KVT[j * 128 + 64 + d];
              YM[(size_t)rr * D + POOLW + h * VD + d] = o; } }
    }
    __syncthreads();
}
__device__ __forceinline__ void pool_task(LAS unsigned char* lds, unsigned char* ws, unsigned char* wl, const float* pscale, int wid, int lane) {
    const GAS float* ZM = (const GAS float*)(ws + WS_MINI + MN_ZM); GAS float* YM = (GAS float*)(ws + WS_MINI + MN_YM);
    LAS float* PM = (LAS float*)lds; const int tid = wid * 64 + lane;
    for (int idx = tid; idx < 16 * POOLW; idx += NWAVES * 64) { const int rr = idx >> 9, c = idx & 511, w = 2 << (c >> 7), cnt = rr + 1 < w ? rr + 1 : w; float s2 = 0.f;
        for (int i = 0; i < cnt; ++i) s2 += ZM[(size_t)(rr - i) * INW + c];
        PM[rr * 516 + c] = s2 / (float)cnt - ZM[(size_t)rr * INW + c]; }
    __syncthreads();
    const int r = lane & 15, q = lane >> 4;
    for (int ch = wid; ch < 32; ch += NWAVES) { const int g = ch >> 3, n0 = 16 * (ch & 7);
        f32x4 acc = {0.f, 0.f, 0.f, 0.f};
#pragma unroll
        for (int s_ = 0; s_ < 4; ++s_) { const int k = 32 * s_ + 8 * q; const LAS float* pa = PM + r * 516 + 128 * g + k;
            const f32x4 a0 = *(const LAS f32x4*)pa, a1 = *(const LAS f32x4*)(pa + 4);
            const bf16x8 bfr = *(const GAS bf16x8*)((const GAS bf16*)(wl + WO_P) + (size_t)(g * 128 + n0 + r) * 128 + k);
            acc = __builtin_amdgcn_mfma_f32_16x16x32_bf16(pack8(a0, a1), bfr, acc, 0, 0, 0); }
        const int col = 128 * g + n0 + r; const float sc = pscale[col];
#pragma unroll
        for (int reg = 0; reg < 4; ++reg) YM[(size_t)(4 * q + reg) * D + col] = acc[reg] * sc; }
    __syncthreads();
}
}

struct Args { P p; int ph_lo, ph_hi, li, pad; };
__global__ void __launch_bounds__(NWAVES * 64, 2) mega_fwd(const Args args) {
    extern __shared__ __attribute__((aligned(16))) unsigned char lds[];
    Frame F{nullptr, nullptr, nullptr, 0, 0, 0, args.p};
    F.lds = (LAS unsigned char*)lds; F.MISC = (volatile LAS unsigned*)(F.lds + MISC_OFF);
    F.wave = __builtin_amdgcn_readfirstlane((int)threadIdx.x >> 6);
    F.G = gridDim.x; { const int bx = blockIdx.x; F.vcu = (F.G % 8 == 0) ? (bx % 8) * (F.G / 8) + bx / 8 : bx; }
    F.ctl = (gu32*)(args.p.ws + WS_CTL);
    const P& p = F.p;
    for (int u = (int)threadIdx.x; u < (LDS_BYTES - LDSCTL_OFF) / 4; u += NWAVES * 64) ((LAS unsigned*)(F.lds + LDSCTL_OFF))[u] = 0u;
    __syncthreads();
    XcdBarrier bar = xcd_barrier_post((unsigned*)(F.ctl + CW_BAR) + args.li * XCD_BAR_WORDS, F.MISC + 8);
    const int lo = args.ph_lo, hi = args.ph_hi;
#define IN(k) (lo <= (k) && (k) < hi)
#define SEAM(k) do { if (IN(k) && IN((k) + 1)) xcd_barrier(bar); } while (0)
    if (IN(0)) { p0_prologue(F); SEAM(0); }
#define PHASE_LOCALS unsigned char* ws = p.ws; int wv = F.wave, vcu = F.vcu, bid = (int)blockIdx.x, li = l; \
    asm volatile("" : "+s"(ws), "+s"(wv), "+s"(vcu), "+s"(bid), "+s"(li)); unsigned char* const wl = ws + WS_W + (size_t)li * WL_BYTES; (void)wl; (void)vcu; (void)bid; (void)wv
#pragma unroll 1
    for (int l = 0; l < DEPTH; ++l) {
        const int pb = 1 + 6 * l;
        if (IN(pb)) {
            PHASE_LOCALS;
            pg8::Gemm g{(const bf16*)(ws + WS_XN), D, 0, (const bf16*)(wl + WO_IN), D}; pg8::StaticOrder S; S.init(64, 5, F.G, bid);
            pg8::EpiZ E{(bf16*)(ws + WS_Z), (float*)(ws + WS_SSQZ), (const float*)(ws + WS_SSQH), p.qa_g + (size_t)li * QLR, p.kva_g + (size_t)li * KVLR};
            pg8::gemm_phase<pg8::EpiZ, pg8::StaticOrder, PG8_ALIGN, PG8_SP2>(F.lds + RING_OFF, g, S, E, wv);
            if (MK_MINI && bid >= 128 && bid < 128 + INW / 16) mini::p1_chunk(F.lds + RING_OFF, ws, wl, p.attn_g + (size_t)li * D, bid - 128, wv, fresh_lane_id());
            SEAM(pb);
        }
        if (IN(pb + 1)) {
            PHASE_LOCALS;
            { pg8::Gemm g{(const bf16*)(ws + WS_Z) + POOLW, ZP, 0, (const bf16*)(wl + WO_Q), QLR}; pg8::StaticOrder S; S.init(64, 3, F.G, bid);
              pg8::EpiQ E{(bf16*)(ws + WS_Q), (const float*)(ws + WS_SSQZ), p.qn_g + (size_t)li * QKD, (const float*)(ws + WS_ROPE)};
              pg8::gemm_phase<pg8::EpiQ, pg8::StaticOrder, false, PG8_SP2>(F.lds + RING_OFF, g, S, E, wv); }
            if (bid >= 192) { const int t_ = wv * 64 + fresh_lane_id(); for (int m = (bid - 192) * (NWAVES * 64) + t_; m < MR; m += 64 * NWAVES * 64) krope_row(ws, p.kn_g + (size_t)li * QKD + NOPE, m); }
            { pg8::Gemm g{(const bf16*)(ws + WS_Z) + POOLW + QLR, ZP, 0, (const bf16*)(wl + WO_KV), KVLR}; pg8::StaticOrder S; S.init(64, 4, F.G, bid);
              pg8::EpiKV E{(bf16*)(ws + WS_K), (bf16*)(ws + WS_V), (const float*)(ws + WS_SSQZ), p.kn_g + (size_t)li * QKD};
              pg8::gemm_phase<pg8::EpiKV, pg8::StaticOrder, false, PG8_SP2>(F.lds + RING_OFF, g, S, E, wv); }
            for (int ui = bid; ui < 256; ui += F.G) pool_unit(F.lds + RING_OFF, ws, wl, p.pool_scale + (size_t)li * POOLW, wv, ui >> 2, ui & 3);
            if (MK_MINI && bid >= 192 && bid < 200) mini::head_task(F.lds + RING_OFF, ws, wl, p.qa_g + (size_t)li * QLR, p.kva_g + (size_t)li * KVLR, p.qn_g + (size_t)li * QKD, p.kn_g + (size_t)li * QKD, bid - 192, li + 1 < DEPTH, wv, fresh_lane_id());
            if (MK_MINI && bid == 200 && li + 1 < DEPTH) mini::pool_task(F.lds + RING_OFF, ws, wl, p.pool_scale + (size_t)li * POOLW, wv, fresh_lane_id());
            SEAM(pb + 1);
        }
        if (IN(pb + 2)) {
            PHASE_LOCALS;
            const int bh = vcu >> 3, sq = vcu & 7;
#pragma unroll 1
            for (int i = 0; i < 2; ++i)
                attn::attn_unit<8>(bh >> 3, bh & 7, i == 0 ? 15 - sq : sq, (const bf16*)(ws + WS_Q), (const bf16*)(ws + WS_K), (const bf16*)(ws + WS_V), (bf16*)(ws + WS_Y), (char*)lds + RING_OFF, wv);
            SEAM(pb + 2);
        }
        if (IN(pb + 3)) {
            PHASE_LOCALS;
            pg8::Gemm g{(const bf16*)(ws + WS_Y), YP, 0, (const bf16*)(wl + WO_OUT), D}; pg8::StaticOrder S; S.init(64, 4, F.G, bid);
            pg8::EpiRes E{li == 0 ? p.x : p.out, p.out, (bf16*)(ws + WS_XN), (float*)(ws + WS_SSQH), p.ffn_g + (size_t)li * D};
            pg8::gemm_phase<pg8::EpiRes, pg8::StaticOrder, false, PG8_SP2>(F.lds + RING_OFF, g, S, E, wv);
            if (MK_MINI && li + 1 < DEPTH && bid < 64) mini::res_chunk(F.lds + RING_OFF, ws, (const GAS float*)(ws + WS_MINI + MN_YM), D, (const GAS bf16*)(wl + WO_OUT), bid, wv, fresh_lane_id());
            SEAM(pb + 3);
        }
        if (IN(pb + 4)) {
            PHASE_LOCALS;
            pg8::Gemm g{(const bf16*)(ws + WS_XN), D, 0, (const bf16*)(wl + WO_GU), D}; pg8::StaticOrder S; S.init(64, 22, F.G, bid);
            pg8::EpiSwiGLU E{(bf16*)(ws + WS_ACT), (const float*)(ws + WS_SSQH)};
            pg8::gemm_phase<pg8::EpiSwiGLU, pg8::StaticOrder, PG8_ALIGN, PG8_SP2>(F.lds + RING_OFF, g, S, E, wv);
            if (MK_MINI && li + 1 < DEPTH && bid >= 128) { for (int ch = bid - 128; ch < FF / 16; ch += 128) mini::ffn_chunk(F.lds + RING_OFF, ws, wl, p.ffn_g + (size_t)li * D, ch, wv, fresh_lane_id()); }
            SEAM(pb + 4);
        }
        if (IN(pb + 5)) {
            PHASE_LOCALS;
            pg8::Gemm g{(const bf16*)(ws + WS_ACT), FF, 0, (const bf16*)(wl + WO_D), FF}; pg8::StaticOrder S; S.init(64, 4, F.G, bid);
            pg8::EpiRes E{p.out, p.out, (bf16*)(ws + WS_XN), (float*)(ws + WS_SSQH), li + 1 < DEPTH ? p.attn_g + (size_t)(li + 1) * D : nullptr};
            pg8::gemm_phase<pg8::EpiRes, pg8::StaticOrder, false, PG8_SP2>(F.lds + RING_OFF, g, S, E, wv);
            if (MK_MINI && li + 1 < DEPTH && bid < 64) mini::res_chunk(F.lds + RING_OFF, ws, (const GAS float*)(ws + WS_MINI + MN_ACT), FF, (const GAS bf16*)(wl + WO_D), bid, wv, fresh_lane_id());
            SEAM(pb + 5);
        }
    }
#undef IN
#undef SEAM
}

extern "C" void kernel_launch(void* const* d_in, const int* in_sizes, int n_in, void* d_out, int out_size, void* d_ws, size_t ws_size, hipStream_t stream) {
    static int grid = 0;
    if (grid == 0) {
        if (n_in != 17 || in_sizes[0] != MR * D || out_size != MR * D || ws_size < WS_END) { fprintf(stderr, "kernel_launch: unexpected shapes (n_in %d, ws %zu)\n", n_in, ws_size); grid = -1; return; }
        int dev = 0, cus = 0;
        if (hipGetDevice(&dev) != hipSuccess || hipDeviceGetAttribute(&cus, hipDeviceAttributeMultiprocessorCount, dev) != hipSuccess) { grid = -1; return; }
        if (hipFuncSetAttribute((const void*)mega_fwd, hipFuncAttributeMaxDynamicSharedMemorySize, LDS_BYTES) != hipSuccess) { fprintf(stderr, "kernel_launch: hipFuncSetAttribute failed\n"); grid = -1; return; }
        (void)hipGetLastError();
        grid = cus;
        if (grid != 256) fprintf(stderr, "kernel_launch: %d CUs (built for 256)\n", grid);
    }
    if (grid < 0) return;
    P p{}; const float** f = &p.x; for (int i = 0; i < 17; ++i) f[i] = (const float*)d_in[i];
    p.out = (float*)d_out; p.ws = (unsigned char*)d_ws;
    (void)hipMemsetAsync((char*)d_ws + WS_CTL, 0, CTL_ZERO_BYTES, stream);
    Args a{}; a.p = p;
    int nl = 0;
    auto mega = [&](int lo, int hi) { a.ph_lo = lo; a.ph_hi = hi; a.li = nl++; hipLaunchKernelGGL(mega_fwd, dim3(grid), dim3(NWAVES * 64), LDS_BYTES, stream, a); };
#if MK_DEV && MK_MINI
    for (int ph = 0; ph < NPHASE; ++ph) mega(ph, ph + 1);
#elif MK_DEV
    using namespace nv;
    (void)hipMemsetAsync((char*)d_ws + WS_Z, 0, WS_END - WS_Z, stream);
    mega(0, 1);
    k_h0<<<R, 256, 0, stream>>>(p);
    for (int l = 0; l < DEPTH; ++l) {
        const int pb = 1 + 6 * l;
        const float* attn_g = p.attn_g + (size_t)l * D; const float* w_in = p.w_in + (size_t)l * D * INW; const float* w_pool = p.w_pool + (size_t)l * 4 * 128 * 128;
        const float* pool_scale = p.pool_scale + (size_t)l * POOLW; const float* qa = p.qa_g + (size_t)l * QLR; const float* wq = p.w_q_b + (size_t)l * QLR * NH * QKD;
        const float* kva = p.kva_g + (size_t)l * KVLR; const float* wkv = p.w_kv_b + (size_t)l * KVLR * NH * 128; const float* qn = p.qn_g + (size_t)l * QKD; const float* kn = p.kn_g + (size_t)l * QKD;
        const float* w_out = p.w_out + (size_t)l * D * D; const float* ffn_g = p.ffn_g + (size_t)l * D; const float* wg = p.w_gate + (size_t)l * D * FF; const float* wu = p.w_up + (size_t)l * D * FF;
        const float* wd = p.w_down + (size_t)l * FF * D;
        if (l == 0 || MK_OPT(6)) k_norm<<<64, 256, 0, stream>>>(p, attn_g, 1); else k_norm<<<R, 256, 0, stream>>>(p, attn_g, 0);
        if (MK_OPT(1)) { k_z<<<dim3(1, 37), 256, 0, stream>>>(p, w_in, qa, kva, 64, 1); mega(pb, pb + 1); }
        else k_z<<<dim3((R + 255) / 256, 37), 256, 0, stream>>>(p, w_in, qa, kva, R, 0);
        if (MK_OPT(2)) {
            k_poolp<<<64, 256, 0, stream>>>(p, 1);
            k_poolgemm<<<dim3(64, 2), 256, 0, stream>>>(p, w_pool, pool_scale, 1);
            k_q<<<dim3(1, NH), 256, 0, stream>>>(p, wq, qn, 64, 1);
            k_kv<<<dim3(1, NH), 256, 0, stream>>>(p, wkv, kn, 64, 1);
            mega(pb + 1, pb + 2);
        } else {
            k_poolp<<<R, 256, 0, stream>>>(p, 0);
            k_poolgemm<<<dim3(R, 2), 256, 0, stream>>>(p, w_pool, pool_scale, 0);
            k_q<<<dim3((R + 255) / 256, NH), 256, 0, stream>>>(p, wq, qn, R, 0);
            k_kv<<<dim3((R + 255) / 256, NH), 256, 0, stream>>>(p, wkv, kn, R, 0);
        }
        if (MK_OPT(3)) { k_attn<<<dim3(1, NH, BATCH), 64, 0, stream>>>(p, NMETA); mega(pb + 2, pb + 3); }
        else k_attn<<<dim3((L + 63) / 64, NH, BATCH), 64, 0, stream>>>(p, L);
        if (MK_OPT(4)) { ngemm<F4, false><<<dim3(D / 64, 1), 256, 0, stream>>>(F4{p, w_out, 1}, 64, D, D); mega(pb + 3, pb + 4); k_norm<<<64, 256, 0, stream>>>(p, ffn_g, 1); }
        else { ngemm<F4, false><<<dim3(D / 64, (R + 63) / 64), 256, 0, stream>>>(F4{p, w_out, 0}, R, D, D); k_norm<<<R, 256, 0, stream>>>(p, ffn_g, 0); }
        if (MK_OPT(5)) { ngemm<F5, true><<<dim3(FF / 64, 1), 256, 0, stream>>>(F5{p, wg, wu, 1}, 64, FF, D); mega(pb + 4, pb + 5); }
        else ngemm<F5, true><<<dim3(FF / 64, (R + 63) / 64), 256, 0, stream>>>(F5{p, wg, wu, 0}, R, FF, D);
        if (MK_OPT(6)) { ngemm<F6, false><<<dim3(D / 64, 1), 256, 0, stream>>>(F6{p, wd, 1}, 64, D, FF); mega(pb + 5, pb + 6); }
        else ngemm<F6, false><<<dim3(D / 64, (R + 63) / 64), 256, 0, stream>>>(F6{p, wd, 0}, R, D, FF);
    }
#else
    mega(0, NPHASE);
#endif
}
```

```cpp
#include <hip/hip_runtime.h>
#include <cstdint>
#include <cstdio>

#ifndef MK_PROBE
#define MK_PROBE -1
#endif
#ifndef MK_PA
#define MK_PA -1
#define MK_PB 0
#define MK_PBLK 0
#endif
#ifndef MK_MINI
#define MK_MINI 1
#endif

constexpr int D = 1024, BATCH = 4, SEQ = 4096, DEPTH = 2, NMETA = 16, L = SEQ + NMETA;
constexpr int R = BATCH * L;
constexpr int RA = R + 256;
constexpr int MR = BATCH * SEQ;
constexpr int POOLW = 512, QLR = 384, KVLR = 256, ROPE = 32, NOPE = 64, QKD = 96, VD = 64, NH = 8;
constexpr int INW = POOLW + QLR + KVLR + ROPE;
constexpr int INWP = 1280;
constexpr int FF = 2816;
constexpr float EPS = 1e-6f;
constexpr float QSCALE = 0.10206207261596577f * 1.4426950408889634f;
constexpr int QP = NH * QKD, KP = NH * QKD, VP = NH * VD, YP = D, ZP = INW, SZ = 40;

typedef unsigned short bf16;
#define GAS __attribute__((address_space(1)))
#define LAS __attribute__((address_space(3)))
constexpr size_t MiB = 1u << 20;
constexpr size_t WS_CTL = 0, CTL_ZERO_BYTES = 1 * MiB;
constexpr size_t WS_ROPE = 1 * MiB, WS_MINI = 2 * MiB, WS_W = 4 * MiB, WL_BYTES = 24 * MiB;
constexpr size_t WO_IN = 0, WO_Q = 2560 * 1024, WO_KV = 3328 * 1024, WO_P = 3840 * 1024, WO_OUT = 4 * MiB, WO_GU = 6 * MiB, WO_D = 17 * MiB;
constexpr size_t MN_HM = 0, MN_ZM = 256 * 1024, MN_YM = 384 * 1024, MN_ACT = 512 * 1024;
constexpr size_t WS_XN = 52 * MiB, WS_Y = 85 * MiB, WS_SSQH = 118 * MiB;
constexpr size_t WS_Z = 119 * MiB, WS_SSQZ = 157 * MiB, WS_Q = 160 * MiB, WS_K = 185 * MiB, WS_V = 210 * MiB, WS_PNAIVE = 227 * MiB, WS_ACT = 119 * MiB, WS_END = 244 * MiB;
static_assert(WO_IN + (size_t)INWP * D * 2 <= WO_Q && WO_Q + (size_t)768 * QLR * 2 <= WO_KV && WO_KV + (size_t)1024 * KVLR * 2 <= WO_P && WO_P + (size_t)4 * 128 * 128 * 2 <= WO_OUT &&
              WO_OUT + (size_t)D * D * 2 <= WO_GU && WO_GU + (size_t)2 * FF * D * 2 <= WO_D && WO_D + (size_t)D * FF * 2 <= WL_BYTES && WS_W + 2 * WL_BYTES <= WS_XN, "weight map");
static_assert(WS_XN + (size_t)RA * D * 2 <= WS_Y && WS_Y + (size_t)RA * D * 2 <= WS_SSQH && WS_SSQH + (size_t)RA * 16 <= WS_Z && WS_Z + (size_t)RA * INW * 2 <= WS_SSQZ && WS_SSQZ + (size_t)RA * SZ * 4 <= WS_Q &&
              WS_Q + (size_t)RA * QP * 2 <= WS_K && WS_K + (size_t)RA * KP * 2 <= WS_V && WS_V + (size_t)RA * VP * 2 <= WS_PNAIVE && WS_PNAIVE + (size_t)RA * 512 * 2 <= WS_END &&
              WS_ACT + (size_t)RA * FF * 2 <= WS_K + (size_t)R * KP * 2, "ws map");

__host__ __device__ __forceinline__ int rowbase(int pm) { return (pm >> 4) * L + NMETA + ((pm & 15) << 8); }
constexpr int KT_N = 65; constexpr size_t KT_BYTES = 12 * 1024;
__host__ __device__ __forceinline__ size_t kcell(int b, int h, int pos, int chunk) { return ((size_t)((b * NH + h) * KT_N + (pos >> 6)) * 12 + chunk) * 1024 + (size_t)(pos & 63) * 16; }
static_assert((size_t)BATCH * NH * KT_N * KT_BYTES <= 25 * MiB, "K image fits its 25 MiB of d_ws");
__device__ __forceinline__ float bf2f(bf16 v) { return __uint_as_float((unsigned)v << 16); }
typedef float pk2_f32x2 __attribute__((ext_vector_type(2))); typedef __bf16 pk2_bf16x2 __attribute__((ext_vector_type(2)));
__device__ __forceinline__ unsigned pk2(float lo, float hi) { const pk2_f32x2 v = {lo, hi}; return __builtin_bit_cast(unsigned, __builtin_convertvector(v, pk2_bf16x2)); }
__device__ __forceinline__ bf16 f2bf(float f) { return (bf16)(pk2(f, 0.f) & 0xffffu); }

struct P {
    const float *x, *meta, *attn_g, *w_in, *w_pool, *pool_scale, *qa_g, *w_q_b, *kva_g, *w_kv_b, *qn_g, *kn_g, *w_out, *ffn_g, *w_gate, *w_up, *w_down;
    float* out; unsigned char* ws;
};

typedef unsigned wt_u32x4 __attribute__((ext_vector_type(4)));
__device__ __forceinline__ __amdgpu_buffer_rsrc_t ws_rsrc(unsigned char* ws) { return __builtin_amdgcn_make_buffer_rsrc(ws, 0, 0x10000000, 0x00020000); }
__device__ __forceinline__ void st16_wt(__amdgpu_buffer_rsrc_t r, size_t off, wt_u32x4 v) { __builtin_amdgcn_raw_buffer_store_b128(v, r, (int)off, 0, 16); }
__device__ __forceinline__ void st4_wt(__amdgpu_buffer_rsrc_t r, size_t off, unsigned v) { __builtin_amdgcn_raw_buffer_store_b32(v, r, (int)off, 0, 16); }
namespace pg8 {
#define PG8_LAS __attribute__((address_space(3)))
typedef unsigned short bf16_t;
typedef short bf16x8 __attribute__((ext_vector_type(8)));
typedef float f32x4 __attribute__((ext_vector_type(4)));
typedef unsigned u32x4 __attribute__((ext_vector_type(4)));
typedef unsigned u32x2 __attribute__((ext_vector_type(2)));
constexpr int BM = 256, BK = 64, HALF = 128, HTB = HALF * BK * 2, STAGE_BYTES = 8 * HTB, NXCD = 8, WGM = 8;
__host__ __device__ __forceinline__ int lds_byte(int r, int c) { const int st = (r >> 4) * 2 + (c >> 5), rr = r & 15, cc = c & 31, ob = rr * 64 + cc * 2; return st * 1024 + (ob ^ (((ob >> 9) & 1) << 5)); }
__host__ __device__ __forceinline__ void stage_rc(int b, int& R_, int& C) { const int st = b / 1024, sb = b % 1024, swz = sb ^ (((sb >> 9) & 1) << 5); R_ = (st >> 1) * 16 + swz / 64; C = (st & 1) * 32 + (swz % 64) / 2; }
__host__ __device__ __forceinline__ int perm32(int rho) { const int n = rho >> 4, i = rho & 15; return 8 * (i >> 2) + 4 * n + (i & 3); }
struct Unit { int pm, pn, hm; };
struct Gemm { const bf16_t* A; int lda; int acolstep; const bf16_t* Bt; int K; };
struct StaticOrder {
    int nM, nN, nwg, G, c, nfull; bool own;
    __host__ __device__ void init(int nM_, int nN_, int G_, int c_, int nsplit = 0) { nM = nM_; nN = nN_; nwg = nM * nN; G = G_; c = c_; nfull = nwg - nsplit; own = nsplit == 128 && G == 256 && nM == 64 && nfull % G == 0; }
    __host__ __device__ bool next(int i, Unit& u) const {
        long Lx = (long)i * G + c; u.hm = 3;
        if (Lx >= nfull && own) { const int j = (int)(Lx - nfull); if (j >= 256) return false; u.pm = 8 * (j & 7) + ((j >> 3) & 7); u.pn = nfull / nM + (j >> 7); u.hm = 1 << ((j >> 6) & 1); return true; }
        if (Lx >= nfull) { const long j = Lx - nfull; Lx = nfull + (j >> 1); u.hm = 1 << (int)(j & 1); }
        if (Lx >= nwg) return false;
        int wgid = (int)Lx; { const int q = nwg / NXCD, r = nwg % NXCD, xcd = wgid % NXCD, off = wgid / NXCD; wgid = (xcd < r ? xcd * (q + 1) : r * (q + 1) + (xcd - r) * q) + off; }
        const int nig = WGM * nN, gid = wgid / nig, fm = gid * WGM, gsz = (nM - fm) < WGM ? (nM - fm) : WGM;
        u.pm = fm + ((wgid % nig) % gsz); u.pn = (wgid % nig) / gsz; return true;
    }
    __device__ __forceinline__ void a_ready(const Unit&) const {}
    __device__ __forceinline__ void done(const Unit&) const {}
};
__device__ __forceinline__ unsigned cvt_pk_bf16(float lo, float hi) { unsigned r; asm volatile("v_cvt_pk_bf16_f32 %0, %1, %2" : "=v"(r) : "v"(lo), "v"(hi)); return r; }
__device__ __forceinline__ float hsum4(f32x4 v) { return (v[0] * v[0] + v[1] * v[1]) + (v[2] * v[2] + v[3] * v[3]); }
__device__ __forceinline__ float xsum_q4(float x) {
    auto a = __builtin_amdgcn_permlane16_swap(__float_as_uint(x), __float_as_uint(x), false, false); x = __uint_as_float(a[0]) + __uint_as_float(a[1]);
    auto b = __builtin_amdgcn_permlane32_swap(__float_as_uint(x), __float_as_uint(x), false, false); return __uint_as_float(b[0]) + __uint_as_float(b[1]); }
__device__ __forceinline__ float xlane32(float x, bool upper) { auto b = __builtin_amdgcn_permlane32_swap(__float_as_uint(x), __float_as_uint(x), false, false); return __uint_as_float(upper ? b[0] : b[1]); }

__device__ __forceinline__ void fresh_lane(int& fr, int& fq) { unsigned m1 = ~0u; asm volatile("" : "+s"(m1)); const int lane = (int)__builtin_amdgcn_mbcnt_hi(m1, __builtin_amdgcn_mbcnt_lo(m1, 0u)); fr = lane & 15; fq = lane >> 4; }
struct EpiZ {
    static constexpr bool PERM = true, AFTER_DRAIN = false;
    bf16_t* Z; float* ssqz; const float* ssqh; const float* qa; const float* kva; unsigned char* wsb; unsigned* zflag;
    __device__ __forceinline__ void operator()(const f32x4 (&acc)[2][2][4][2], const Unit& u, int wr, int wc, int, int) const {
        int fr, fq; fresh_lane(fr, fq);
        const int kr0 = rowbase(u.pm) + wr * 64 + fr; const bool pub = u.pn < 2; const __amdgpu_buffer_rsrc_t rsr = ws_rsrc(wsb);
        f32x4 g[2][2]; bool valid[2];
#pragma unroll
        for (int bj = 0; bj < 2; ++bj) { const int cb = u.pn * BM + bj * HALF + wc * 32; valid[bj] = cb < INW; const int c0 = cb + 8 * fq;
            const float* gp = (cb >= POOLW && cb < POOLW + QLR) ? qa + (c0 - POOLW) : (cb >= POOLW + QLR && cb < POOLW + QLR + KVLR) ? kva + (c0 - POOLW - QLR) : nullptr;
            g[bj][0] = gp ? *(const f32x4*)gp : (f32x4){1.f, 1.f, 1.f, 1.f}; g[bj][1] = gp ? *(const f32x4*)(gp + 4) : (f32x4){1.f, 1.f, 1.f, 1.f}; }
        float rsv[2][4];
        { f32x4 sqv[2][4];
#pragma unroll
          for (int ai = 0; ai < 2; ++ai)
#pragma unroll
              for (int m = 0; m < 4; ++m) sqv[ai][m] = *(const GAS f32x4*)(ssqh + (size_t)(kr0 + ai * HALF + m * 16) * 4);
#pragma unroll
          for (int ai = 0; ai < 2; ++ai)
#pragma unroll
              for (int m = 0; m < 4; ++m) { const f32x4 sq = sqv[ai][m]; rsv[ai][m] = __builtin_amdgcn_rsqf(((sq[0] + sq[1]) + (sq[2] + sq[3])) * (1.0f / D) + EPS); asm volatile("" : "+v"(rsv[ai][m])); } }
#pragma unroll
        for (int ai = 0; ai < 2; ++ai) { if (!((u.hm >> ai) & 1)) continue;
#pragma unroll
            for (int m = 0; m < 4; ++m) { const int krow = kr0 + ai * HALF + m * 16;
                const float rs = rsv[ai][m];
#pragma unroll
                for (int bj = 0; bj < 2; ++bj) { if (!valid[bj]) continue;
                    const f32x4 v0 = acc[ai][bj][m][0] * rs, v1 = acc[ai][bj][m][1] * rs;
                    float ss = xsum_q4(hsum4(v0) + hsum4(v1));
                    if (fq == 0) st4_wt(rsr, WS_SSQZ + ((size_t)krow * SZ + u.pn * 8 + bj * 4 + wc) * 4, __float_as_uint(ss));
                    const f32x4 o0 = v0 * g[bj][0], o1 = v1 * g[bj][1];
                    u32x4 w; w.x = cvt_pk_bf16(o0[0], o0[1]); w.y = cvt_pk_bf16(o0[2], o0[3]); w.z = cvt_pk_bf16(o1[0], o1[1]); w.w = cvt_pk_bf16(o1[2], o1[3]);
                    st16_wt(rsr, WS_Z + ((size_t)krow * ZP + u.pn * BM + bj * HALF + wc * 32 + 8 * fq) * 2, w); } } }
        if (pub) { asm volatile("s_waitcnt vmcnt(0)" ::: "memory");
            if (fr == 0 && fq == 0) __hip_atomic_fetch_add((GAS unsigned*)(zflag + 64 * (2 * u.pm + u.pn)), 1u, __ATOMIC_RELAXED, __HIP_MEMORY_SCOPE_AGENT); }
    }
};

struct EpiQ {
    static constexpr bool PERM = true, AFTER_DRAIN = false;
    bf16_t* Q; const float* ssqz; const float* qn; const float* rope; const PG8_LAS float* rtab;
    __device__ __forceinline__ void operator()(const f32x4 (&acc)[2][2][4][2], const Unit& u, int wr, int wc, int, int) const {
        int fr, fq; fresh_lane(fr, fq);
        const int kr0 = rowbase(u.pm) + wr * 64 + fr, pos0 = NMETA + ((u.pm & 15) << 8) + wr * 64 + fr;
        float rqv[2][4];
        if (rtab) {
#pragma unroll
            for (int ai = 0; ai < 2; ++ai)
#pragma unroll
                for (int m = 0; m < 4; ++m) rqv[ai][m] = rtab[wr * 64 + fr + ai * HALF + m * 16];
        } else {
#pragma unroll
            for (int ai = 0; ai < 2; ++ai) { f32x4 raw[4][3];
#pragma unroll
                for (int m = 0; m < 4; ++m) { const GAS f32x4* sq = (const GAS f32x4*)(ssqz + (size_t)(kr0 + ai * HALF + m * 16) * SZ + 16); raw[m][0] = sq[0]; raw[m][1] = sq[1]; raw[m][2] = sq[2]; }
#pragma unroll
                for (int m = 0; m < 4; ++m) { const f32x4 t = raw[m][0] + raw[m][1] + raw[m][2]; rqv[ai][m] = __builtin_amdgcn_rsqf(((t[0] + t[1]) + (t[2] + t[3])) * (1.0f / QLR) + EPS); }
                asm volatile("" ::: "memory"); }
        }
        if (u.pn < 2) {
            const int head = 4 * u.pn + wc; f32x4 gq[2][2];
#pragma unroll
            for (int bj = 0; bj < 2; ++bj)
#pragma unroll
                for (int n = 0; n < 2; ++n) gq[bj][n] = *(const f32x4*)(qn + 32 * bj + 8 * fq + 4 * n);
#pragma unroll
            for (int ai = 0; ai < 2; ++ai) {
#pragma unroll
                for (int m = 0; m < 4; ++m) { const int krow = kr0 + ai * HALF + m * 16;
                    const float rq = rqv[ai][m];
                    f32x4 v[2][2]; float ss = 0.f;
#pragma unroll
                    for (int bj = 0; bj < 2; ++bj)
#pragma unroll
                        for (int n = 0; n < 2; ++n) { v[bj][n] = acc[ai][bj][m][n] * rq; ss += hsum4(v[bj][n]); }
                    ss = xsum_q4(ss);
                    const float r1 = __builtin_amdgcn_rsqf(ss * (1.0f / NOPE) + EPS) * QSCALE;
                    bf16_t* qp = Q + (size_t)krow * QP + head * QKD + 8 * fq;
#pragma unroll
                    for (int bj = 0; bj < 2; ++bj) { const f32x4 o0 = v[bj][0] * r1 * gq[bj][0], o1 = v[bj][1] * r1 * gq[bj][1];
                        u32x4 w; w.x = cvt_pk_bf16(o0[0], o0[1]); w.y = cvt_pk_bf16(o0[2], o0[3]); w.z = cvt_pk_bf16(o1[0], o1[1]); w.w = cvt_pk_bf16(o1[2], o1[3]); *(GAS u32x4*)(qp + 32 * bj) = w; } }
                asm volatile("" ::: "memory"); }
        } else {
            const bool lo = fq < 2; const int jj = 8 * (fq & 1);
            const f32x4 g0 = *(const f32x4*)(qn + NOPE + 8 * fq), g1 = *(const f32x4*)(qn + NOPE + 8 * fq + 4);
            f32x4 cc[2][2], sc[2][2];
#define ROPE_LD(rg_, b_) do { const GAS float* rp = (const GAS float*)rope + (size_t)(pos0 + ((rg_) >> 2) * HALF + ((rg_) & 3) * 16) * 32 + jj; \
                cc[b_][0] = *(const GAS f32x4*)rp; cc[b_][1] = *(const GAS f32x4*)(rp + 4); sc[b_][0] = *(const GAS f32x4*)(rp + 16); sc[b_][1] = *(const GAS f32x4*)(rp + 20); } while (0)
            ROPE_LD(0, 0);
#pragma unroll
            for (int rg = 0; rg < 8; ++rg) { const int ai = rg >> 2, m = rg & 3, bb = rg & 1; const int krow = kr0 + ai * HALF + m * 16;
                if (rg + 1 < 8) { ROPE_LD(rg + 1, (rg + 1) & 1); }
                __builtin_amdgcn_sched_barrier(0);
                const float rq = rqv[ai][m];
#pragma unroll
                for (int bj = 0; bj < 2; ++bj) { const int head = 4 * bj + wc; const f32x4 v0 = acc[ai][bj][m][0], v1 = acc[ai][bj][m][1];
                    const float ss = xsum_q4(hsum4(v0) + hsum4(v1)) * (rq * rq);
                    const float r2 = __builtin_amdgcn_rsqf(ss * (1.0f / ROPE) + EPS) * (QSCALE * rq);
                    const f32x4 y0 = v0 * r2 * g0, y1 = v1 * r2 * g1; f32x4 p0, p1;
#pragma unroll
                    for (int e = 0; e < 4; ++e) { p0[e] = xlane32(y0[e], !lo); p1[e] = xlane32(y1[e], !lo); }
                    const f32x4 o0 = lo ? y0 * cc[bb][0] - p0 * sc[bb][0] : p0 * sc[bb][0] + y0 * cc[bb][0], o1 = lo ? y1 * cc[bb][1] - p1 * sc[bb][1] : p1 * sc[bb][1] + y1 * cc[bb][1];
                    u32x4 w; w.x = cvt_pk_bf16(o0[0], o0[1]); w.y = cvt_pk_bf16(o0[2], o0[3]); w.z = cvt_pk_bf16(o1[0], o1[1]); w.w = cvt_pk_bf16(o1[2], o1[3]);
                    *(GAS u32x4*)(Q + (size_t)krow * QP + head * QKD + NOPE + 8 * fq) = w; }
                asm volatile("" ::: "memory"); }
#undef ROPE_LD
        }
    }
};
struct EpiKV {
    static constexpr bool PERM = true, AFTER_DRAIN = false;
    bf16_t* Kb; bf16_t* Vb; const float* ssqz; const float* kn; const PG8_LAS float* rtab;
    __device__ __forceinline__ void operator()(const f32x4 (&acc)[2][2][4][2], const Unit& u, int wr, int wc, int, int) const {
        int fr, fq; fresh_lane(fr, fq);
        const int kr0 = rowbase(u.pm) + wr * 64 + fr; const bool isk = u.pn < 2; const int head = 4 * (u.pn & 1) + wc;
        f32x4 gk[2][2];
#pragma unroll
        for (int bj = 0; bj < 2; ++bj)
#pragma unroll
            for (int n = 0; n < 2; ++n) gk[bj][n] = isk ? *(const f32x4*)(kn + 32 * bj + 8 * fq + 4 * n) : (f32x4){1.f, 1.f, 1.f, 1.f};
        float rkv[2][4];
        if (rtab) {
#pragma unroll
            for (int ai = 0; ai < 2; ++ai)
#pragma unroll
                for (int m = 0; m < 4; ++m) rkv[ai][m] = rtab[wr * 64 + fr + ai * HALF + m * 16];
        } else {
#pragma unroll
            for (int ai = 0; ai < 2; ++ai) { f32x4 tk[4];
#pragma unroll
                for (int m = 0; m < 4; ++m) { const GAS f32x4* sq = (const GAS f32x4*)(ssqz + (size_t)(kr0 + ai * HALF + m * 16) * SZ + 28); tk[m] = sq[0] + sq[1]; }
#pragma unroll
                for (int m = 0; m < 4; ++m) { const f32x4 t = tk[m]; rkv[ai][m] = __builtin_amdgcn_rsqf(((t[0] + t[1]) + (t[2] + t[3])) * (1.0f / KVLR) + EPS); }
                asm volatile("" ::: "memory"); }
        }
#pragma unroll
        for (int ai = 0; ai < 2; ++ai) {
#pragma unroll
            for (int m = 0; m < 4; ++m) { const int krow = kr0 + ai * HALF + m * 16;
                const float rk = rkv[ai][m];
                const int kb_ = u.pm >> 4, kpos = NMETA + ((u.pm & 15) << 8) + ai * HALF + wr * 64 + m * 16 + fr;
                if (isk) {
                    float ss = 0.f;
#pragma unroll
                    for (int bj = 0; bj < 2; ++bj)
#pragma unroll
                        for (int n = 0; n < 2; ++n) ss += hsum4(acc[ai][bj][m][n]);
                    ss = xsum_q4(ss) * (rk * rk);
                    const float k1 = __builtin_amdgcn_rsqf(ss * (1.0f / NOPE) + EPS) * rk;
#pragma unroll
                    for (int bj = 0; bj < 2; ++bj) { const f32x4 o0 = acc[ai][bj][m][0] * k1 * gk[bj][0], o1 = acc[ai][bj][m][1] * k1 * gk[bj][1];
                        u32x4 w; w.x = cvt_pk_bf16(o0[0], o0[1]); w.y = cvt_pk_bf16(o0[2], o0[3]); w.z = cvt_pk_bf16(o1[0], o1[1]); w.w = cvt_pk_bf16(o1[2], o1[3]);
                        *(GAS u32x4*)((GAS unsigned char*)Kb + kcell(kb_, head, kpos, 4 * bj + fq)) = w; }
                } else {
                    bf16_t* op = Vb + (size_t)krow * VP + head * VD + 8 * fq;
#pragma unroll
                    for (int bj = 0; bj < 2; ++bj) { const f32x4 o0 = acc[ai][bj][m][0] * rk, o1 = acc[ai][bj][m][1] * rk;
                        u32x4 w; w.x = cvt_pk_bf16(o0[0], o0[1]); w.y = cvt_pk_bf16(o0[2], o0[3]); w.z = cvt_pk_bf16(o1[0], o1[1]); w.w = cvt_pk_bf16(o1[2], o1[3]);
                        *(GAS u32x4*)(op + 32 * bj) = w; }
                } }
            asm volatile("" ::: "memory"); }
    }
};
template <bool WT> struct EpiResT {
    static constexpr bool PERM = true, AFTER_DRAIN = true;
    bf16_t* h16; float* ssqh; float* outf;
    __device__ __forceinline__ void prefetch(const Unit& u, int wr, int wc, u32x4 (&pre)[2][4][2]) const {
        int fr, fq; fresh_lane(fr, fq);
        const int col0 = u.pn * BM + wc * 32 + 8 * fq;
#pragma unroll
        for (int ai = 0; ai < 2; ++ai)
#pragma unroll
            for (int m = 0; m < 4; ++m)
#pragma unroll
                for (int bj = 0; bj < 2; ++bj) pre[ai][m][bj] = *(const GAS u32x4*)(h16 + (size_t)(rowbase(u.pm) + ai * HALF + wr * 64 + m * 16 + fr) * D + col0 + bj * HALF);
    }
    __device__ __forceinline__ void fused(const f32x4 (&acc)[2][2][4][2], const Unit& u, int wr, int wc, int, int, PG8_LAS unsigned char* lds, int wid, int, const u32x4 (&pre)[2][4][2]) const {
        int fr, fq; fresh_lane(fr, fq);
        const int col0 = u.pn * BM + wc * 32 + 8 * fq; const bool fin = outf != nullptr;
        const __amdgpu_buffer_rsrc_t rsh = ws_rsrc((unsigned char*)h16), rss = ws_rsrc((unsigned char*)ssqh);
        PG8_LAS float* Pp = (PG8_LAS float*)lds;
#pragma unroll
        for (int ai = 0; ai < 2; ++ai) {
#pragma unroll
            for (int m = 0; m < 4; ++m) { const int r = ai * HALF + wr * 64 + m * 16 + fr; float ss = 0.f;
#pragma unroll
                for (int bj = 0; bj < 2; ++bj) { const u32x4 pw = pre[ai][m][bj];
                    const f32x4 b0 = {__uint_as_float(pw.x << 16), __uint_as_float(pw.x & 0xffff0000u), __uint_as_float(pw.y << 16), __uint_as_float(pw.y & 0xffff0000u)};
                    const f32x4 b1 = {__uint_as_float(pw.z << 16), __uint_as_float(pw.z & 0xffff0000u), __uint_as_float(pw.w << 16), __uint_as_float(pw.w & 0xffff0000u)};
                    const f32x4 o0 = b0 + acc[ai][bj][m][0], o1 = b1 + acc[ai][bj][m][1];
                    if (fin) { GAS f32x4* op = (GAS f32x4*)(outf + (size_t)(u.pm * BM + r) * D + col0 + bj * HALF); op[0] = o0; op[1] = o1; }
                    else { ss += hsum4(o0) + hsum4(o1); u32x4 w; w.x = cvt_pk_bf16(o0[0], o0[1]); w.y = cvt_pk_bf16(o0[2], o0[3]); w.z = cvt_pk_bf16(o1[0], o1[1]); w.w = cvt_pk_bf16(o1[2], o1[3]);
                        if (WT) st16_wt(rsh, ((size_t)(rowbase(u.pm) + r) * D + col0 + bj * HALF) * 2, __builtin_bit_cast(wt_u32x4, w)); else *(GAS u32x4*)(h16 + (size_t)(rowbase(u.pm) + r) * D + col0 + bj * HALF) = w; } }
                if (!fin) { ss = xsum_q4(ss); if (fq == 0) Pp[r * 4 + wc] = ss; } }
            asm volatile("" ::: "memory"); }
        if (!fin) {
            asm volatile("s_waitcnt lgkmcnt(0)" ::: "memory"); __builtin_amdgcn_s_barrier(); asm volatile("" ::: "memory");
            const int t = wid * 64 + fq * 16 + fr;
            if (t < 256) { const f32x4 q = *(const PG8_LAS f32x4*)(Pp + t * 4); const float sv = (q[0] + q[1]) + (q[2] + q[3]);
                if (WT) st4_wt(rss, ((size_t)(rowbase(u.pm) + t) * 4 + u.pn) * 4, __float_as_uint(sv)); else ((GAS float*)ssqh)[(size_t)(rowbase(u.pm) + t) * 4 + u.pn] = sv; }
        }
    }
};
using EpiRes = EpiResT<false>;
struct EpiSwiGLU {
    static constexpr bool PERM = true, AFTER_DRAIN = false;
    bf16_t* act; const float* ssqh; const PG8_LAS float* rst;
    __device__ __forceinline__ void operator()(const f32x4 (&acc)[2][2][4][2], const Unit& u, int wr, int wc, int, int) const {
        int fr, fq; fresh_lane(fr, fq);
        const int kr0 = rowbase(u.pm) + wr * 64 + fr; const __amdgpu_buffer_rsrc_t rsa = ws_rsrc((unsigned char*)act);
        float rsv[2][4];
        if (rst) {
#pragma unroll
            for (int ai = 0; ai < 2; ++ai)
#pragma unroll
                for (int m = 0; m < 4; ++m) rsv[ai][m] = rst[wr * 64 + fr + ai * HALF + m * 16];
        } else {
            f32x4 sqv[2][4];
#pragma unroll
            for (int ai = 0; ai < 2; ++ai)
#pragma unroll
                for (int m = 0; m < 4; ++m) sqv[ai][m] = *(const GAS f32x4*)(ssqh + (size_t)(kr0 + ai * HALF + m * 16) * 4);
#pragma unroll
            for (int ai = 0; ai < 2; ++ai)
#pragma unroll
                for (int m = 0; m < 4; ++m) { const f32x4 sq = sqv[ai][m]; rsv[ai][m] = rsqrtf(((sq[0] + sq[1]) + (sq[2] + sq[3])) * (1.0f / D) + EPS); }
        }
#pragma unroll
        for (int ai = 0; ai < 2; ++ai) { if (!((u.hm >> ai) & 1)) continue;
#pragma unroll
            for (int m = 0; m < 4; ++m) { const int krow = kr0 + ai * HALF + m * 16;
                const float rs = rsv[ai][m];
                const float cneg = -1.4426950408889634f * rs, rs2 = rs * rs;
                f32x4 a[2], t[2], p[2];
#pragma unroll
                for (int n = 0; n < 2; ++n) { t[n] = acc[ai][0][m][n] * cneg; p[n] = acc[ai][0][m][n] * acc[ai][1][m][n]; }
#pragma unroll
                for (int n = 0; n < 2; ++n)
#pragma unroll
                    for (int e = 0; e < 4; ++e) t[n][e] = __builtin_amdgcn_exp2f(t[n][e]);
#pragma unroll
                for (int n = 0; n < 2; ++n) t[n] = t[n] + 1.0f;
#pragma unroll
                for (int n = 0; n < 2; ++n)
#pragma unroll
                    for (int e = 0; e < 4; ++e) t[n][e] = __builtin_amdgcn_rcpf(t[n][e]);
#pragma unroll
                for (int n = 0; n < 2; ++n) a[n] = p[n] * (t[n] * rs2);
                u32x4 w; w.x = cvt_pk_bf16(a[0][0], a[0][1]); w.y = cvt_pk_bf16(a[0][2], a[0][3]); w.z = cvt_pk_bf16(a[1][0], a[1][1]); w.w = cvt_pk_bf16(a[1][2], a[1][3]);
                st16_wt(rsa, ((size_t)krow * FF + u.pn * HALF + wc * 32 + 8 * fq) * 2, __builtin_bit_cast(wt_u32x4, w)); } }
    }
};

#define PG8_KLOOP(H0_, H1_) _Pragma("unroll 1") \
        for (int t = 0; t < nt; t += 2) { \
            const bool last = (t == nt - 2); \
            const char* a1 = cA + (size_t)(t + 1) * kstep; \
            const char* a2 = last ? nA : cA + (size_t)(t + 2) * kstep; const char* b2 = last ? nB : cB + (size_t)(t + 2) * kstep; \
            const char* a3 = a2 + kstep; const char* b3 = b2 + kstep; \
            if (last && has_next) S.a_ready(nxt); \
            if constexpr (SP2) { \
            PG8_LDB(B0, 0, 0); PG8_LDB(B1, 0, 1); PG8_SCHED; PG8_LDA(At, 0, 0); PG8_STAGE(PG8_SA(1, 1), a1 + hstepA, voffA); \
            PG8_WAIT_V(8); PG8_WAIT_L(0); PG8_BAR; if (H0_) { PG8_MMA(0, 0, At, B0); PG8_MMA(0, 1, At, B1); } PG8_BAR; PG8_SCHED; \
            PG8_LDA(At, 0, 1); PG8_STAGE(PG8_SB(0, 0), b2, voffB); PG8_STAGE(PG8_SB(0, 1), b2 + hstepB, voffB); PG8_STAGE(PG8_SA(0, 0), a2, voffA); \
            PG8_WAIT_V(8); PG8_WAIT_L(0); PG8_BAR; if (H1_) { PG8_MMA(1, 0, At, B0); PG8_MMA(1, 1, At, B1); } PG8_BAR; PG8_SCHED; \
            PG8_LDB(B0, 1, 0); PG8_LDB(B1, 1, 1); PG8_SCHED; PG8_LDA(At, 1, 0); PG8_STAGE(PG8_SA(0, 1), a2 + hstepA, voffA); \
            PG8_WAIT_V(8); PG8_WAIT_L(0); PG8_BAR; if (H0_) { PG8_MMA(0, 0, At, B0); PG8_MMA(0, 1, At, B1); } PG8_BAR; PG8_SCHED; \
            PG8_LDA(At, 1, 1); PG8_STAGE(PG8_SB(1, 0), b3, voffB); PG8_STAGE(PG8_SB(1, 1), b3 + hstepB, voffB); PG8_STAGE(PG8_SA(1, 0), a3, voffA); \
            PG8_WAIT_V(8); PG8_WAIT_L(0); PG8_BAR; if (H1_) { PG8_MMA(1, 0, At, B0); PG8_MMA(1, 1, At, B1); } PG8_BAR; PG8_SCHED; \
            } else { \
            PG8_LDB(B0, 0, 0); PG8_SCHED; PG8_LDA(At, 0, 0); PG8_STAGE(PG8_SA(1, 1), a1 + hstepA, voffA); \
            PG8_WAIT_L(8); PG8_BAR; PG8_WAIT_L(0); PG8_MMA(0, 0, At, B0); PG8_BAR; PG8_SCHED; \
            PG8_LDB(B1, 0, 1); PG8_STAGE(PG8_SB(0, 0), b2, voffB); \
            PG8_BAR; PG8_WAIT_L(0); PG8_MMA(0, 1, At, B1); PG8_BAR; \
            PG8_LDA(At, 0, 1); PG8_STAGE(PG8_SA(0, 0), a2, voffA); \
            PG8_BAR; PG8_WAIT_L(0); PG8_MMA(1, 0, At, B0); PG8_BAR; PG8_SCHED; \
            PG8_STAGE(PG8_SB(0, 1), b2 + hstepB, voffB); \
            PG8_WAIT_V(6); PG8_BAR; PG8_MMA(1, 1, At, B1); PG8_BAR; \
            PG8_LDB(B0, 1, 0); PG8_SCHED; PG8_LDA(At, 1, 0); PG8_STAGE(PG8_SA(0, 1), a2 + hstepA, voffA); \
            PG8_WAIT_L(8); PG8_BAR; PG8_WAIT_L(0); PG8_MMA(0, 0, At, B0); PG8_BAR; PG8_SCHED; \
            PG8_LDB(B1, 1, 1); PG8_STAGE(PG8_SB(1, 0), b3, voffB); \
            PG8_BAR; PG8_WAIT_L(0); PG8_MMA(0, 1, At, B1); PG8_BAR; \
            PG8_LDA(At, 1, 1); PG8_STAGE(PG8_SA(1, 0), a3, voffA); \
            PG8_BAR; PG8_WAIT_L(0); PG8_MMA(1, 0, At, B0); PG8_BAR; PG8_SCHED; \
            PG8_STAGE(PG8_SB(1, 1), b3 + hstepB, voffB); \
            PG8_WAIT_V(6); PG8_BAR; PG8_MMA(1, 1, At, B1); PG8_BAR; \
            } \
        }
template <class Epi, class Sched, bool ALIGN_EPI = false, bool SP2 = false, bool HALVES = false>
__device__ __forceinline__ void gemm_phase(PG8_LAS unsigned char* lds, const Gemm g, const Sched& S, const Epi& E, const int wid, volatile PG8_LAS unsigned* stp = nullptr) {
#define GST(i) do { if (stp && threadIdx.x == 0) stp[i] = (unsigned)__builtin_amdgcn_s_memrealtime(); } while (0)
    GST(0);
    int fr_, fq_; fresh_lane(fr_, fq_);
    const int lane = fq_ * 16 + fr_, tid = wid * 64 + lane, wr = wid >> 2, wc = wid & 3, fr = lane & 15, fq = lane >> 4;
    const int K = g.K, nt = K / BK, lda = g.lda;
    unsigned voffA[2], voffB[2];
#pragma unroll
    for (int i = 0; i < 2; ++i) { int R_, C; stage_rc(tid * 16 + i * 8192, R_, C); const int Rb = Epi::PERM ? ((R_ & ~31) + perm32(R_ & 31)) : R_;
        voffA[i] = (unsigned)(R_ * lda + C) * 2u; voffB[i] = (unsigned)(Rb * K + C) * 2u; }
    const size_t kstep = (size_t)(BK * 2);
    const size_t hstepA = (size_t)HALF * lda * 2, hstepB = (size_t)HALF * K * 2, tstepB = 2 * hstepB;
    const unsigned ldsw = (unsigned)wid * 1024u;
    const int aoff = lds_byte(wr * 64 + fr, fq * 8), boff = lds_byte(wc * 32 + fr, fq * 8);
#define PG8_SA(b, h) (((b) * 2 + (h)) * HTB)
#define PG8_SB(b, h) ((4 + (b) * 2 + (h)) * HTB)
#define PG8_STAGE(bufoff, gbase, voff) do { _Pragma("unroll") for (int _i = 0; _i < 2; ++_i) \
        __builtin_amdgcn_global_load_lds((const unsigned*)((const char*)(gbase) + (voff)[_i]), (PG8_LAS unsigned*)(lds + (bufoff) + ldsw + _i * 8192), 16, 0, 0); } while (0)
#define PG8_LDA(dst, b, h) do { _Pragma("unroll") for (int m = 0; m < 4; ++m) _Pragma("unroll") for (int k = 0; k < 2; ++k) dst[m][k] = *(const PG8_LAS bf16x8*)(lds + PG8_SA(b, h) + aoff + m * 2048 + k * 1024); } while (0)
#define PG8_LDB(dst, b, h) do { _Pragma("unroll") for (int n = 0; n < 2; ++n) _Pragma("unroll") for (int k = 0; k < 2; ++k) dst[n][k] = *(const PG8_LAS bf16x8*)(lds + PG8_SB(b, h) + boff + n * 2048 + k * 1024); } while (0)
#define PG8_MMA(ai, bj, At, Bt) do { __builtin_amdgcn_s_setprio(1); _Pragma("unroll") for (int m = 0; m < 4; ++m) _Pragma("unroll") for (int n = 0; n < 2; ++n) _Pragma("unroll") for (int k = 0; k < 2; ++k) \
        acc[ai][bj][m][n] = __builtin_amdgcn_mfma_f32_16x16x32_bf16(Bt[n][k], At[m][k], acc[ai][bj][m][n], 0, 0, 0); __builtin_amdgcn_s_setprio(0); } while (0)
#define PG8_WAIT_V(n) asm volatile("s_waitcnt vmcnt(" #n ")" ::: "memory")
#define PG8_WAIT_L(n) asm volatile("s_waitcnt lgkmcnt(" #n ")" ::: "memory")
#define PG8_BAR __builtin_amdgcn_s_barrier()
#define PG8_SCHED __builtin_amdgcn_sched_barrier(0)
#define PG8_APTR(u_) ((const char*)g.A + ((size_t)rowbase((u_).pm) * lda + (size_t)(u_).pn * g.acolstep) * 2)
#define PG8_BPTR(u_) ((const char*)g.Bt + (size_t)(u_).pn * tstepB)
    Unit cur, nxt; int ui = 0;
    if (!S.next(0, cur)) return;
    f32x4 acc[2][2][4][2];
#pragma unroll
    for (int a = 0; a < 2; ++a)
#pragma unroll
        for (int b = 0; b < 2; ++b)
#pragma unroll
            for (int m = 0; m < 4; ++m)
#pragma unroll
                for (int n = 0; n < 2; ++n) acc[a][b][m][n] = (f32x4){0.f, 0.f, 0.f, 0.f};
    bf16x8 At[4][2], B0[2][2], B1[2][2];
    const char* cA = PG8_APTR(cur); const char* cB = PG8_BPTR(cur);
    S.a_ready(cur);
    if constexpr (SP2) {
        PG8_STAGE(PG8_SB(0, 0), cB, voffB); PG8_STAGE(PG8_SB(0, 1), cB + hstepB, voffB); PG8_STAGE(PG8_SA(0, 0), cA, voffA); PG8_STAGE(PG8_SA(0, 1), cA + hstepA, voffA);
        if (wr == 1) PG8_BAR;
        PG8_WAIT_V(2); PG8_BAR;
        PG8_STAGE(PG8_SB(1, 0), cB + kstep, voffB); PG8_STAGE(PG8_SA(1, 0), cA + kstep, voffA); PG8_STAGE(PG8_SB(1, 1), cB + hstepB + kstep, voffB);
        PG8_WAIT_V(6); PG8_BAR;
    } else {
        PG8_STAGE(PG8_SB(0, 0), cB, voffB); PG8_STAGE(PG8_SA(0, 0), cA, voffA); PG8_STAGE(PG8_SB(0, 1), cB + hstepB, voffB); PG8_STAGE(PG8_SA(0, 1), cA + hstepA, voffA);
        if (wr == 1) PG8_BAR;
        PG8_WAIT_V(4); PG8_BAR;
        PG8_STAGE(PG8_SB(1, 0), cB + kstep, voffB); PG8_STAGE(PG8_SA(1, 0), cA + kstep, voffA); PG8_STAGE(PG8_SB(1, 1), cB + hstepB + kstep, voffB);
        PG8_WAIT_V(6); PG8_BAR;
    }
    GST(1);
    for (;;) {
        const bool has_next = S.next(ui + 1, nxt);
        const char* nA = has_next ? PG8_APTR(nxt) : cA; const char* nB = has_next ? PG8_BPTR(nxt) : cB;
        if constexpr (HALVES) { if (cur.hm == 3) { PG8_KLOOP(true, true) } else if (cur.hm == 1) { PG8_KLOOP(true, false) } else { PG8_KLOOP(false, true) } }
        else { PG8_KLOOP(true, true) }
        if constexpr (ALIGN_EPI) { if (wr == 0) PG8_BAR; }
        GST(2);
        if constexpr (!Epi::AFTER_DRAIN) { E(acc, cur, wr, wc, fr, fq); S.done(cur); }
        GST(3);
        if (!has_next) break;
#pragma unroll
        for (int a = 0; a < 2; ++a)
#pragma unroll
            for (int b = 0; b < 2; ++b)
#pragma unroll
                for (int m = 0; m < 4; ++m)
#pragma unroll
                    for (int n = 0; n < 2; ++n) acc[a][b][m][n] = (f32x4){0.f, 0.f, 0.f, 0.f};
        cur = nxt; cA = nA; cB = nB; ++ui;
        if constexpr (ALIGN_EPI) { if (wr == 1) PG8_BAR; }
    }
    if constexpr (Epi::AFTER_DRAIN) {
        u32x4 pre[2][4][2]; E.prefetch(cur, wr, wc, pre);
        PG8_WAIT_V(0);
        if constexpr (!ALIGN_EPI) { if (wr == 0) PG8_BAR; }
        PG8_BAR;
        GST(4);
        E.fused(acc, cur, wr, wc, fr, fq, lds, wid, lane, pre); S.done(cur);
    } else {
    PG8_WAIT_V(0);
    if constexpr (!ALIGN_EPI) { if (wr == 0) PG8_BAR; }
    PG8_BAR;
    GST(4);
    }
    GST(5);
#undef GST
#undef PG8_SA
#undef PG8_SB
#undef PG8_STAGE
#undef PG8_LDA
#undef PG8_LDB
#undef PG8_MMA
#undef PG8_WAIT_V
#undef PG8_WAIT_L
#undef PG8_BAR
#undef PG8_SCHED
#undef PG8_APTR
#undef PG8_BPTR
}
template <class Epi0, class Epi1, class Sched0, class Sched1>
__device__ __forceinline__ void gemm_phase2(PG8_LAS unsigned char* lds, const Gemm g0, const Gemm g1, const Sched0& S0, const Sched1& S1, const Epi0& E0, const Epi1& E1, const int wid) {
    static_assert(Epi0::PERM && Epi1::PERM && !Epi0::AFTER_DRAIN && !Epi1::AFTER_DRAIN, "gemm_phase2: in-loop PERM epilogues");
    int fr_, fq_; fresh_lane(fr_, fq_);
    const int lane = fq_ * 16 + fr_, tid = wid * 64 + lane, wr = wid >> 2, wc = wid & 3, fr = lane & 15, fq = lane >> 4;
    const int lda = g0.lda;
    unsigned voffA[2], voffB0[2], voffB1[2];
#pragma unroll
    for (int i = 0; i < 2; ++i) { int R_, C; stage_rc(tid * 16 + i * 8192, R_, C); const int Rb = (R_ & ~31) + perm32(R_ & 31);
        voffA[i] = (unsigned)(R_ * lda + C) * 2u; voffB0[i] = (unsigned)(Rb * g0.K + C) * 2u; voffB1[i] = (unsigned)(Rb * g1.K + C) * 2u; }
    const size_t kstep = (size_t)(BK * 2), hstepA = (size_t)HALF * lda * 2;
    const unsigned ldsw = (unsigned)wid * 1024u;
    const int aoff = lds_byte(wr * 64 + fr, fq * 8), boff = lds_byte(wc * 32 + fr, fq * 8);
#define PG8_SA(b, h) (((b) * 2 + (h)) * HTB)
#define PG8_SB(b, h) ((4 + (b) * 2 + (h)) * HTB)
#define PG8_STAGEA(bufoff, gbase) do { _Pragma("unroll") for (int _i = 0; _i < 2; ++_i) \
        __builtin_amdgcn_global_load_lds((const unsigned*)((const char*)(gbase) + voffA[_i]), (PG8_LAS unsigned*)(lds + (bufoff) + ldsw + _i * 8192), 16, 0, 0); } while (0)
#define PG8_STAGEB(bufoff, gbase, sg) do { _Pragma("unroll") for (int _i = 0; _i < 2; ++_i) \
        __builtin_amdgcn_global_load_lds((const unsigned*)((const char*)(gbase) + ((sg) ? voffB1[_i] : voffB0[_i])), (PG8_LAS unsigned*)(lds + (bufoff) + ldsw + _i * 8192), 16, 0, 0); } while (0)
#define PG8_LDA(dst, b, h) do { _Pragma("unroll") for (int m = 0; m < 4; ++m) _Pragma("unroll") for (int k = 0; k < 2; ++k) dst[m][k] = *(const PG8_LAS bf16x8*)(lds + PG8_SA(b, h) + aoff + m * 2048 + k * 1024); } while (0)
#define PG8_LDB(dst, b, h) do { _Pragma("unroll") for (int n = 0; n < 2; ++n) _Pragma("unroll") for (int k = 0; k < 2; ++k) dst[n][k] = *(const PG8_LAS bf16x8*)(lds + PG8_SB(b, h) + boff + n * 2048 + k * 1024); } while (0)
#define PG8_MMA(ai, bj, At, Bt) do { __builtin_amdgcn_s_setprio(1); _Pragma("unroll") for (int m = 0; m < 4; ++m) _Pragma("unroll") for (int n = 0; n < 2; ++n) _Pragma("unroll") for (int k = 0; k < 2; ++k) \
        acc[ai][bj][m][n] = __builtin_amdgcn_mfma_f32_16x16x32_bf16(Bt[n][k], At[m][k], acc[ai][bj][m][n], 0, 0, 0); __builtin_amdgcn_s_setprio(0); } while (0)
#define PG8_WAIT_V(n) asm volatile("s_waitcnt vmcnt(" #n ")" ::: "memory")
#define PG8_WAIT_L(n) asm volatile("s_waitcnt lgkmcnt(" #n ")" ::: "memory")
#define PG8_BAR __builtin_amdgcn_s_barrier()
#define PG8_SCHED __builtin_amdgcn_sched_barrier(0)
#define PG8_APTR(u_, sg) ((const char*)((sg) ? g1.A : g0.A) + ((size_t)rowbase((u_).pm) * lda + (size_t)(u_).pn * ((sg) ? g1.acolstep : g0.acolstep)) * 2)
#define PG8_BPTR(u_, sg) ((const char*)((sg) ? g1.Bt : g0.Bt) + (size_t)(u_).pn * (size_t)(2 * HALF * 2) * ((sg) ? g1.K : g0.K))
    Unit cur, nxt; int cs, ns, i0 = 0, i1 = 0;
    if (S0.next(0, cur)) { cs = 0; i0 = 1; } else if (S1.next(0, cur)) { cs = 1; i1 = 1; } else return;
    f32x4 acc[2][2][4][2];
#pragma unroll
    for (int a = 0; a < 2; ++a)
#pragma unroll
        for (int b = 0; b < 2; ++b)
#pragma unroll
            for (int m = 0; m < 4; ++m)
#pragma unroll
                for (int n = 0; n < 2; ++n) acc[a][b][m][n] = (f32x4){0.f, 0.f, 0.f, 0.f};
    bf16x8 At[4][2], B0[2][2], B1[2][2];
    const char* cA = PG8_APTR(cur, cs); const char* cB = PG8_BPTR(cur, cs);
    { const size_t hB = (size_t)HALF * (cs ? g1.K : g0.K) * 2;
      PG8_STAGEB(PG8_SB(0, 0), cB, cs); PG8_STAGEB(PG8_SB(0, 1), cB + hB, cs); PG8_STAGEA(PG8_SA(0, 0), cA); PG8_STAGEA(PG8_SA(0, 1), cA + hstepA);
      if (wr == 1) PG8_BAR;
      PG8_WAIT_V(2); PG8_BAR;
      PG8_STAGEB(PG8_SB(1, 0), cB + kstep, cs); PG8_STAGEA(PG8_SA(1, 0), cA + kstep); PG8_STAGEB(PG8_SB(1, 1), cB + hB + kstep, cs);
      PG8_WAIT_V(6); PG8_BAR; }
    for (;;) {
        bool has_next;
        if (cs == 0 && S0.next(i0, nxt)) { has_next = true; ns = 0; ++i0; } else if (S1.next(i1, nxt)) { has_next = true; ns = 1; ++i1; } else { has_next = false; ns = cs; }
        const char* nA = has_next ? PG8_APTR(nxt, ns) : cA; const char* nB = has_next ? PG8_BPTR(nxt, ns) : cB;
        const int nt = (cs ? g1.K : g0.K) / BK;
        const size_t hBc = (size_t)HALF * (cs ? g1.K : g0.K) * 2, hBn = (size_t)HALF * (ns ? g1.K : g0.K) * 2;
#pragma unroll 1
        for (int t = 0; t < nt; t += 2) {
            const bool last = (t == nt - 2);
            const char* a1 = cA + (size_t)(t + 1) * kstep;
            const char* a2 = last ? nA : cA + (size_t)(t + 2) * kstep; const char* b2 = last ? nB : cB + (size_t)(t + 2) * kstep;
            const char* a3 = a2 + kstep; const char* b3 = b2 + kstep;
            const int sg2 = last ? ns : cs; const size_t hB2 = last ? hBn : hBc;
            PG8_LDB(B0, 0, 0); PG8_LDB(B1, 0, 1); PG8_SCHED; PG8_LDA(At, 0, 0); PG8_STAGEA(PG8_SA(1, 1), a1 + hstepA);
            PG8_WAIT_V(8); PG8_WAIT_L(0); PG8_BAR; PG8_MMA(0, 0, At, B0); PG8_MMA(0, 1, At, B1); PG8_BAR; PG8_SCHED;
            PG8_LDA(At, 0, 1); PG8_STAGEB(PG8_SB(0, 0), b2, sg2); PG8_STAGEB(PG8_SB(0, 1), b2 + hB2, sg2); PG8_STAGEA(PG8_SA(0, 0), a2);
            PG8_WAIT_V(8); PG8_WAIT_L(0); PG8_BAR; PG8_MMA(1, 0, At, B0); PG8_MMA(1, 1, At, B1); PG8_BAR; PG8_SCHED;
            PG8_LDB(B0, 1, 0); PG8_LDB(B1, 1, 1); PG8_SCHED; PG8_LDA(At, 1, 0); PG8_STAGEA(PG8_SA(0, 1), a2 + hstepA);
            PG8_WAIT_V(8); PG8_WAIT_L(0); PG8_BAR; PG8_MMA(0, 0, At, B0); PG8_MMA(0, 1, At, B1); PG8_BAR; PG8_SCHED;
            PG8_LDA(At, 1, 1); PG8_STAGEB(PG8_SB(1, 0), b3, sg2); PG8_STAGEB(PG8_SB(1, 1), b3 + hB2, sg2); PG8_STAGEA(PG8_SA(1, 0), a3);
            PG8_WAIT_V(8); PG8_WAIT_L(0); PG8_BAR; PG8_MMA(1, 0, At, B0); PG8_MMA(1, 1, At, B1); PG8_BAR; PG8_SCHED;
        }
        if (wr == 0) PG8_BAR;
        if (cs == 0) E0(acc, cur, wr, wc, fr, fq); else E1(acc, cur, wr, wc, fr, fq);
        if (!has_next) break;
#pragma unroll
        for (int a = 0; a < 2; ++a)
#pragma unroll
            for (int b = 0; b < 2; ++b)
#pragma unroll
                for (int m = 0; m < 4; ++m)
#pragma unroll
                    for (int n = 0; n < 2; ++n) acc[a][b][m][n] = (f32x4){0.f, 0.f, 0.f, 0.f};
        cur = nxt; cs = ns; cA = nA; cB = nB;
        if (wr == 1) PG8_BAR;
    }
    PG8_WAIT_V(0);
    PG8_BAR;
#undef PG8_SA
#undef PG8_SB
#undef PG8_STAGEA
#undef PG8_STAGEB
#undef PG8_LDA
#undef PG8_LDB
#undef PG8_MMA
#undef PG8_WAIT_V
#undef PG8_WAIT_L
#undef PG8_BAR
#undef PG8_SCHED
#undef PG8_APTR
#undef PG8_BPTR
}
}
#define PG8_SP2 true
#define PG8_ALIGN true

__device__ __forceinline__ int fresh_lane_id() { unsigned m1 = ~0u; asm volatile("" : "+s"(m1)); return (int)__builtin_amdgcn_mbcnt_hi(m1, __builtin_amdgcn_mbcnt_lo(m1, 0u)); }
namespace attn {
using bf16x8 = __attribute__((ext_vector_type(8))) short;
using s16x4 = __attribute__((ext_vector_type(4))) short;
using f32x16 = __attribute__((ext_vector_type(16))) float;
using u32x4 = __attribute__((ext_vector_type(4))) unsigned;
constexpr int NW = 8, QBLK = 32, QB = 256, KVBLK = 64;
constexpr int KSLOT = 12288, VSLOT = 8192, NSLOT = 3;
constexpr int LDS_K = 0, LDS_V = NSLOT * KSLOT, LDS_WS = LDS_V + NSLOT * VSLOT, LDS_QF = LDS_WS + NW * 64 * 4, QF_BYTES = 6144, LDS_BYTES = LDS_QF + NW * QF_BYTES;
__device__ __forceinline__ int crow(int r, int hi) { return (r & 3) + 8 * (r >> 2) + 4 * hi; }
#define SBAR() __builtin_amdgcn_sched_barrier(0)
__device__ __forceinline__ void cmask(f32x16& p0, f32x16& p1, int jb, int qrel, int hi) {
    const float NEG = -INFINITY; const int kb = 64 * jb - NMETA + 4 * hi;
#pragma unroll
    for (int r = 0; r < 16; ++r) { const int kv = kb + (r & 3) + 8 * (r >> 2); if (kv > qrel) p0[r] = NEG; if (kv + 32 > qrel) p1[r] = NEG; }
}
__device__ __forceinline__ void glds16(const void* gsrc, unsigned lds_dst) { unsigned keep;
    asm volatile("s_mov_b32 %0, m0\n\ts_mov_b32 m0, %2\n\ts_nop 0\n\tglobal_load_lds_dwordx4 %1, off\n\ts_mov_b32 m0, %0" : "=&s"(keep) : "v"(gsrc), "s"(lds_dst) : "memory"); }
__device__ __forceinline__ float max3f(float a, float b, float c) { float r; asm("v_max3_f32 %0, %1, %2, %3" : "=v"(r) : "v"(a), "v"(b), "v"(c)); return r; }
__device__ __forceinline__ float max2f(float a, float b) { float r; asm("v_max_f32_e32 %0, %1, %2" : "=v"(r) : "v"(a), "v"(b)); return r; }
__device__ __forceinline__ float fadd_s(float a, float b) { float r; asm("v_add_f32_e32 %0, %1, %2" : "=v"(r) : "v"(a), "v"(b)); return r; }
__device__ __forceinline__ float fsub_s(float a, float b) { float r; asm("v_sub_f32_e32 %0, %1, %2" : "=v"(r) : "v"(a), "v"(b)); return r; }
typedef float f32x2_t __attribute__((ext_vector_type(2))); typedef __bf16 bf16x2_t __attribute__((ext_vector_type(2)));
__device__ __forceinline__ unsigned cvtpk_s(float lo, float hi) { f32x2_t v = {lo, hi}; bf16x2_t b = __builtin_convertvector(v, bf16x2_t); return __builtin_bit_cast(unsigned, b); }
template <int N> __device__ __forceinline__ void wait_bar() { asm volatile("s_waitcnt vmcnt(%0) lgkmcnt(0)\n\ts_barrier" :: "n"(N) : "memory"); }
#define WAITB(nk, nv) do { if (w2) wait_bar<2 * (nk) + (nv)>(); else wait_bar<(nk) + (nv)>(); } while (0)
typedef __attribute__((address_space(3))) const char* lds_cptr;
typedef short v4i16_t __attribute__((ext_vector_type(4)));
#define LDSV(p) (*(const __attribute__((address_space(3))) bf16x8*)(p))
__device__ __forceinline__ void kload12(bf16x8* kf, lds_cptr kp) {
#pragma unroll
    for (int j = 0; j < 6; ++j) { kf[2 * j] = LDSV(kp + j * 2048); kf[2 * j + 1] = LDSV(kp + j * 2048 + 512); }
}
__device__ __forceinline__ void kload2(bf16x8* kf, lds_cptr kp, int j) { kf[2 * j] = LDSV(kp + j * 2048); kf[2 * j + 1] = LDSV(kp + j * 2048 + 512); }
__device__ __forceinline__ s16x4 vtr(lds_cptr p) { return __builtin_bit_cast(s16x4, __builtin_amdgcn_ds_read_tr16_b64_v4i16((__attribute__((address_space(3))) v4i16_t*)p)); }
__device__ __forceinline__ float rowmax(const f32x16& p0, const f32x16& p1) {
    float a = max3f(p0[0], p0[1], p1[0]), b = max3f(p0[2], p0[3], p1[1]); a = max3f(a, p1[2], p1[3]);
#pragma unroll
    for (int r = 4; r < 16; r += 4) { a = max3f(a, p0[r], p0[r + 1]); b = max3f(b, p0[r + 2], p0[r + 3]); a = max3f(a, p1[r], p1[r + 1]); b = max3f(b, p1[r + 2], p1[r + 3]); }
    const float m = max2f(a, b);
    auto rr = __builtin_amdgcn_permlane32_swap(__float_as_uint(m), __float_as_uint(m), false, false);
    return max2f(__uint_as_float(rr[0]), __uint_as_float(rr[1]));
}
__device__ __forceinline__ void pv(f32x16* o, int vb, bf16x8 pa0, bf16x8 pa1, bf16x8 pa2, bf16x8 pa3) {
#pragma unroll
    for (int d0 = 0; d0 < 2; ++d0) { s16x4 lo[4], hi[4];
#pragma unroll
        for (int ks = 0; ks < 4; ++ks) {
            asm volatile("ds_read_b64_tr_b16 %0,%1 offset:%c2" : "=&v"(lo[ks]) : "v"(vb), "i"(d0 * 4096 + ks * 1024) : "memory");
            asm volatile("ds_read_b64_tr_b16 %0,%1 offset:%c2" : "=&v"(hi[ks]) : "v"(vb), "i"(d0 * 4096 + ks * 1024 + 512) : "memory"); }
        asm volatile("s_waitcnt lgkmcnt(0)" ::: "memory"); SBAR();
#define PK(k) (bf16x8){lo[k][0], lo[k][1], lo[k][2], lo[k][3], hi[k][0], hi[k][1], hi[k][2], hi[k][3]}
        o[d0] = __builtin_amdgcn_mfma_f32_32x32x16_bf16(pa0, PK(0), o[d0], 0, 0, 0);
        o[d0] = __builtin_amdgcn_mfma_f32_32x32x16_bf16(pa1, PK(1), o[d0], 0, 0, 0);
        o[d0] = __builtin_amdgcn_mfma_f32_32x32x16_bf16(pa2, PK(2), o[d0], 0, 0, 0);
        o[d0] = __builtin_amdgcn_mfma_f32_32x32x16_bf16(pa3, PK(3), o[d0], 0, 0, 0);
#undef PK
    }
}
template <int THRL> __device__ __forceinline__ void attn_unit(int b, int h, int qb, const bf16* Q, const bf16* __restrict__ K, const bf16* __restrict__ V, bf16* Y, char* shm, const int wid) {
    const int lane = fresh_lane_id(), r32 = lane & 31, hi = lane >> 5;
    const long krow0 = (long)b * L; const int q0 = NMETA + qb * QB;
    const bf16* Qw = Q + (krow0 + q0 + wid * QBLK) * QP + h * QKD;
    const bf16* Vh = V + krow0 * VP + h * VD; const unsigned char* Kh = (const unsigned char*)K + (size_t)((b * NH + h) * KT_N) * KT_BYTES;
    const unsigned lds0 = (unsigned)(uintptr_t)shm;
    float* wsf = (float*)(shm + LDS_WS) + wid * 64;
    const bool w2 = wid < 4;
    const unsigned char* ksrc = Kh + wid * 1024 + lane * 16;
    const bf16* vsrc = Vh + (long)(16 * (wid & 3) + (lane >> 2)) * VP + (wid >> 2) * 32 + (lane & 3) * 8;
    const unsigned kdst = lds0 + LDS_K + wid * 1024, vdst = lds0 + LDS_V + wid * 1024;
#define KS(sl) ((sl) + ((sl) >> 1))
#define DMA_K(t, sl) do { glds16(ksrc + (size_t)(t) * KT_BYTES, (unsigned)__builtin_amdgcn_readfirstlane(kdst + KS(sl))); \
        if (w2) glds16(ksrc + 8192 + (size_t)(t) * KT_BYTES, (unsigned)__builtin_amdgcn_readfirstlane(kdst + 8192 + KS(sl))); } while (0)
#define DMA_V(t, sl) glds16(vsrc + (long)(t) * KVBLK * VP, (unsigned)__builtin_amdgcn_readfirstlane(vdst + (sl)))
    const int vb0 = (int)(lds0 + LDS_V) + ((lane >> 4) & 1) * 32 + (lane & 3) * 8 + (4 * hi + ((lane & 15) >> 2)) * 64;
    const char* Kbase = shm + LDS_K; bf16x8 kf[12];
    const lds_cptr shm3 = (lds_cptr)shm; const lds_cptr kp0 = shm3 + LDS_K + hi * 1024 + r32 * 16; const lds_cptr vp0 = shm3 + LDS_V + ((lane >> 4) & 1) * 32 + (lane & 3) * 8 + (4 * hi + ((lane & 15) >> 2)) * 64;
    const lds_cptr qfp = shm3 + LDS_QF + wid * QF_BYTES + lane * 16;
#define QF(d0) LDSV(qfp + (d0) * 1024)
    const int NT = 4 * qb + 5;
    DMA_K(0, 0); DMA_V(0, 0); DMA_K(1, VSLOT);
    {
        bf16x8 qt[6];
#pragma unroll
        for (int d0 = 0; d0 < 6; ++d0) qt[d0] = *(const GAS bf16x8*)(&Qw[(long)r32 * QP + d0 * 16 + hi * 8]);
#pragma unroll
        for (int d0 = 0; d0 < 6; ++d0) *(__attribute__((address_space(3))) bf16x8*)(shm3 + LDS_QF + wid * QF_BYTES + lane * 16 + d0 * 1024) = qt[d0];
    }
    float mhat = 0.f, l_reg = 0.f; f32x16 o[2]; o[0] = f32x16{}; o[1] = f32x16{}; f32x16 negm = f32x16{}; asm volatile("" : "+v"(negm));
    const int qrel = wid * QBLK + r32;
#define CMASK(P0, P1, t) do { int jb_ = (t) - (NT - 5); if (jb_ >= 0) cmask(P0, P1, jb_, qrel, hi); } while (0)
    bool resc = false;
#define START(P0, P1) do { const float rm = rowmax(P0, P1); resc = false; \
    { const float dl = rm; mhat = fadd_s(mhat, dl); \
      _Pragma("unroll") for (int r = 0; r < 16; ++r) { P0[r] = fsub_s(P0[r], dl); P1[r] = fsub_s(P1[r], dl); } \
      _Pragma("unroll") for (int r = 0; r < 16; ++r) negm[r] = -mhat; asm volatile("" : "+v"(negm)); } \
    _Pragma("unroll") for (int r = 0; r < 16; ++r) P0[r] = __builtin_amdgcn_exp2f(P0[r]); } while (0)
#define RESC() do { if (resc) { asm volatile("s_waitcnt lgkmcnt(0)" ::: "memory"); \
      _Pragma("unroll") for (int d_ = 0; d_ < 2; ++d_) _Pragma("unroll") for (int r = 0; r < 16; ++r) o[d_][r] *= wsf[crow(r, hi)]; } } while (0)
    f32x16 pA0, pA1, pB0, pB1;
    int sl_prev = 0, sl_cur = 0, sl_next = VSLOT;
#define ROT() do { sl_prev = sl_cur; sl_cur = sl_next; sl_next = (sl_next == (NSLOT - 1) * VSLOT) ? 0 : sl_next + VSLOT; } while (0)
    DMA_K(2, 2 * VSLOT);
    WAITB(2, 1);
    {
        const char* kb = Kbase + hi * 1024 + r32 * 16;
#pragma unroll
        for (int d0 = 0; d0 < 6; ++d0) { const bf16x8 b0 = *reinterpret_cast<const bf16x8*>(kb + d0 * 2048), b1 = *reinterpret_cast<const bf16x8*>(kb + d0 * 2048 + 512); const bf16x8 qv = QF(d0);
            if (d0 == 0) { pA0 = __builtin_amdgcn_mfma_f32_32x32x16_bf16(b0, qv, negm, 0, 0, 0); pA1 = __builtin_amdgcn_mfma_f32_32x32x16_bf16(b1, qv, negm, 0, 0, 0); }
            else { pA0 = __builtin_amdgcn_mfma_f32_32x32x16_bf16(b0, qv, pA0, 0, 0, 0); pA1 = __builtin_amdgcn_mfma_f32_32x32x16_bf16(b1, qv, pA1, 0, 0, 0); } }
    }
    asm volatile("s_nop 15\n\ts_nop 7" : "+v"(pA0), "+v"(pA1)); CMASK(pA0, pA1, 0);
    START(pA0, pA1);
    _Pragma("unroll") for (int r = 0; r < 16; ++r) pA1[r] = __builtin_amdgcn_exp2f(pA1[r]);
    WAITB(0, 0);
    DMA_K(3, 0); DMA_V(1, VSLOT);
    ROT();
    kload12(kf, kp0 + KS(sl_cur));
    WAITB(1, 1);
    s16x4 vlo[8], vhi[8]; u32x4 pw0, pw1, pw2, pw3; bf16x8 qa, qb_;
#define PKW(P, B) cvtpk_s(P[B], P[B + 1])
#define PAF(k) __builtin_bit_cast(bf16x8, pw##k)
#define VFR(i) (bf16x8){vlo[i][0], vlo[i][1], vlo[i][2], vlo[i][3], vhi[i][0], vhi[i][1], vhi[i][2], vhi[i][3]}
#define PIN(x) asm volatile("" : "+v"(x))
#define MX3(a, b, c) __builtin_fmaxf(__builtin_fmaxf((a), (b)), (c))
#define MF(c, a, b, cc) c = __builtin_amdgcn_mfma_f32_32x32x16_bf16(a, b, cc, 0, 0, 0)
#define GAPA(MFS, A0, A1, A2, A3, W0, W1, PW) do { MFS; sacc += A0; sacc += A1; sacc += A2; sacc += A3; PIN(sacc); W0; W1; PIN(PW); SBAR(); } while (0)
#define GAPM(MFS) do { MFS; SBAR(); } while (0)
#define EX(v) __builtin_amdgcn_exp2f(v)
#define GAPB(MFS, X, B) do { MFS; X[B] = EX(X[B]); X[B + 1] = EX(X[B + 1]); X[B + 2] = EX(X[B + 2]); X[B + 3] = EX(X[B + 3]); PIN(X); SBAR(); } while (0)
#define VRD(i) do { vlo[i] = vtr(vp_ + (((i) >> 2) * 4096 + ((i) & 3) * 1024)); vhi[i] = vtr(vp_ + (((i) >> 2) * 4096 + ((i) & 3) * 1024 + 512)); } while (0)
#define KRD(G, j) do { if (G) { kload2(kf, kp0 + KS(sl_next), j); SBAR(); } } while (0)
#define STEP(C0, C1, P0, P1, t, GK, GV, GL) do { SBAR(); \
    const lds_cptr vp_ = vp0 + sl_prev; \
    qa = QF(0); qb_ = QF(1); \
    VRD(0); SBAR(); float sacc = (P0[0] + P0[1]); \
    GAPA(MF(C0, kf[0], qa, negm), P0[2], P0[3], P0[4], P0[5],     pw0[0] = PKW(P0, 0), pw0[1] = PKW(P0, 2), pw0); \
    VRD(4); SBAR(); GAPA(MF(C1, kf[1], qa, negm), P0[6], P0[7], P0[8], P0[9],     pw0[2] = PKW(P0, 4), pw0[3] = PKW(P0, 6), pw0); \
    qa = QF(2); \
    VRD(1); SBAR(); GAPA(MF(C0, kf[2], qb_, C0),  P0[10], P0[11], P0[12], P0[13], pw1[0] = PKW(P0, 8), pw1[1] = PKW(P0, 10), pw1); \
    VRD(5); SBAR(); GAPA(MF(C1, kf[3], qb_, C1),  P0[14], P0[15], P1[0], P1[1],   pw1[2] = PKW(P0, 12), pw1[3] = PKW(P0, 14), pw1); \
    qb_ = QF(3); \
    VRD(2); SBAR(); GAPA(MF(C0, kf[4], qa, C0),   P1[2], P1[3], P1[4], P1[5],     pw2[0] = PKW(P1, 0), pw2[1] = PKW(P1, 2), pw2); \
    VRD(6); SBAR(); GAPA(MF(C1, kf[5], qa, C1),   P1[6], P1[7], P1[8], P1[9],     pw2[2] = PKW(P1, 4), pw2[3] = PKW(P1, 6), pw2); \
    qa = QF(4); \
    VRD(3); SBAR(); GAPA(MF(C0, kf[6], qb_, C0),  P1[10], P1[11], P1[12], P1[13], pw3[0] = PKW(P1, 8), pw3[1] = PKW(P1, 10), pw3); \
    VRD(7); SBAR(); GAPA(MF(C1, kf[7], qb_, C1),  P1[14], P1[15], 0.f, 0.f,       pw3[2] = PKW(P1, 12), pw3[3] = PKW(P1, 14), pw3); \
    qb_ = QF(5); \
    GAPM(MF(C0, kf[8], qa, C0)); GAPM(MF(C1, kf[9], qa, C1)); GAPM(MF(C0, kf[10], qb_, C0)); GAPM(MF(C1, kf[11], qb_, C1)); \
    l_reg += sacc; \
    if (GK) { DMA_K((t) + 3, sl_cur); } if (GV) { DMA_V((t) + 1, sl_next); } \
    CMASK(C0, C1, t); \
    { float a = MX3(C0[0], C0[1], C1[0]), b = MX3(C0[2], C0[3], C1[1]); a = MX3(a, C1[2], C1[3]); \
      _Pragma("unroll") for (int r = 4; r < 16; r += 4) { a = MX3(a, C0[r], C0[r + 1]); b = MX3(b, C0[r + 2], C0[r + 3]); a = MX3(a, C1[r], C1[r + 1]); b = MX3(b, C1[r + 2], C1[r + 3]); } \
      float rm = __builtin_fmaxf(a, b); { auto rr = __builtin_amdgcn_permlane32_swap(__float_as_uint(rm), __float_as_uint(rm), false, false); rm = __builtin_fmaxf(__uint_as_float(rr[0]), __uint_as_float(rr[1])); } \
      resc = false; \
      if (__builtin_expect(__any(rm > (float)THRL), 0)) { const float dl = __builtin_fmaxf(rm, 0.f); mhat += dl; \
        _Pragma("unroll") for (int r = 0; r < 16; ++r) { C0[r] -= dl; C1[r] -= dl; } \
        _Pragma("unroll") for (int r = 0; r < 16; ++r) negm[r] = -mhat; asm volatile("" : "+v"(negm)); \
        const float f = __builtin_amdgcn_exp2f(-dl); l_reg *= f; if (hi == 0) wsf[r32] = f; resc = true; } } \
    SBAR(); \
    GAPB(MF(o[0], PAF(0), VFR(0), o[0]), C0, 0); \
    KRD(GL, 0); GAPB(MF(o[1], PAF(0), VFR(4), o[1]), C0, 4); \
    KRD(GL, 1); GAPB(MF(o[0], PAF(1), VFR(1), o[0]), C0, 8); \
    KRD(GL, 2); GAPB(MF(o[1], PAF(1), VFR(5), o[1]), C0, 12); \
    KRD(GL, 3); GAPB(MF(o[0], PAF(2), VFR(2), o[0]), C1, 0); \
    KRD(GL, 4); GAPB(MF(o[1], PAF(2), VFR(6), o[1]), C1, 4); \
    KRD(GL, 5); GAPB(MF(o[0], PAF(3), VFR(3), o[0]), C1, 8); \
    GAPB(MF(o[1], PAF(3), VFR(7), o[1]), C1, 12); \
    } while (0)
    int t = 1;
#undef CMASK
#define CMASK(P0, P1, t) do {} while (0)
    for (; t + 6 < NT; t += 2) {
        STEP(pB0, pB1, pA0, pA1, t, true, true, true);     WAITB(1, 1); RESC(); ROT();
        STEP(pA0, pA1, pB0, pB1, t + 1, true, true, true); WAITB(1, 1); RESC(); ROT();
    }
#undef CMASK
#define CMASK(P0, P1, t) do { int jb_ = (t) - (NT - 5); if (jb_ >= 0) cmask(P0, P1, jb_, qrel, hi); } while (0)
#define ENDW(tt) do { if ((tt) + 3 < NT) { WAITB(1, 1); } else if ((tt) + 2 < NT) { WAITB(0, 1); } else { WAITB(0, 0); } } while (0)
    for (; t + 1 < NT; t += 2) {
        STEP(pB0, pB1, pA0, pA1, t, (t + 3 < NT), (t + 1 < NT), (t + 1 < NT));       ENDW(t);     RESC(); ROT();
        STEP(pA0, pA1, pB0, pB1, t + 1, (t + 4 < NT), (t + 2 < NT), (t + 2 < NT));   ENDW(t + 1); RESC(); ROT();
    }
    {
        float sacc = pA0[0] + pA0[1]; _Pragma("unroll") for (int r = 2; r < 16; ++r) sacc += pA0[r]; _Pragma("unroll") for (int r = 0; r < 16; ++r) sacc += pA1[r]; l_reg += sacc;
        pw0 = (u32x4){PKW(pA0, 0), PKW(pA0, 2), PKW(pA0, 4), PKW(pA0, 6)}; pw1 = (u32x4){PKW(pA0, 8), PKW(pA0, 10), PKW(pA0, 12), PKW(pA0, 14)};
        pw2 = (u32x4){PKW(pA1, 0), PKW(pA1, 2), PKW(pA1, 4), PKW(pA1, 6)}; pw3 = (u32x4){PKW(pA1, 8), PKW(pA1, 10), PKW(pA1, 12), PKW(pA1, 14)};
        SBAR(); pv(o, vb0 + sl_prev, PAF(0), PAF(1), PAF(2), PAF(3));
    }
#undef PKW
#undef PAF
#undef VFR
#undef PIN
#undef MX3
#undef MF
#undef GAPA
#undef GAPM
#undef GAPB
#undef EX
#undef VRD
#undef KRD
#undef STEP
#undef ENDW
    { auto rr = __builtin_amdgcn_permlane32_swap(__float_as_uint(l_reg), __float_as_uint(l_reg), false, false); l_reg = __uint_as_float(rr[0]) + __uint_as_float(rr[1]); }
    if (hi == 0) wsf[32 + r32] = l_reg; asm volatile("s_waitcnt lgkmcnt(0)" ::: "memory");
    float rli[16];
#pragma unroll
    for (int r = 0; r < 16; ++r) rli[r] = __builtin_amdgcn_rcpf(wsf[32 + crow(r, hi)]);
    bf16* Ow = Y + (krow0 + q0 + wid * QBLK) * YP + POOLW + h * VD; const __amdgpu_buffer_rsrc_t rsy = ws_rsrc((unsigned char*)Y);
    { bf16* stg = (bf16*)(shm + LDS_QF + wid * QF_BYTES);
#pragma unroll
      for (int r = 0; r < 16; ++r) { const int orow = crow(r, hi);
#pragma unroll
          for (int d0 = 0; d0 < 2; ++d0) stg[orow * 64 + d0 * 32 + r32] = f2bf(o[d0][r] * rli[r]); }
      asm volatile("s_waitcnt lgkmcnt(0)" ::: "memory");
#pragma unroll
      for (int i = 0; i < 4; ++i) { const int row = i * 8 + (lane >> 3), ch = lane & 7; const u32x4 v = *(const u32x4*)(stg + row * 64 + ch * 8);
          st16_wt(rsy, (size_t)((Ow - Y) + (long)row * YP + ch * 8) * 2, __builtin_bit_cast(wt_u32x4, v)); } }
    asm volatile("s_waitcnt lgkmcnt(0)\n\ts_barrier" ::: "memory");
#undef DMA_K
#undef DMA_V
#undef KS
#undef QF
#undef CMASK
#undef START
#undef RESC
#undef ROT
}
#undef SBAR
#undef WAITB
#undef LDSV
}

constexpr int NWAVES = 8;
constexpr int NPHASE = 1 + 6 * DEPTH;
constexpr int CW_TMO = 0, CW_CODE = 1, CW_ZM = 64, CW_M4 = 256, CW_M5 = 320, CW_BAR = 4096, CW_ZF = 65536, CW_GRP = 131072, CW_YP = 139264, CW_P3D = 147456;
constexpr int _cw_dummy = 0;
constexpr int RING_OFF = 0, RING_BYTES = 131072, LDSCTL_OFF = RING_BYTES, MISC_OFF = LDSCTL_OFF + 320, RST_OFF = MISC_OFF + 1024  , LDS_BYTES = 147456;
typedef unsigned v4u __attribute__((ext_vector_type(4)));
typedef float f32x4 __attribute__((ext_vector_type(4)));
typedef GAS unsigned gu32;
#define RLX_AGENT __ATOMIC_RELAXED, __HIP_MEMORY_SCOPE_AGENT
#define LDS_WAIT() asm volatile("s_waitcnt lgkmcnt(0)" ::: "memory")
#define VM_WAIT() asm volatile("s_waitcnt vmcnt(0)" ::: "memory")

#define XB_TMO      128
#define XB_XCNT(j)  (256  + 64 * (j))
#define XB_XSUB(j)  (1280 + 64 * (j))
#define XB_XGEN(j)  (2304 + 64 * (j))
#define XB_TOP      3328
#define XB_TOPGEN   3392
#define XCD_BAR_WORDS 3456
#define XB_SPIN_CAP (1u << 18)
__device__ __forceinline__ unsigned xb_ld(unsigned* p)              { return __hip_atomic_load((GAS unsigned*)p, __ATOMIC_RELAXED, __HIP_MEMORY_SCOPE_AGENT); }
__device__ __forceinline__ unsigned xb_add(unsigned* p, unsigned v) { return __hip_atomic_fetch_add((GAS unsigned*)p, v, __ATOMIC_RELAXED, __HIP_MEMORY_SCOPE_AGENT); }
__device__ __forceinline__ unsigned xb_xcc_id() { return (unsigned)__builtin_amdgcn_s_getreg((3 << 11) | 20) & 0xFu; }
#define XB_SPIN(cond, bar) do { unsigned _sp = 0; while (cond) { __builtin_amdgcn_s_sleep(1); \
    if ((++_sp & 255u) == 0u) { if (xb_ld(&(bar)[XB_TMO])) break; if (_sp > XB_SPIN_CAP) { xb_add(&(bar)[XB_TMO], 1u); break; } } } } while (0)
struct XcdBarrier { unsigned* bar; unsigned x; volatile LAS unsigned* st; };
__device__ __forceinline__ XcdBarrier xcd_barrier_post(unsigned* bar, volatile LAS unsigned* st) {
    XcdBarrier b; b.bar = bar; b.x = xb_xcc_id(); b.st = st;
    if (threadIdx.x == 0) (void)xb_add(&bar[XB_XCNT(b.x)], 1u);
    return b;
}
__device__ __forceinline__ void xcd_barrier_complete(unsigned* bar, unsigned x, unsigned& nloc, unsigned& nx) {
    const unsigned G = gridDim.x * gridDim.y * gridDim.z;
    unsigned sum, cnt, mine, sp = 0u;
    for (;;) {
        sum = 0u; cnt = 0u; mine = 0u;
#pragma unroll
        for (unsigned j = 0; j < 16; ++j) { const unsigned c = xb_ld(&bar[XB_XCNT(j)]); sum += c; cnt += (c > 0u) ? 1u : 0u; mine = (j == x) ? c : mine; }
        if (sum == G) break;
        __builtin_amdgcn_s_sleep(1);
        if ((++sp & 255u) == 0u) { if (xb_ld(&bar[XB_TMO])) break; if (sp > XB_SPIN_CAP) { xb_add(&bar[XB_TMO], 1u); break; } }
    }
    nloc = mine > 0u ? mine : 1u; nx = cnt > 0u ? cnt : 1u;
}
__device__ __forceinline__ void xcd_barrier(const XcdBarrier& b) {
    asm volatile("s_waitcnt vmcnt(0)" ::: "memory");
    __syncthreads();
    if (threadIdx.x == 0) {
        unsigned* bar = b.bar; unsigned bx = b.x; asm volatile("" : "+s"(bar), "+s"(bx));
        __builtin_amdgcn_s_waitcnt(0);
        unsigned nloc = b.st[0], nx = b.st[1];
        if (nloc == 0u) { xcd_barrier_complete(bar, bx, nloc, nx); b.st[0] = nloc; b.st[1] = nx; }
        const unsigned old = xb_add(&bar[XB_XSUB(bx)], 1u);
        const unsigned gen = old / nloc;
        if (old + 1u == (gen + 1u) * nloc) {
            __builtin_amdgcn_fence(__ATOMIC_RELEASE, "agent");
            asm volatile("s_waitcnt vmcnt(0)" ::: "memory");
            const unsigned og = xb_add(&bar[XB_TOP], 1u);
            const unsigned tgt = (og / nx + 1u) * nx;
            if (og + 1u != tgt) XB_SPIN(xb_ld(&bar[XB_TOP]) < tgt, bar);
            __builtin_amdgcn_fence(__ATOMIC_ACQUIRE, "agent");
            asm volatile("s_waitcnt vmcnt(0)" ::: "memory");
        } else {
            const unsigned tgt = (gen + 1u) * nx;
            XB_SPIN(xb_ld(&bar[XB_TOP]) < tgt, bar);
            __builtin_amdgcn_fence(__ATOMIC_ACQUIRE, "agent");
            asm volatile("s_waitcnt vmcnt(0)" ::: "memory");
        }
    }
    __syncthreads();
}

__device__ __forceinline__ void group_seam(unsigned* grp, unsigned target, unsigned* bar, unsigned* also = nullptr, unsigned also_target = 0u) {
    asm volatile("s_waitcnt vmcnt(0)" ::: "memory");
    __syncthreads();
    if (threadIdx.x == 0) {
        unsigned* w = grp; unsigned tg = target; asm volatile("" : "+s"(w), "+s"(tg));
        (void)xb_add(w, 1u);
        XB_SPIN(xb_ld(w) < tg, bar);
        if (also) { unsigned* w2 = also; unsigned t2 = also_target; asm volatile("" : "+s"(w2), "+s"(t2)); XB_SPIN(xb_ld(w2) < t2, bar); }
        __builtin_amdgcn_fence(__ATOMIC_ACQUIRE, "agent");
        asm volatile("s_waitcnt vmcnt(0)" ::: "memory");
    }
    __syncthreads();
}

__device__ __forceinline__ void wait_count(unsigned* cw, unsigned target, unsigned* bar) {
    if (threadIdx.x == 0) {
        unsigned* w = cw; unsigned tg = target; asm volatile("" : "+s"(w), "+s"(tg));
        XB_SPIN(xb_ld(w) < tg, bar);
        __builtin_amdgcn_fence(__ATOMIC_ACQUIRE, "agent");
        asm volatile("s_waitcnt vmcnt(0)" ::: "memory");
    }
    __syncthreads();
}

struct Frame {
    LAS unsigned char* lds; volatile LAS unsigned* MISC; gu32* ctl;
    int wave, vcu, G;
    const P& p;
    __device__ __forceinline__ int lane() const { return fresh_lane_id(); }
    __device__ __forceinline__ int tid() const { return wave * 64 + fresh_lane_id(); }
};
__device__ __forceinline__ float wave_sum(float v) {
#pragma unroll
    for (int o = 1; o < 64; o <<= 1) v += __shfl_xor(v, o);
    return v;
}
__device__ __forceinline__ void transpose_item(const float* W, int ldw, int k0, int n0, bf16* dst, int ldt, LAS float* scr, int lane, const float* kgain = nullptr) {
    {
        const int kk0 = lane >> 3, c4 = (lane & 7) * 4; f32x4 v[8]; float gk[8];
#pragma unroll
        for (int i = 0; i < 8; ++i) { v[i] = __builtin_nontemporal_load((const GAS f32x4*)(W + (size_t)(k0 + kk0 + 8 * i) * ldw + n0 + c4)); gk[i] = kgain ? kgain[k0 + kk0 + 8 * i] : 1.0f; }
#pragma unroll
        for (int i = 0; i < 8; ++i) { LAS float* d = scr + (kk0 + 8 * i) * 33 + c4; d[0] = v[i][0] * gk[i]; d[1] = v[i][1] * gk[i]; d[2] = v[i][2] * gk[i]; d[3] = v[i][3] * gk[i]; } }
    LDS_WAIT(); asm volatile("" ::: "memory");
    const int c = lane & 7;
#pragma unroll
    for (int j = 0; j < 4; ++j) { const int n = (lane >> 3) + 8 * j; const LAS float* s = scr + (8 * c) * 33 + n;
        v4u o; o.x = pk2(s[0 * 33], s[1 * 33]); o.y = pk2(s[2 * 33], s[3 * 33]); o.z = pk2(s[4 * 33], s[5 * 33]); o.w = pk2(s[6 * 33], s[7 * 33]);
        *(GAS v4u*)(dst + (size_t)n * ldt + 8 * c) = o; }
    LDS_WAIT(); asm volatile("" ::: "memory");
}
__device__ __forceinline__ int rowmap_q(int n0)  { const int head = n0 / 96, e0 = n0 % 96; return e0 < 64 ? 256 * (head >> 2) + 128 * (e0 >> 5) + 32 * (head & 3) : 512 + 128 * (head >> 2) + 32 * (head & 3); }
__device__ __forceinline__ int rowmap_kv(int n0) { const int head = n0 >> 7, e0 = n0 & 127; return e0 < 64 ? 256 * (head >> 2) + 128 * (e0 >> 5) + 32 * (head & 3) : 512 + 256 * (head >> 2) + 128 * ((e0 - 64) >> 5) + 32 * (head & 3); }
constexpr int IT_IN = 16 * 37, IT_Q = 6 * 24, IT_KV = 4 * 32, IT_P = 4 * 8, IT_OUT = 16 * 32, IT_G = 16 * 88, IT_D = 44 * 32;
constexpr int IT_LAYER = IT_IN + IT_Q + IT_KV + IT_P + IT_OUT + 2 * IT_G + IT_D;
__device__ __forceinline__ void conv_range(const P& p, LAS float* scr, int lo, int hi, int widx, int wcnt, int lane) {
    for (int it = lo + widx; it < hi; it += wcnt) {
        const int l = it / IT_LAYER; int r = it % IT_LAYER; unsigned char* wl = p.ws + WS_W + (size_t)l * WL_BYTES;
        if (r < IT_IN) { const int kb = r / 37, nb = r % 37; transpose_item(p.w_in + (size_t)l * D * INW, INW, 64 * kb, 32 * nb, (bf16*)(wl + WO_IN) + (size_t)(32 * nb) * D + 64 * kb, D, scr, lane, p.attn_g + (size_t)l * D); continue; } r -= IT_IN;
        if (r < IT_Q) { const int kb = r / 24, nb = r % 24; transpose_item(p.w_q_b + (size_t)l * QLR * 768, 768, 64 * kb, 32 * nb, (bf16*)(wl + WO_Q) + (size_t)rowmap_q(32 * nb) * QLR + 64 * kb, QLR, scr, lane); continue; } r -= IT_Q;
        if (r < IT_KV) { const int kb = r / 32, nb = r % 32; transpose_item(p.w_kv_b + (size_t)l * KVLR * 1024, 1024, 64 * kb, 32 * nb, (bf16*)(wl + WO_KV) + (size_t)rowmap_kv(32 * nb) * KVLR + 64 * kb, KVLR, scr, lane); continue; } r -= IT_KV;
        if (r < IT_P) { const int g = r >> 3, kb = (r >> 2) & 1, nb = r & 3; transpose_item(p.w_pool + ((size_t)l * 4 + g) * 128 * 128, 128, 64 * kb, 32 * nb, (bf16*)(wl + WO_P) + (size_t)(g * 128 + 32 * nb) * 128 + 64 * kb, 128, scr, lane); continue; } r -= IT_P;
        if (r < IT_OUT) { const int kb = r / 32, nb = r % 32; transpose_item(p.w_out + (size_t)l * D * D, D, 64 * kb, 32 * nb, (bf16*)(wl + WO_OUT) + (size_t)(32 * nb) * D + 64 * kb, D, scr, lane); continue; } r -= IT_OUT;
        if (r < 2 * IT_G) { const int up = r >= IT_G; if (up) r -= IT_G; const int kb = r / 88, nb = r % 88, f0 = 32 * nb;
            transpose_item((up ? p.w_up : p.w_gate) + (size_t)l * D * FF, FF, 64 * kb, f0, (bf16*)(wl + WO_GU) + (size_t)(256 * (f0 >> 7) + 128 * up + (f0 & 127)) * D + 64 * kb, D, scr, lane, p.ffn_g + (size_t)l * D); continue; } r -= 2 * IT_G;
        { const int kb = r / 32, nb = r % 32; transpose_item(p.w_down + (size_t)l * FF * D, D, 64 * kb, 32 * nb, (bf16*)(wl + WO_D) + (size_t)(32 * nb) * FF + 64 * kb, FF, scr, lane); }
    }
}
constexpr int CV0 = IT_IN + IT_Q + IT_KV + IT_P  , CV1 = CV0 + IT_OUT + IT_G  ,
              CV1B = IT_LAYER  , CV2 = IT_LAYER + CV0 + IT_OUT  , CV3 = CV2 + 2 * IT_G  ,
              CV4 = 2 * IT_LAYER  ;
__device__ __forceinline__ void p0_prologue(Frame& F) {
    const P& p = F.p;
    LAS float* scr = (LAS float*)(F.lds + RING_OFF + F.wave * 16384);
    const int gw = F.vcu * NWAVES + F.wave, NGW = F.G * NWAVES, lane = F.lane();
    conv_range(p, scr, 0, CV0, gw, NGW, lane);
    { const int gt = gw * 64 + lane, NGT = NGW * 64; const v4u z4 = {0u, 0u, 0u, 0u};
      for (int i = gt; i < DEPTH * 96 * D / 8; i += NGT) { const int l = i / (96 * D / 8), o = i % (96 * D / 8); *((GAS v4u*)(p.ws + WS_W + (size_t)l * WL_BYTES + WO_IN + (size_t)INW * D * 2) + o) = z4; }
      for (int i = gt; i < 256 * VP / 8; i += NGT) *((GAS v4u*)(p.ws + WS_V + (size_t)R * VP * 2) + i) = z4;
      for (int i = gt; i < L * 16; i += NGT) { const int pos = i >> 4, j = i & 15; const float inv = 1.0f / powf(10000.0f, (float)(2 * j) / 32.0f); const float ang = (float)pos * inv;
          float* t = (float*)(p.ws + WS_ROPE) + (size_t)pos * 32; t[j] = cosf(ang); t[16 + j] = sinf(ang); } }
    for (int i = gw * 64 + lane; i < NMETA * D; i += NGW * 64) ((GAS float*)(p.ws + WS_MINI + MN_HM))[i] = p.meta[i];
    for (int m0 = gw; m0 < MR; m0 += 4 * NGW) {
        f32x4 v[4][4]; float sq[4];
#pragma unroll
        for (int u = 0; u < 4; ++u) { const int m = m0 + u * NGW < MR ? m0 + u * NGW : m0; const GAS f32x4* xr = (const GAS f32x4*)(p.x + (size_t)m * D) + lane;
#pragma unroll
            for (int j = 0; j < 4; ++j) v[u][j] = __builtin_nontemporal_load(xr + 64 * j); }
#pragma unroll
        for (int u = 0; u < 4; ++u) { float s_ = 0.f;
#pragma unroll
            for (int j = 0; j < 4; ++j) s_ += (v[u][j].x * v[u][j].x + v[u][j].y * v[u][j].y) + (v[u][j].z * v[u][j].z + v[u][j].w * v[u][j].w);
            sq[u] = wave_sum(s_); }
#pragma unroll
        for (int u = 0; u < 4; ++u) { const int m = m0 + u * NGW; if (m < MR) { const int krow = rowbase(m >> 8) + (m & 255);
            GAS unsigned long long* o8 = (GAS unsigned long long*)(p.ws + WS_XN + (size_t)krow * D * 2) + lane;
#pragma unroll
            for (int j = 0; j < 4; ++j) o8[64 * j] = (unsigned long long)pk2(v[u][j].x, v[u][j].y) | ((unsigned long long)pk2(v[u][j].z, v[u][j].w) << 32);
            if (lane == 0) *(GAS f32x4*)(p.ws + WS_SSQH + (size_t)krow * 16) = (f32x4){sq[u], 0.f, 0.f, 0.f}; } }
    }
}

__device__ __forceinline__ void krope_item(unsigned char* ws, const float* kn, int item) {
    const int m = item >> 2, c = item & 3;
    const int krow = rowbase(m >> 8) + (m & 255), pos = NMETA + (((m >> 8) & 15) << 8) + (m & 255);
    const v4u zw = *(const GAS v4u*)(ws + WS_Z + ((size_t)krow * ZP + POOLW + QLR + KVLR + 8 * c) * 2);
    const GAS float* t = (const GAS float*)(ws + WS_ROPE) + (size_t)pos * 32 + 8 * (c & 1);
    const f32x4 c0 = *(const GAS f32x4*)t, c1 = *(const GAS f32x4*)(t + 4), s0 = *(const GAS f32x4*)(t + 16), s1 = *(const GAS f32x4*)(t + 20);
    const f32x4 g0 = *(const f32x4*)(kn + 8 * c), g1 = *(const f32x4*)(kn + 8 * c + 4);
    const float r2 = rsqrtf(((const GAS float*)(ws + WS_SSQZ))[(size_t)krow * SZ + 36] * (1.0f / ROPE) + EPS);
    f32x4 y0 = {__uint_as_float(zw.x << 16), __uint_as_float(zw.x & 0xffff0000u), __uint_as_float(zw.y << 16), __uint_as_float(zw.y & 0xffff0000u)};
    f32x4 y1 = {__uint_as_float(zw.z << 16), __uint_as_float(zw.z & 0xffff0000u), __uint_as_float(zw.w << 16), __uint_as_float(zw.w & 0xffff0000u)};
    y0 = y0 * r2 * g0; y1 = y1 * r2 * g1;
    f32x4 p0, p1;
#pragma unroll
    for (int e = 0; e < 4; ++e) { p0[e] = __shfl_xor(y0[e], 2); p1[e] = __shfl_xor(y1[e], 2); }
    const bool lo = c < 2;
    const f32x4 o0 = lo ? y0 * c0 - p0 * s0 : p0 * s0 + y0 * c0, o1 = lo ? y1 * c1 - p1 * s1 : p1 * s1 + y1 * c1;
    v4u ow; ow.x = pk2(o0[0], o0[1]); ow.y = pk2(o0[2], o0[3]); ow.z = pk2(o1[0], o1[1]); ow.w = pk2(o1[2], o1[3]);
    const int kb_ = m >> 12;
#pragma unroll
    for (int h = 0; h < NH; ++h) *(GAS v4u*)(ws + WS_K + kcell(kb_, h, pos, 8 + c)) = ow;
}
__device__ __forceinline__ void wait_ztiles(unsigned* f0, unsigned* f1, unsigned want0, unsigned want1) {
    if (threadIdx.x == 0) { unsigned sp = 0;
        while (__hip_atomic_load((GAS unsigned*)f0, __ATOMIC_RELAXED, __HIP_MEMORY_SCOPE_AGENT) < want0 || (f1 && __hip_atomic_load((GAS unsigned*)f1, __ATOMIC_RELAXED, __HIP_MEMORY_SCOPE_AGENT) < want1)) { __builtin_amdgcn_s_sleep(2); if (++sp > (1u << 22)) break; }
        __builtin_amdgcn_fence(__ATOMIC_ACQUIRE, "agent"); asm volatile("s_waitcnt vmcnt(0)" ::: "memory"); }
    __syncthreads();
}
typedef short bf16x8_t __attribute__((ext_vector_type(8)));
typedef float f32x16 __attribute__((ext_vector_type(16)));
constexpr int PU_PITCH = 272, PU_B = 272 * PU_PITCH;
__device__ __forceinline__ void pool_unit(LAS unsigned char* lds, unsigned char* ws, unsigned char* wl, const float* pscale, const int wid, int pm, int g) {
    const int lane = fresh_lane_id(), tid = wid * 64 + lane, r32 = lane & 31, hi = lane >> 5;
    const int krow0 = rowbase(pm), w = 2 << g;
    const GAS unsigned char* zb = (const GAS unsigned char*)(ws + WS_Z) + ((size_t)(krow0 - 16) * ZP + 128 * g) * 2;
    const GAS unsigned char* wb = (const GAS unsigned char*)(wl + WO_P) + (size_t)g * 128 * 128 * 2;
    {
        const int ch = tid & 15, r0 = tid >> 4; v4u ut[9], bt[4];
#pragma unroll
        for (int i = 0; i < 9; ++i) { const int row = r0 + 32 * i; ut[i] = row < 272 ? *(const GAS v4u*)(zb + (size_t)row * ZP * 2 + ch * 16) : (v4u){0u, 0u, 0u, 0u}; }
#pragma unroll
        for (int i = 0; i < 4; ++i) bt[i] = *(const GAS v4u*)(wb + (size_t)(r0 + 32 * i) * 256 + ch * 16);
#pragma unroll
        for (int i = 0; i < 9; ++i) { const int row = r0 + 32 * i; if (row < 272) *(LAS v4u*)(lds + row * PU_PITCH + ch * 16) = ut[i]; }
#pragma unroll
        for (int i = 0; i < 4; ++i) *(LAS v4u*)(lds + PU_B + (r0 + 32 * i) * PU_PITCH + ch * 16) = bt[i];
    }
    __syncthreads();
    {
        const float invw = 1.0f / (float)w; float s0 = 0.f, s1 = 0.f;
        const LAS unsigned* ub = (const LAS unsigned*)(lds + (16 + 32 * wid) * PU_PITCH) + lane;
#pragma unroll 1
        for (int i = 1; i < w; ++i) { const unsigned uu = ub[-(i * (PU_PITCH / 4))]; s0 += __uint_as_float(uu << 16); s1 += __uint_as_float(uu & 0xffff0000u); }
        unsigned pk[32];
#pragma unroll
        for (int j = 0; j < 32; ++j) { const unsigned uu = ub[j * (PU_PITCH / 4)]; const float a0 = __uint_as_float(uu << 16), a1 = __uint_as_float(uu & 0xffff0000u);
            s0 += a0; s1 += a1; pk[j] = pk2(s0 * invw - a0, s1 * invw - a1);
            const unsigned uo = ub[(j - (w - 1)) * (PU_PITCH / 4)]; s0 -= __uint_as_float(uo << 16); s1 -= __uint_as_float(uo & 0xffff0000u); }
        __syncthreads();
        LAS unsigned* uw = (LAS unsigned*)(lds + (16 + 32 * wid) * PU_PITCH) + lane;
#pragma unroll
        for (int j = 0; j < 32; ++j) uw[j * (PU_PITCH / 4)] = pk[j];
    }
    __syncthreads();
    f32x16 acc[4];
#pragma unroll
    for (int nb = 0; nb < 4; ++nb)
#pragma unroll
        for (int r = 0; r < 16; ++r) acc[nb][r] = 0.f;
    const LAS unsigned char* pa = lds + (16 + 32 * wid + r32) * PU_PITCH + hi * 16; const LAS unsigned char* wa = lds + PU_B + r32 * PU_PITCH + hi * 16;
#pragma unroll
    for (int s = 0; s < 8; ++s) { const bf16x8_t bfr = *(const LAS bf16x8_t*)(pa + s * 32);
#pragma unroll
        for (int nb = 0; nb < 4; ++nb) { const bf16x8_t afr = *(const LAS bf16x8_t*)(wa + nb * 32 * PU_PITCH + s * 32); acc[nb] = __builtin_amdgcn_mfma_f32_32x32x16_bf16(afr, bfr, acc[nb], 0, 0, 0); } }
    const float* ps = pscale + 128 * g + 4 * hi;
    GAS unsigned char* yb = (GAS unsigned char*)(ws + WS_Y) + ((size_t)(krow0 + 32 * wid + r32) * YP + 128 * g + 4 * hi) * 2;
#pragma unroll
    for (int nb = 0; nb < 4; ++nb)
#pragma unroll
        for (int k4 = 0; k4 < 4; ++k4) { const f32x4 sc = *(const f32x4*)(ps + 32 * nb + 8 * k4);
            pg8::u32x2 o; o.x = pk2(acc[nb][4 * k4] * sc[0], acc[nb][4 * k4 + 1] * sc[1]); o.y = pk2(acc[nb][4 * k4 + 2] * sc[2], acc[nb][4 * k4 + 3] * sc[3]);
            *(GAS pg8::u32x2*)(yb + (32 * nb + 8 * k4) * 2) = o; }
    __syncthreads();
}

namespace mini {
typedef short bf16x8 __attribute__((ext_vector_type(8)));
typedef float f32x4 __attribute__((ext_vector_type(4)));
__device__ __forceinline__ float hs4(f32x4 v) { return (v[0] * v[0] + v[1] * v[1]) + (v[2] * v[2] + v[3] * v[3]); }
__device__ __forceinline__ bf16x8 pack8(f32x4 a0, f32x4 a1) { v4u w; w.x = pk2(a0[0], a0[1]); w.y = pk2(a0[2], a0[3]); w.z = pk2(a1[0], a1[1]); w.w = pk2(a1[2], a1[3]); return __builtin_bit_cast(bf16x8, w); }
template <int NB, int U = 4> __device__ __forceinline__ void acc_steps(const GAS float* A, int lda, const float* gain, const GAS bf16* const (&Bt)[NB], int ldb, int K, int s0, int sstep, int lane, f32x4 (&acc)[NB], float& ssq) {
    const int r = lane & 15, q = lane >> 4;
    const int ns = K / 32;
    for (int sb = s0; sb < ns; sb += U * sstep) {
        f32x4 a0[U], a1[U], g0[U], g1[U]; bf16x8 bfr[U][NB];
#pragma unroll
        for (int u = 0; u < U; ++u) { const int s_ = sb + u * sstep, k = 32 * (s_ < ns ? s_ : s0) + 8 * q;
            a0[u] = *(const GAS f32x4*)(A + (size_t)r * lda + k); a1[u] = *(const GAS f32x4*)(A + (size_t)r * lda + k + 4);
            if (gain) { g0[u] = *(const f32x4*)(gain + k); g1[u] = *(const f32x4*)(gain + k + 4); }
#pragma unroll
            for (int nb = 0; nb < NB; ++nb) bfr[u][nb] = *(const GAS bf16x8*)(Bt[nb] + (size_t)r * ldb + k); }
#pragma unroll
        for (int u = 0; u < U; ++u) { if (sb + u * sstep < ns) {
            ssq += hs4(a0[u]) + hs4(a1[u]);
            if (gain) { a0[u] = a0[u] * g0[u]; a1[u] = a1[u] * g1[u]; }
            const bf16x8 af = pack8(a0[u], a1[u]);
#pragma unroll
            for (int nb = 0; nb < NB; ++nb) acc[nb] = __builtin_amdgcn_mfma_f32_16x16x32_bf16(af, bfr[u][nb], acc[nb], 0, 0, 0); } }
    }
}
template <int NB, bool NORM, int U = 4> __device__ __forceinline__ void chunk_wg(LAS unsigned char* lds, const GAS float* A, int lda, const float* gain, const GAS bf16* const (&Bt)[NB], int ldb, int K, int wid, int lane, f32x4 (&out)[NB]) {
    f32x4 acc[NB]; float ssq = 0.f;
#pragma unroll
    for (int nb = 0; nb < NB; ++nb) acc[nb] = (f32x4){0.f, 0.f, 0.f, 0.f};
    acc_steps<NB, U>(A, lda, gain, Bt, ldb, K, wid, 8, lane, acc, ssq);
    LAS f32x4* red = (LAS f32x4*)lds; LAS float* sq = (LAS float*)(lds + 8 * NB * 64 * 16);
#pragma unroll
    for (int nb = 0; nb < NB; ++nb) red[(wid * NB + nb) * 64 + lane] = acc[nb];
    sq[wid * 64 + lane] = ssq;
    __syncthreads();
    if (wid == 0) {
#pragma unroll
        for (int nb = 0; nb < NB; ++nb) { f32x4 t = red[nb * 64 + lane];
#pragma unroll
            for (int w = 1; w < 8; ++w) t = t + red[(w * NB + nb) * 64 + lane];
            out[nb] = t; }
        if (NORM) { float tot = 0.f;
#pragma unroll
            for (int w = 0; w < 8; ++w)
#pragma unroll
                for (int qq = 0; qq < 4; ++qq) tot += sq[w * 64 + (lane & 15) + 16 * qq];
            const float rs = rsqrtf(tot / (float)K + EPS);
#pragma unroll
            for (int reg = 0; reg < 4; ++reg) { const float rr = __shfl(rs, 4 * (lane >> 4) + reg);
#pragma unroll
                for (int nb = 0; nb < NB; ++nb) out[nb][reg] *= rr; } }
    }
    __syncthreads();
}
__device__ __forceinline__ void publish(unsigned* cnt, int lane) {
    asm volatile("s_waitcnt vmcnt(0)" ::: "memory"); __builtin_amdgcn_fence(__ATOMIC_RELEASE, "agent"); asm volatile("s_waitcnt vmcnt(0)" ::: "memory");
    if (lane == 0) __hip_atomic_fetch_add((GAS unsigned*)cnt, 1u, __ATOMIC_RELAXED, __HIP_MEMORY_SCOPE_AGENT);
}
__device__ __forceinline__ void publish_wt(unsigned* cnt, int lane) {
    asm volatile("s_waitcnt vmcnt(0)" ::: "memory");
    if (lane == 0) __hip_atomic_fetch_add((GAS unsigned*)cnt, 1u, __ATOMIC_RELAXED, __HIP_MEMORY_SCOPE_AGENT);
}
__device__ __forceinline__ void p1_chunk(LAS unsigned char* lds, unsigned char* ws, unsigned char* wl, unsigned* zm_cnt, int chunk, int wid, int lane) {
    const GAS float* HM = (const GAS float*)(ws + WS_MINI + MN_HM); GAS float* ZM = (GAS float*)(ws + WS_MINI + MN_ZM);
    const GAS bf16* const Bt[1] = {(const GAS bf16*)(wl + WO_IN) + (size_t)(16 * chunk) * D}; f32x4 o[1];
    chunk_wg<1, true>(lds, HM, D, nullptr, Bt, D, D, wid, lane, o);
    if (wid == 0) { const int col = 16 * chunk + (lane & 15);
#pragma unroll
        for (int reg = 0; reg < 4; ++reg) { const int r = 4 * (lane >> 4) + reg; ZM[(size_t)r * INW + col] = o[0][reg];
            if (col < POOLW) { const bf16 zb = f2bf(o[0][reg]);
#pragma unroll
                for (int b = 0; b < BATCH; ++b) ((GAS bf16*)(ws + WS_Z))[(size_t)(b * L + r) * ZP + col] = zb; } }
        asm volatile("s_waitcnt vmcnt(0)" ::: "memory"); __builtin_amdgcn_fence(__ATOMIC_RELEASE, "agent"); asm volatile("s_waitcnt vmcnt(0)" ::: "memory");
        if (lane == 0) __hip_atomic_fetch_add((GAS unsigned*)zm_cnt, 1u, __ATOMIC_RELAXED, __HIP_MEMORY_SCOPE_AGENT); }
}
__device__ __forceinline__ void wait_zm(unsigned* zm_cnt, unsigned want) {
    if (threadIdx.x == 0) { unsigned sp = 0;
        while (__hip_atomic_load((GAS unsigned*)zm_cnt, __ATOMIC_RELAXED, __HIP_MEMORY_SCOPE_AGENT) < want) { __builtin_amdgcn_s_sleep(2); if (++sp > (1u << 22)) break; }
        __builtin_amdgcn_fence(__ATOMIC_ACQUIRE, "agent"); asm volatile("s_waitcnt vmcnt(0)" ::: "memory"); }
    __syncthreads();
}
template <int U> __device__ __forceinline__ void res_chunk(LAS unsigned char* lds, unsigned char* ws, const GAS float* A, int K, const GAS bf16* Btw, int chunk, int wid, int lane, unsigned* pub = nullptr) {
    GAS float* HM = (GAS float*)(ws + WS_MINI + MN_HM);
    const GAS bf16* const Bt[1] = {Btw + (size_t)(16 * chunk) * K}; f32x4 o[1];
    chunk_wg<1, false, U>(lds, A, K, nullptr, Bt, K, K, wid, lane, o);
    if (wid == 0) { const int col = 16 * chunk + (lane & 15);
#pragma unroll
        for (int reg = 0; reg < 4; ++reg) { const int r = 4 * (lane >> 4) + reg; const float hv = HM[(size_t)r * D + col] + o[0][reg];
            if (pub) st4_wt(ws_rsrc(ws), WS_MINI + MN_HM + ((size_t)r * D + col) * 4, __float_as_uint(hv)); else HM[(size_t)r * D + col] = hv; }
        if (pub) publish_wt(pub, lane); }
}
__device__ __forceinline__ void ffn_chunk(LAS unsigned char* lds, unsigned char* ws, unsigned char* wl, const float* ffn_g, int chunk, int wid, int lane, unsigned* pub = nullptr) {
    const GAS float* HM = (const GAS float*)(ws + WS_MINI + MN_HM); GAS float* AM = (GAS float*)(ws + WS_MINI + MN_ACT);
    const int f0 = 32 * chunk, row0 = 256 * (f0 >> 7) + (f0 & 127);
    const GAS bf16* const Bt[4] = {(const GAS bf16*)(wl + WO_GU) + (size_t)row0 * D, (const GAS bf16*)(wl + WO_GU) + (size_t)(row0 + 128) * D,
                                   (const GAS bf16*)(wl + WO_GU) + (size_t)(row0 + 16) * D, (const GAS bf16*)(wl + WO_GU) + (size_t)(row0 + 144) * D}; f32x4 o[4];
    chunk_wg<4, true>(lds, HM, D, nullptr, Bt, D, D, wid, lane, o); (void)ffn_g;
    if (wid == 0) {
#pragma unroll
        for (int hh = 0; hh < 2; ++hh) { const int col = f0 + 16 * hh + (lane & 15);
#pragma unroll
            for (int reg = 0; reg < 4; ++reg) { const int r = 4 * (lane >> 4) + reg; const float g = o[2 * hh][reg]; st4_wt(ws_rsrc(ws), WS_MINI + MN_ACT + ((size_t)r * FF + col) * 4, __float_as_uint(g / (1.0f + __expf(-g)) * o[2 * hh + 1][reg])); } }
        if (pub) publish_wt(pub, lane); }
}
__device__ __forceinline__ void head_task(LAS unsigned char* lds, unsigned char* ws, unsigned char* wl, const float* qa, const float* kva, const float* qn, const float* kn, int h, bool need_q, int wid, int lane) {
    const GAS float* ZM = (const GAS float*)(ws + WS_MINI + MN_ZM); const GAS float* rope = (const GAS float*)(ws + WS_ROPE);
    LAS float* QT = (LAS float*)lds; LAS float* KVT = QT + 16 * 96; LAS float* KR = KVT + 16 * 128; LAS float* ST = KR + 16 * 32; LAS float* S = ST + 64;
    const int tid = wid * 64 + lane, r = lane & 15, q = lane >> 4;
    if (need_q && wid < 6) {
        const int e0 = 16 * wid, drow = e0 < 64 ? 256 * (h >> 2) + 128 * (e0 >> 5) + 32 * (h & 3) + (e0 & 31) : 512 + 128 * (h >> 2) + 32 * (h & 3) + (e0 - 64);
        const GAS bf16* const Bt[1] = {(const GAS bf16*)(wl + WO_Q) + (size_t)drow * QLR}; f32x4 acc[1] = {(f32x4){0.f, 0.f, 0.f, 0.f}}; float ssq = 0.f;
        acc_steps<1, 6>(ZM + POOLW, INW, qa, Bt, QLR, QLR, 0, 1, lane, acc, ssq);
        ssq += __shfl_xor(ssq, 16); ssq += __shfl_xor(ssq, 32); const float rs = rsqrtf(ssq / (float)QLR + EPS);
#pragma unroll
        for (int reg = 0; reg < 4; ++reg) QT[(4 * q + reg) * 96 + e0 + r] = acc[0][reg] * __shfl(rs, 4 * q + reg);
    }
    {
        const int e0 = 16 * wid, drow = e0 < 64 ? 256 * (h >> 2) + 128 * (e0 >> 5) + 32 * (h & 3) + (e0 & 31) : 512 + 256 * (h >> 2) + 128 * ((e0 - 64) >> 5) + 32 * (h & 3) + ((e0 - 64) & 31);
        const GAS bf16* const Bt[1] = {(const GAS bf16*)(wl + WO_KV) + (size_t)drow * KVLR}; f32x4 acc[1] = {(f32x4){0.f, 0.f, 0.f, 0.f}}; float ssq = 0.f;
        acc_steps<1, 8>(ZM + POOLW + QLR, INW, kva, Bt, KVLR, KVLR, 0, 1, lane, acc, ssq);
        ssq += __shfl_xor(ssq, 16); ssq += __shfl_xor(ssq, 32); const float rs = rsqrtf(ssq / (float)KVLR + EPS);
#pragma unroll
        for (int reg = 0; reg < 4; ++reg) KVT[(4 * q + reg) * 128 + e0 + r] = acc[0][reg] * __shfl(rs, 4 * q + reg);
    }
    {
        const int rr = tid >> 5, e = tid & 31; KR[rr * 32 + e] = ZM[(size_t)rr * INW + POOLW + QLR + KVLR + e]; }
    __syncthreads();
    if (tid < 256) { const int rr = tid >> 4, sub = tid & 15; float s0 = 0.f, s1 = 0.f, s2 = 0.f, s3 = 0.f;
#pragma unroll
        for (int i = 0; i < 4; ++i) { const float a = QT[rr * 96 + sub + 16 * i], b = KVT[rr * 128 + sub + 16 * i]; s0 += a * a; s2 += b * b; }
#pragma unroll
        for (int i = 0; i < 2; ++i) { const float a = QT[rr * 96 + 64 + sub + 16 * i], b = KR[rr * 32 + sub + 16 * i]; s1 += a * a; s3 += b * b; }
#pragma unroll
        for (int o = 1; o < 16; o <<= 1) { s0 += __shfl_xor(s0, o); s1 += __shfl_xor(s1, o); s2 += __shfl_xor(s2, o); s3 += __shfl_xor(s3, o); }
        if (sub == 0) { ST[rr * 4 + 0] = rsqrtf(s0 / 64.f + EPS); ST[rr * 4 + 1] = rsqrtf(s1 / 32.f + EPS); ST[rr * 4 + 2] = rsqrtf(s2 / 64.f + EPS); ST[rr * 4 + 3] = rsqrtf(s3 / 32.f + EPS); } }
    __syncthreads();
    float qv[3], kvv[3];
    { const int rr = tid >> 5, e = tid & 31; const GAS float* t = rope + (size_t)rr * 32;
      qv[0] = QT[rr * 96 + e] * ST[rr * 4 + 0] * qn[e] * QSCALE; qv[1] = QT[rr * 96 + 32 + e] * ST[rr * 4 + 0] * qn[32 + e] * QSCALE;
      kvv[0] = KVT[rr * 128 + e] * ST[rr * 4 + 2] * kn[e]; kvv[1] = KVT[rr * 128 + 32 + e] * ST[rr * 4 + 2] * kn[32 + e];
      const int j = e & 15; const float c = t[j], sn = t[16 + j];
      const float q1 = QT[rr * 96 + 64 + j] * ST[rr * 4 + 1] * qn[64 + j], q2 = QT[rr * 96 + 80 + j] * ST[rr * 4 + 1] * qn[80 + j];
      const float k1 = KR[rr * 32 + j] * ST[rr * 4 + 3] * kn[64 + j], k2 = KR[rr * 32 + 16 + j] * ST[rr * 4 + 3] * kn[80 + j];
      qv[2] = (e < 16 ? q1 * c - q2 * sn : q1 * sn + q2 * c) * QSCALE; kvv[2] = e < 16 ? k1 * c - k2 * sn : k1 * sn + k2 * c; }
    __syncthreads();
    { const int rr = tid >> 5, e = tid & 31;
#pragma unroll
      for (int i = 0; i < 3; ++i) { QT[rr * 96 + 32 * i + e] = qv[i]; if (i < 2) KVT[rr * 128 + 32 * i + e] = kvv[i]; else KR[rr * 32 + e] = kvv[2]; } }
    __syncthreads();
    if (tid < 320) {
        const bool isk = tid < 192; const int u_ = isk ? tid : tid - 192, rr = isk ? u_ / 12 : u_ >> 3, ch = isk ? u_ % 12 : u_ & 7;
        const LAS float* src = isk ? (ch < 8 ? KVT + rr * 128 + 8 * ch : KR + rr * 32 + 8 * (ch - 8)) : KVT + rr * 128 + 64 + 8 * ch;
        v4u w; w.x = pk2(src[0], src[1]); w.y = pk2(src[2], src[3]); w.z = pk2(src[4], src[5]); w.w = pk2(src[6], src[7]);
#pragma unroll
        for (int b = 0; b < BATCH; ++b) { if (isk) *(GAS v4u*)(ws + WS_K + kcell(b, h, rr, ch)) = w; else *(GAS v4u*)(ws + WS_V + ((size_t)(b * L + rr) * VP + h * VD + 8 * ch) * 2) = w; } }
    if (need_q) {
        if (tid < 256) { const int rr = tid >> 4, j = tid & 15; float sc = 0.f;
            for (int e = 0; e < 64; ++e) sc += QT[rr * 96 + e] * KVT[j * 128 + e];
            for (int e = 0; e < 32; ++e) sc += QT[rr * 96 + 64 + e] * KR[j * 32 + e];
            S[rr * 16 + j] = j <= rr ? sc : -INFINITY; }
        __syncthreads();
        float pj = 0.f;
        if (tid < 256) { const int rr = tid >> 4, j = tid & 15; float m = -INFINITY; for (int jj = 0; jj < 16; ++jj) m = fmaxf(m, S[rr * 16 + jj]);
            float l = 0.f; for (int jj = 0; jj < 16; ++jj) l += exp2f(S[rr * 16 + jj] - m);
            pj = exp2f(S[rr * 16 + j] - m) / l; }
        __syncthreads();
        if (tid < 256) S[tid] = pj;
        __syncthreads();
        { GAS float* YM = (GAS float*)(ws + WS_MINI + MN_YM);
#pragma unroll
          for (int i = 0; i < 2; ++i) { const int idx = tid + 512 * i, rr = idx >> 6, d = idx & 63; float o = 0.f;
              for (int j = 0; j < 16; ++j) o += S[rr * 16 + j] * KVT[j * 128 + 64 + d];
              YM[(size_t)rr * D + POOLW + h * VD + d] = o; } }
    }
    __syncthreads();
}
__device__ __forceinline__ void pool_task(LAS unsigned char* lds, unsigned char* ws, unsigned char* wl, const float* pscale, int wid, int lane) {
    const GAS float* ZM = (const GAS float*)(ws + WS_MINI + MN_ZM); GAS float* YM = (GAS float*)(ws + WS_MINI + MN_YM);
    LAS float* PM = (LAS float*)lds; LAS float* UM = PM + 16 * 516; const int tid = wid * 64 + lane;
    { f32x4 t[4];
#pragma unroll
      for (int i = 0; i < 4; ++i) { const int idx = tid + 512 * i, rr = idx >> 7, c4 = (idx & 127) * 4; t[i] = *(const GAS f32x4*)(ZM + (size_t)rr * INW + c4); }
#pragma unroll
      for (int i = 0; i < 4; ++i) { const int idx = tid + 512 * i, rr = idx >> 7, c4 = (idx & 127) * 4; *(LAS f32x4*)(UM + rr * 516 + c4) = t[i]; } }
    __syncthreads();
    for (int idx = tid; idx < 16 * POOLW; idx += NWAVES * 64) { const int rr = idx >> 9, c = idx & 511, w = 2 << (c >> 7), cnt = rr + 1 < w ? rr + 1 : w; float s2 = 0.f;
        for (int i = 0; i < cnt; ++i) s2 += UM[(rr - i) * 516 + c];
        PM[rr * 516 + c] = s2 / (float)cnt - UM[rr * 516 + c]; }
    __syncthreads();
    const int r = lane & 15, q = lane >> 4;
    for (int ch = wid; ch < 32; ch += NWAVES) { const int g = ch >> 3, n0 = 16 * (ch & 7);
        f32x4 acc = {0.f, 0.f, 0.f, 0.f};
#pragma unroll
        for (int s_ = 0; s_ < 4; ++s_) { const int k = 32 * s_ + 8 * q; const LAS float* pa = PM + r * 516 + 128 * g + k;
            const f32x4 a0 = *(const LAS f32x4*)pa, a1 = *(const LAS f32x4*)(pa + 4);
            const bf16x8 bfr = *(const GAS bf16x8*)((const GAS bf16*)(wl + WO_P) + (size_t)(g * 128 + n0 + r) * 128 + k);
            acc = __builtin_amdgcn_mfma_f32_16x16x32_bf16(pack8(a0, a1), bfr, acc, 0, 0, 0); }
        const int col = 128 * g + n0 + r; const float sc = pscale[col];
#pragma unroll
        for (int reg = 0; reg < 4; ++reg) YM[(size_t)(4 * q + reg) * D + col] = acc[reg] * sc; }
    __syncthreads();
}
}

struct Args { P p; int ph_lo, ph_hi, li, pad; };
__global__ void __launch_bounds__(NWAVES * 64, 2) mega_fwd(const Args args) {
    extern __shared__ __attribute__((aligned(16))) unsigned char lds[];
    Frame F{nullptr, nullptr, nullptr, 0, 0, 0, args.p};
    F.lds = (LAS unsigned char*)lds; F.MISC = (volatile LAS unsigned*)(F.lds + MISC_OFF);
    F.wave = __builtin_amdgcn_readfirstlane((int)threadIdx.x >> 6);
    F.G = gridDim.x; { const int bx = blockIdx.x; F.vcu = (F.G % 8 == 0) ? (bx % 8) * (F.G / 8) + bx / 8 : bx; }
    F.ctl = (gu32*)(args.p.ws + WS_CTL);
    const P& p = F.p;
    for (int u = (int)threadIdx.x; u < (LDS_BYTES - LDSCTL_OFF) / 4; u += NWAVES * 64) ((LAS unsigned*)(F.lds + LDSCTL_OFF))[u] = 0u;
    __syncthreads();
    XcdBarrier bar = xcd_barrier_post((unsigned*)(F.ctl + CW_BAR) + args.li * XCD_BAR_WORDS, F.MISC + 8);
    const int lo = args.ph_lo, hi = args.ph_hi;
#define IN(k) (lo <= (k) && (k) < hi)
#define STAMP(k) do { if (MK_PROBE >= 0 && blockIdx.x == 0 && threadIdx.x == 0) F.MISC[16 + (k)] = (unsigned)__builtin_amdgcn_s_memrealtime(); } while (0)
#define SEAM(k) do { if ((IN(k) && IN((k) + 1)) || ((MK_PROBE >= 0 || MK_PA >= 0) && (k) == NPHASE - 1)) xcd_barrier(bar); STAMP((k) + 1); } while (0)
#define GSEAM(k, n, ...) do { if (IN(k) && IN((k) + 1)) { const int gb_ = (int)blockIdx.x; if (F.G != 256) xcd_barrier(bar); else group_seam((unsigned*)(F.ctl + CW_GRP) + 64 * (8 * (gb_ & 7) + ((gb_ >> 3) & 7)), 4u * (unsigned)(n), bar.bar, ##__VA_ARGS__); } STAMP((k) + 1); } while (0)
    STAMP(0);
#define PST(id) do { if (MK_PA >= 0 && l == 0) { __syncthreads(); if ((int)blockIdx.x == MK_PBLK && threadIdx.x == 0) F.MISC[40 + (id)] = (unsigned)__builtin_amdgcn_s_memrealtime(); } } while (0)
    if (IN(0)) { p0_prologue(F); SEAM(0); }
#define PHASE_LOCALS unsigned char* ws = p.ws; int wv = F.wave, vcu = F.vcu, bid = (int)blockIdx.x, li = l; \
    asm volatile("" : "+s"(ws), "+s"(wv), "+s"(vcu), "+s"(bid), "+s"(li)); unsigned char* const wl = ws + WS_W + (size_t)li * WL_BYTES; (void)wl; (void)vcu; (void)bid; (void)wv
#pragma unroll 1
    for (int l = 0; l < DEPTH; ++l) {
        const int pb = 1 + 6 * l;
        if (IN(pb)) {
            PHASE_LOCALS;
            pg8::Gemm g{(const bf16*)(ws + WS_XN), D, 0, (const bf16*)(wl + WO_IN), D}; pg8::StaticOrder S; S.init(64, 5, F.G, bid);
            unsigned* const zflag = (unsigned*)(ws + WS_CTL) + CW_ZF + 64 * 128 * li;
            pg8::EpiZ E{(bf16*)(ws + WS_Z), (float*)(ws + WS_SSQZ), (const float*)(ws + WS_SSQH), p.qa_g + (size_t)li * QLR, p.kva_g + (size_t)li * KVLR, ws, zflag};
            unsigned* const zm_cnt = (unsigned*)(ws + WS_CTL) + CW_ZM + 64 * li;
            if (MK_MINI && bid >= 128 && bid < 128 + INW / 16) mini::p1_chunk(F.lds + RING_OFF, ws, wl, zm_cnt, bid - 128, wv, fresh_lane_id());
            pg8::gemm_phase<pg8::EpiZ, pg8::StaticOrder, PG8_ALIGN, PG8_SP2>(F.lds + RING_OFF, g, S, E, wv);
            if (MK_MINI && bid >= 210 && bid < 219) {
                mini::wait_zm(zm_cnt, INW / 16);
                if (bid < 218) mini::head_task(F.lds + RING_OFF, ws, wl, p.qa_g + (size_t)li * QLR, p.kva_g + (size_t)li * KVLR, p.qn_g + (size_t)li * QKD, p.kn_g + (size_t)li * QKD, bid - 210, li + 1 < DEPTH, wv, fresh_lane_id());
                else if (li + 1 < DEPTH) mini::pool_task(F.lds + RING_OFF, ws, wl, p.pool_scale + (size_t)li * POOLW, wv, fresh_lane_id());
            } else if (bid >= 64) {
                const int rank = bid < 128 ? bid - 64 : bid >= 219 ? 72 + bid - 219 : bid >= 202 ? 64 + bid - 202 : 109 + bid - 128;
                for (int ui = rank; ui < 256; ui += 183) { if (ui >= 183 && rank >= 73) break; const int pm = ui >> 2, g = ui & 3, pn = g >> 1;
                    if (pm & 15) wait_ztiles(zflag + 64 * (2 * pm + pn), zflag + 64 * (2 * (pm - 1) + pn), 8u, 8u); else wait_ztiles(zflag + 64 * (2 * pm + pn), zm_cnt, 8u, (unsigned)(INW / 16));
                    pool_unit(F.lds + RING_OFF, ws, wl, p.pool_scale + (size_t)li * POOLW, wv, pm, g); }
                if (rank >= 73) conv_range(p, (LAS float*)(F.lds + RING_OFF + wv * 16384), li == 0 ? CV0 : CV2, li == 0 ? CV1 : CV3, (rank - 73) * NWAVES + wv, 110 * NWAVES, fresh_lane_id()); }
            GSEAM(pb, 3 * l + 1);
        }
        if (IN(pb + 1)) {
            PHASE_LOCALS;
            PST(0);
            if (bid >= 192) { const int t_ = wv * 64 + fresh_lane_id(), pm_ = 8 * (bid & 7) + ((bid >> 3) & 7);
                for (int j = t_; j < 1024; j += NWAVES * 64) krope_item(ws, p.kn_g + (size_t)li * QKD + NOPE, pm_ * 1024 + j); }
            PST(1); PST(2);
            { pg8::Gemm gq{(const bf16*)(ws + WS_Z) + POOLW, ZP, 0, (const bf16*)(wl + WO_Q), QLR}, gkv{(const bf16*)(ws + WS_Z) + POOLW + QLR, ZP, 0, (const bf16*)(wl + WO_KV), KVLR};
              pg8::StaticOrder Sq, Skv; Sq.init(64, 3, F.G, bid); Skv.init(64, 4, F.G, bid);
              LAS float* rqt = nullptr; LAS float* rkt = nullptr;
              if (F.G == 256) {
                  rqt = (LAS float*)(F.lds + RST_OFF); rkt = rqt + 256; const int t_ = wv * 64 + fresh_lane_id();
                  if (t_ < 256) { const GAS pg8::f32x4* sq = (const GAS pg8::f32x4*)(ws + WS_SSQZ + ((size_t)(rowbase(8 * (bid & 7) + ((bid >> 3) & 7)) + t_) * SZ + 16) * 4);
                      const pg8::f32x4 a_ = sq[0] + sq[1] + sq[2], b_ = sq[3] + sq[4];
                      rqt[t_] = __builtin_amdgcn_rsqf(((a_[0] + a_[1]) + (a_[2] + a_[3])) * (1.0f / QLR) + EPS); rkt[t_] = __builtin_amdgcn_rsqf(((b_[0] + b_[1]) + (b_[2] + b_[3])) * (1.0f / KVLR) + EPS); }
                  LDS_WAIT(); }
              pg8::EpiQ Eq{(bf16*)(ws + WS_Q), (const float*)(ws + WS_SSQZ), p.qn_g + (size_t)li * QKD, (const float*)(ws + WS_ROPE), rqt};
              pg8::EpiKV Ekv{(bf16*)(ws + WS_K), (bf16*)(ws + WS_V), (const float*)(ws + WS_SSQZ), p.kn_g + (size_t)li * QKD, rkt};
              pg8::gemm_phase2(F.lds + RING_OFF, gq, gkv, Sq, Skv, Eq, Ekv, wv); }
            PST(3);
            PST(4);
            if (li == 0 && bid < 128) conv_range(p, (LAS float*)(F.lds + RING_OFF + wv * 16384), CV1, CV1 + 128 * NWAVES, bid * NWAVES + wv, 128 * NWAVES, fresh_lane_id());
            if (bid >= 192) conv_range(p, (LAS float*)(F.lds + RING_OFF + wv * 16384), li == 0 ? CV1 + 128 * NWAVES : CV3, li == 0 ? CV1B : CV4, (bid - 192) * NWAVES + wv, (F.G - 192) * NWAVES, fresh_lane_id());
            PST(5);
            SEAM(pb + 1);
            PST(6);
        }
        if (IN(pb + 2)) {
            PHASE_LOCALS;
            const int bh = vcu >> 3, sq = vcu & 7;
#pragma unroll 1
            for (int i = 0; i < 2; ++i)
                attn::attn_unit<8>(bh >> 3, bh & 7, i == 0 ? 15 - sq : sq, (const bf16*)(ws + WS_Q), (const bf16*)(ws + WS_K), (const bf16*)(ws + WS_V), (bf16*)(ws + WS_Y), (char*)lds + RING_OFF, wv);
            if (F.G != 256) SEAM(pb + 2);
            else if (IN(pb + 2) && IN(pb + 3)) {
                asm volatile("s_waitcnt vmcnt(0)" ::: "memory"); __syncthreads();
                if (threadIdx.x == 0) { unsigned* yp = (unsigned*)(F.ctl + CW_YP) + 64 * 16 * (bh >> 3);
                    __hip_atomic_fetch_add((GAS unsigned*)(yp + 64 * (15 - sq)), 1u, RLX_AGENT); __hip_atomic_fetch_add((GAS unsigned*)(yp + 64 * sq), 1u, RLX_AGENT);
                    __hip_atomic_fetch_add((GAS unsigned*)((unsigned*)(F.ctl + CW_P3D)), 1u, RLX_AGENT); }
                STAMP(pb + 3);
            }
        }
        if (IN(pb + 3)) {
            PHASE_LOCALS;
            PST(7);
            pg8::Gemm g{(const bf16*)(ws + WS_Y), YP, 0, (const bf16*)(wl + WO_OUT), D}; pg8::StaticOrder S; S.init(64, 4, F.G, bid);
            if (F.G == 256 && IN(pb + 2)) wait_count((unsigned*)(F.ctl + CW_YP) + 64 * (8 * (bid & 7) + ((bid >> 3) & 7)), 8u * (unsigned)(li + 1), bar.bar);
            pg8::EpiResT<true> E{(bf16*)(ws + WS_XN), (float*)(ws + WS_SSQH), nullptr};
            pg8::gemm_phase<pg8::EpiResT<true>, pg8::StaticOrder, false, PG8_SP2>(F.lds + RING_OFF, g, S, E, wv);
            PST(8);
            PST(9);
            GSEAM(pb + 3, 3 * l + 2, IN(pb + 2) ? (unsigned*)(F.ctl + CW_P3D) : nullptr, 256u * (unsigned)(l + 1));
            PST(10);
        }
        if (IN(pb + 4)) {
            PHASE_LOCALS;
            unsigned* const m4 = (unsigned*)(ws + WS_CTL) + CW_M4; unsigned* const m5 = (unsigned*)(ws + WS_CTL) + CW_M5;
            if (MK_MINI && li + 1 < DEPTH && bid >= 216) for (int c = bid - 216; c < 64; c += 40) mini::res_chunk<4>(F.lds + RING_OFF, ws, (const GAS float*)(ws + WS_MINI + MN_YM), D, (const GAS bf16*)(wl + WO_OUT), c, wv, fresh_lane_id(), m4);
            pg8::Gemm g{(const bf16*)(ws + WS_XN), D, 0, (const bf16*)(wl + WO_GU), D}; pg8::StaticOrder S; S.init(64, 22, F.G, bid, li == 0 ? 0 : 128);
            LAS float* rst = nullptr;
            if (F.G == 256) {
                rst = (LAS float*)(F.lds + RST_OFF); const int t_ = wv * 64 + fresh_lane_id();
                if (t_ < 256) { const pg8::f32x4 sq = *(const GAS pg8::f32x4*)(ws + WS_SSQH + (size_t)(rowbase(8 * (bid & 7) + ((bid >> 3) & 7)) + t_) * 16); rst[t_] = rsqrtf(((sq[0] + sq[1]) + (sq[2] + sq[3])) * (1.0f / D) + EPS); }
                LDS_WAIT(); }
            pg8::EpiSwiGLU E{(bf16*)(ws + WS_ACT), (const float*)(ws + WS_SSQH), rst};
            pg8::gemm_phase<pg8::EpiSwiGLU, pg8::StaticOrder, PG8_ALIGN, PG8_SP2, true>(F.lds + RING_OFF, g, S, E, wv);
            if (li + 1 < DEPTH && bid >= 128) {
                if (MK_MINI) { mini::wait_zm(m4, 64u);
                    if (bid < 128 + FF / 32) mini::ffn_chunk(F.lds + RING_OFF, ws, wl, p.ffn_g + (size_t)li * D, bid - 128, wv, fresh_lane_id(), m5); }
                if (bid < 192) { if (MK_MINI) { mini::wait_zm(m5, (unsigned)(FF / 32)); mini::res_chunk<6>(F.lds + RING_OFF, ws, (const GAS float*)(ws + WS_MINI + MN_ACT), FF, (const GAS bf16*)(wl + WO_D), bid - 128, wv, fresh_lane_id()); } }
                else conv_range(p, (LAS float*)(F.lds + RING_OFF + wv * 16384), CV1B, CV2, (bid - 192) * NWAVES + wv, (F.G - 192) * NWAVES, fresh_lane_id());
            }
            GSEAM(pb + 4, 3 * l + 3);
        }
        if (IN(pb + 5)) {
            PHASE_LOCALS;
            pg8::Gemm g{(const bf16*)(ws + WS_ACT), FF, 0, (const bf16*)(wl + WO_D), FF}; pg8::StaticOrder S; S.init(64, 4, F.G, bid);
            pg8::EpiResT<true> E{(bf16*)(ws + WS_XN), (float*)(ws + WS_SSQH), li + 1 < DEPTH ? nullptr : p.out};
            pg8::gemm_phase<pg8::EpiResT<true>, pg8::StaticOrder, false, PG8_SP2>(F.lds + RING_OFF, g, S, E, wv);
            SEAM(pb + 5);
        }
    }
    if (MK_PA >= 0 && (int)blockIdx.x == MK_PBLK && threadIdx.x == 0) p.out[0] += (float)(F.MISC[40 + MK_PA] - F.MISC[40 + MK_PB]) * 0.01f;
    if (MK_PROBE >= 0 && blockIdx.x == 0 && threadIdx.x == 0) { const unsigned t1 = MK_PROBE == 100 ? F.MISC[16 + NPHASE] : F.MISC[16 + MK_PROBE + 1], t0 = MK_PROBE == 100 ? F.MISC[16] : F.MISC[16 + MK_PROBE];
        p.out[0] += (float)(t1 - t0) * 0.01f; }
#undef IN
#undef SEAM
#undef GSEAM
}

extern "C" void kernel_launch(void* const* d_in, const int* in_sizes, int n_in, void* d_out, int out_size, void* d_ws, size_t ws_size, hipStream_t stream) {
    static int grid = 0;
    if (grid == 0) {
        if (n_in != 17 || in_sizes[0] != MR * D || out_size != MR * D || ws_size < WS_END) { fprintf(stderr, "kernel_launch: unexpected shapes (n_in %d, ws %zu)\n", n_in, ws_size); grid = -1; return; }
        int dev = 0, cus = 0;
        if (hipGetDevice(&dev) != hipSuccess || hipDeviceGetAttribute(&cus, hipDeviceAttributeMultiprocessorCount, dev) != hipSuccess) { grid = -1; return; }
        if (hipFuncSetAttribute((const void*)mega_fwd, hipFuncAttributeMaxDynamicSharedMemorySize, LDS_BYTES) != hipSuccess) { fprintf(stderr, "kernel_launch: hipFuncSetAttribute failed\n"); grid = -1; return; }
        (void)hipGetLastError();
        grid = cus;
        if (grid != 256) fprintf(stderr, "kernel_launch: %d CUs (built for 256)\n", grid);
    }
    if (grid < 0) return;
    P p{}; const float** f = &p.x; for (int i = 0; i < 17; ++i) f[i] = (const float*)d_in[i];
    p.out = (float*)d_out; p.ws = (unsigned char*)d_ws;
    (void)hipMemsetAsync((char*)d_ws + WS_CTL, 0, CTL_ZERO_BYTES, stream);
    Args a{}; a.p = p;
    int nl = 0;
    auto mega = [&](int lo, int hi) { a.ph_lo = lo; a.ph_hi = hi; a.li = nl++; hipLaunchKernelGGL(mega_fwd, dim3(grid), dim3(NWAVES * 64), LDS_BYTES, stream, a); };
    mega(0, NPHASE);

}
```

```cpp
#include <hip/hip_runtime.h>
#include <cstdint>
#include <cstdio>

#ifndef MK_PROBE
#define MK_PROBE -1
#endif
#ifndef MK_PA
#define MK_PA -1
#define MK_PB 0
#define MK_PBLK 0
#endif
#ifndef MK_MINI
#define MK_MINI 1
#endif

constexpr int D = 1024, BATCH = 4, SEQ = 4096, DEPTH = 2, NMETA = 16, L = SEQ + NMETA;
constexpr int R = BATCH * L;
constexpr int RA = R + 256;
constexpr int MR = BATCH * SEQ;
constexpr int POOLW = 512, QLR = 384, KVLR = 256, ROPE = 32, NOPE = 64, QKD = 96, VD = 64, NH = 8;
constexpr int INW = POOLW + QLR + KVLR + ROPE;
constexpr int INWP = 1280;
constexpr int FF = 2816;
constexpr float EPS = 1e-6f;
constexpr float QSCALE = 0.10206207261596577f * 1.4426950408889634f;
constexpr int QP = NH * QKD, KP = NH * QKD, VP = NH * VD, YP = D, ZP = INW, SZ = 40;

typedef unsigned short bf16;
#define GAS __attribute__((address_space(1)))
#define LAS __attribute__((address_space(3)))
constexpr size_t MiB = 1u << 20;
constexpr size_t WS_CTL = 0, CTL_ZERO_BYTES = 1 * MiB;
constexpr size_t WS_ROPE = 1 * MiB, WS_MINI = 2 * MiB, WS_W = 4 * MiB, WL_BYTES = 24 * MiB;
constexpr size_t WO_IN = 0, WO_Q = 2560 * 1024, WO_KV = 3328 * 1024, WO_P = 3840 * 1024, WO_OUT = 4 * MiB, WO_GU = 6 * MiB, WO_D = 17 * MiB;
constexpr size_t MN_HM = 0, MN_ZM = 256 * 1024, MN_YM = 384 * 1024, MN_ACT = 512 * 1024;
constexpr size_t WS_XN = 52 * MiB, WS_Y = 85 * MiB, WS_SSQH = 118 * MiB;
constexpr size_t WS_Z = 119 * MiB, WS_SSQZ = 157 * MiB, WS_Q = 160 * MiB, WS_K = 185 * MiB, WS_V = 210 * MiB, WS_PNAIVE = 227 * MiB, WS_ACT = 119 * MiB, WS_END = 244 * MiB;
static_assert(WO_IN + (size_t)INWP * D * 2 <= WO_Q && WO_Q + (size_t)768 * QLR * 2 <= WO_KV && WO_KV + (size_t)1024 * KVLR * 2 <= WO_P && WO_P + (size_t)4 * 128 * 128 * 2 <= WO_OUT &&
              WO_OUT + (size_t)D * D * 2 <= WO_GU && WO_GU + (size_t)2 * FF * D * 2 <= WO_D && WO_D + (size_t)D * FF * 2 <= WL_BYTES && WS_W + 2 * WL_BYTES <= WS_XN, "weight map");
static_assert(WS_XN + (size_t)RA * D * 2 <= WS_Y && WS_Y + (size_t)RA * D * 2 <= WS_SSQH && WS_SSQH + (size_t)RA * 16 <= WS_Z && WS_Z + (size_t)RA * INW * 2 <= WS_SSQZ && WS_SSQZ + (size_t)RA * SZ * 4 <= WS_Q &&
              WS_Q + (size_t)RA * QP * 2 <= WS_K && WS_K + (size_t)RA * KP * 2 <= WS_V && WS_V + (size_t)RA * VP * 2 <= WS_PNAIVE && WS_PNAIVE + (size_t)RA * 512 * 2 <= WS_END &&
              WS_ACT + (size_t)RA * FF * 2 <= WS_K + (size_t)R * KP * 2, "ws map");

__host__ __device__ __forceinline__ int rowbase(int pm) { return (pm >> 4) * L + NMETA + ((pm & 15) << 8); }
constexpr int KT_N = 65; constexpr size_t KT_BYTES = 12 * 1024;
__host__ __device__ __forceinline__ size_t kcell(int b, int h, int pos, int chunk) { return ((size_t)((b * NH + h) * KT_N + (pos >> 6)) * 12 + chunk) * 1024 + (size_t)(pos & 63) * 16; }
static_assert((size_t)BATCH * NH * KT_N * KT_BYTES <= 25 * MiB, "K image fits its 25 MiB of d_ws");
__device__ __forceinline__ float bf2f(bf16 v) { return __uint_as_float((unsigned)v << 16); }
typedef float pk2_f32x2 __attribute__((ext_vector_type(2))); typedef __bf16 pk2_bf16x2 __attribute__((ext_vector_type(2)));
__device__ __forceinline__ unsigned pk2(float lo, float hi) { const pk2_f32x2 v = {lo, hi}; return __builtin_bit_cast(unsigned, __builtin_convertvector(v, pk2_bf16x2)); }
__device__ __forceinline__ bf16 f2bf(float f) { return (bf16)(pk2(f, 0.f) & 0xffffu); }

struct P {
    const float *x, *meta, *attn_g, *w_in, *w_pool, *pool_scale, *qa_g, *w_q_b, *kva_g, *w_kv_b, *qn_g, *kn_g, *w_out, *ffn_g, *w_gate, *w_up, *w_down;
    float* out; unsigned char* ws;
};

typedef unsigned wt_u32x4 __attribute__((ext_vector_type(4)));
__device__ __forceinline__ __amdgpu_buffer_rsrc_t ws_rsrc(unsigned char* ws) { return __builtin_amdgcn_make_buffer_rsrc(ws, 0, 0x10000000, 0x00020000); }
__device__ __forceinline__ void st16_wt(__amdgpu_buffer_rsrc_t r, size_t off, wt_u32x4 v) { __builtin_amdgcn_raw_buffer_store_b128(v, r, (int)off, 0, 16); }
__device__ __forceinline__ void st4_wt(__amdgpu_buffer_rsrc_t r, size_t off, unsigned v) { __builtin_amdgcn_raw_buffer_store_b32(v, r, (int)off, 0, 16); }
namespace pg8 {
#define PG8_LAS __attribute__((address_space(3)))
typedef unsigned short bf16_t;
typedef short bf16x8 __attribute__((ext_vector_type(8)));
typedef float f32x4 __attribute__((ext_vector_type(4)));
typedef unsigned u32x4 __attribute__((ext_vector_type(4)));
typedef unsigned u32x2 __attribute__((ext_vector_type(2)));
constexpr int BM = 256, BK = 64, HALF = 128, HTB = HALF * BK * 2, STAGE_BYTES = 8 * HTB, NXCD = 8, WGM = 8;
__host__ __device__ __forceinline__ int lds_byte(int r, int c) { const int st = (r >> 4) * 2 + (c >> 5), rr = r & 15, cc = c & 31, ob = rr * 64 + cc * 2; return st * 1024 + (ob ^ (((ob >> 9) & 1) << 5)); }
__host__ __device__ __forceinline__ void stage_rc(int b, int& R_, int& C) { const int st = b / 1024, sb = b % 1024, swz = sb ^ (((sb >> 9) & 1) << 5); R_ = (st >> 1) * 16 + swz / 64; C = (st & 1) * 32 + (swz % 64) / 2; }
__host__ __device__ __forceinline__ int perm32(int rho) { const int n = rho >> 4, i = rho & 15; return 8 * (i >> 2) + 4 * n + (i & 3); }
struct Unit { int pm, pn, hm; };
struct Gemm { const bf16_t* A; int lda; int acolstep; const bf16_t* Bt; int K; };
struct StaticOrder {
    int nM, nN, nwg, G, c, nfull; bool own;
    __host__ __device__ void init(int nM_, int nN_, int G_, int c_, int nsplit = 0) { nM = nM_; nN = nN_; nwg = nM * nN; G = G_; c = c_; nfull = nwg - nsplit; own = nsplit == 128 && G == 256 && nM == 64 && nfull % G == 0; }
    __host__ __device__ bool next(int i, Unit& u) const {
        long Lx = (long)i * G + c; u.hm = 3;
        if (Lx >= nfull && own) { const int j = (int)(Lx - nfull); if (j >= 256) return false; u.pm = 8 * (j & 7) + ((j >> 3) & 7); u.pn = nfull / nM + (j >> 7); u.hm = 1 << ((j >> 6) & 1); return true; }
        if (Lx >= nfull) { const long j = Lx - nfull; Lx = nfull + (j >> 1); u.hm = 1 << (int)(j & 1); }
        if (Lx >= nwg) return false;
        int wgid = (int)Lx; { const int q = nwg / NXCD, r = nwg % NXCD, xcd = wgid % NXCD, off = wgid / NXCD; wgid = (xcd < r ? xcd * (q + 1) : r * (q + 1) + (xcd - r) * q) + off; }
        const int nig = WGM * nN, gid = wgid / nig, fm = gid * WGM, gsz = (nM - fm) < WGM ? (nM - fm) : WGM;
        u.pm = fm + ((wgid % nig) % gsz); u.pn = (wgid % nig) / gsz; return true;
    }
    __device__ __forceinline__ void a_ready(const Unit&) const {}
    __device__ __forceinline__ void done(const Unit&) const {}
};
__device__ __forceinline__ unsigned cvt_pk_bf16(float lo, float hi) { unsigned r; asm volatile("v_cvt_pk_bf16_f32 %0, %1, %2" : "=v"(r) : "v"(lo), "v"(hi)); return r; }
__device__ __forceinline__ float hsum4(f32x4 v) { return (v[0] * v[0] + v[1] * v[1]) + (v[2] * v[2] + v[3] * v[3]); }
__device__ __forceinline__ float xsum_q4(float x) {
    auto a = __builtin_amdgcn_permlane16_swap(__float_as_uint(x), __float_as_uint(x), false, false); x = __uint_as_float(a[0]) + __uint_as_float(a[1]);
    auto b = __builtin_amdgcn_permlane32_swap(__float_as_uint(x), __float_as_uint(x), false, false); return __uint_as_float(b[0]) + __uint_as_float(b[1]); }
__device__ __forceinline__ float xlane32(float x, bool upper) { auto b = __builtin_amdgcn_permlane32_swap(__float_as_uint(x), __float_as_uint(x), false, false); return __uint_as_float(upper ? b[0] : b[1]); }

__device__ __forceinline__ void fresh_lane(int& fr, int& fq) { unsigned m1 = ~0u; asm volatile("" : "+s"(m1)); const int lane = (int)__builtin_amdgcn_mbcnt_hi(m1, __builtin_amdgcn_mbcnt_lo(m1, 0u)); fr = lane & 15; fq = lane >> 4; }
struct EpiZ {
    static constexpr bool PERM = true, AFTER_DRAIN = false;
    bf16_t* Z; float* ssqz; const float* ssqh; const float* qa; const float* kva; unsigned char* wsb; unsigned* zflag;
    __device__ __forceinline__ void operator()(const f32x4 (&acc)[2][2][4][2], const Unit& u, int wr, int wc, int, int) const {
        int fr, fq; fresh_lane(fr, fq);
        const int kr0 = rowbase(u.pm) + wr * 64 + fr; const bool pub = u.pn < 2; const __amdgpu_buffer_rsrc_t rsr = ws_rsrc(wsb);
        f32x4 g[2][2]; bool valid[2];
#pragma unroll
        for (int bj = 0; bj < 2; ++bj) { const int cb = u.pn * BM + bj * HALF + wc * 32; valid[bj] = cb < INW; const int c0 = cb + 8 * fq;
            const float* gp = (cb >= POOLW && cb < POOLW + QLR) ? qa + (c0 - POOLW) : (cb >= POOLW + QLR && cb < POOLW + QLR + KVLR) ? kva + (c0 - POOLW - QLR) : nullptr;
            g[bj][0] = gp ? *(const f32x4*)gp : (f32x4){1.f, 1.f, 1.f, 1.f}; g[bj][1] = gp ? *(const f32x4*)(gp + 4) : (f32x4){1.f, 1.f, 1.f, 1.f}; }
        float rsv[2][4];
        { f32x4 sqv[2][4];
#pragma unroll
          for (int ai = 0; ai < 2; ++ai)
#pragma unroll
              for (int m = 0; m < 4; ++m) sqv[ai][m] = *(const GAS f32x4*)(ssqh + (size_t)(kr0 + ai * HALF + m * 16) * 4);
#pragma unroll
          for (int ai = 0; ai < 2; ++ai)
#pragma unroll
              for (int m = 0; m < 4; ++m) { const f32x4 sq = sqv[ai][m]; rsv[ai][m] = __builtin_amdgcn_rsqf(((sq[0] + sq[1]) + (sq[2] + sq[3])) * (1.0f / D) + EPS); asm volatile("" : "+v"(rsv[ai][m])); } }
#pragma unroll
        for (int ai = 0; ai < 2; ++ai) { if (!((u.hm >> ai) & 1)) continue;
#pragma unroll
            for (int m = 0; m < 4; ++m) { const int krow = kr0 + ai * HALF + m * 16;
                const float rs = rsv[ai][m];
#pragma unroll
                for (int bj = 0; bj < 2; ++bj) { if (!valid[bj]) continue;
                    const f32x4 v0 = acc[ai][bj][m][0] * rs, v1 = acc[ai][bj][m][1] * rs;
                    float ss = xsum_q4(hsum4(v0) + hsum4(v1));
                    if (fq == 0) st4_wt(rsr, WS_SSQZ + ((size_t)krow * SZ + u.pn * 8 + bj * 4 + wc) * 4, __float_as_uint(ss));
                    const f32x4 o0 = v0 * g[bj][0], o1 = v1 * g[bj][1];
                    u32x4 w; w.x = cvt_pk_bf16(o0[0], o0[1]); w.y = cvt_pk_bf16(o0[2], o0[3]); w.z = cvt_pk_bf16(o1[0], o1[1]); w.w = cvt_pk_bf16(o1[2], o1[3]);
                    st16_wt(rsr, WS_Z + ((size_t)krow * ZP + u.pn * BM + bj * HALF + wc * 32 + 8 * fq) * 2, w); } } }
        if (pub) { asm volatile("s_waitcnt vmcnt(0)" ::: "memory");
            if (fr == 0 && fq == 0) __hip_atomic_fetch_add((GAS unsigned*)(zflag + 64 * (2 * u.pm + u.pn)), 1u, __ATOMIC_RELAXED, __HIP_MEMORY_SCOPE_AGENT); }
    }
};

struct EpiQ {
    static constexpr bool PERM = true, AFTER_DRAIN = false;
    bf16_t* Q; const float* ssqz; const float* qn; const float* rope; const PG8_LAS float* rtab;
    __device__ __forceinline__ void operator()(const f32x4 (&acc)[2][2][4][2], const Unit& u, int wr, int wc, int, int) const {
        int fr, fq; fresh_lane(fr, fq);
        const int kr0 = rowbase(u.pm) + wr * 64 + fr, pos0 = NMETA + ((u.pm & 15) << 8) + wr * 64 + fr;
        float rqv[2][4];
        if (rtab) {
#pragma unroll
            for (int ai = 0; ai < 2; ++ai)
#pragma unroll
                for (int m = 0; m < 4; ++m) rqv[ai][m] = rtab[wr * 64 + fr + ai * HALF + m * 16];
        } else {
#pragma unroll
            for (int ai = 0; ai < 2; ++ai) { f32x4 raw[4][3];
#pragma unroll
                for (int m = 0; m < 4; ++m) { const GAS f32x4* sq = (const GAS f32x4*)(ssqz + (size_t)(kr0 + ai * HALF + m * 16) * SZ + 16); raw[m][0] = sq[0]; raw[m][1] = sq[1]; raw[m][2] = sq[2]; }
#pragma unroll
                for (int m = 0; m < 4; ++m) { const f32x4 t = raw[m][0] + raw[m][1] + raw[m][2]; rqv[ai][m] = __builtin_amdgcn_rsqf(((t[0] + t[1]) + (t[2] + t[3])) * (1.0f / QLR) + EPS); }
                asm volatile("" ::: "memory"); }
        }
        if (u.pn < 2) {
            const int head = 4 * u.pn + wc; f32x4 gq[2][2];
#pragma unroll
            for (int bj = 0; bj < 2; ++bj)
#pragma unroll
                for (int n = 0; n < 2; ++n) gq[bj][n] = *(const f32x4*)(qn + 32 * bj + 8 * fq + 4 * n);
#pragma unroll
            for (int ai = 0; ai < 2; ++ai) {
#pragma unroll
                for (int m = 0; m < 4; ++m) { const int krow = kr0 + ai * HALF + m * 16;
                    const float rq = rqv[ai][m]; float ss = 0.f;
#pragma unroll
                    for (int bj = 0; bj < 2; ++bj)
#pragma unroll
                        for (int n = 0; n < 2; ++n) ss += hsum4(acc[ai][bj][m][n]);
                    ss = xsum_q4(ss) * (rq * rq);
                    const float r1 = __builtin_amdgcn_rsqf(ss * (1.0f / NOPE) + EPS) * (QSCALE * rq);
                    bf16_t* qp = Q + (size_t)krow * QP + head * QKD + 8 * fq;
#pragma unroll
                    for (int bj = 0; bj < 2; ++bj) { const f32x4 o0 = acc[ai][bj][m][0] * r1 * gq[bj][0], o1 = acc[ai][bj][m][1] * r1 * gq[bj][1];
                        u32x4 w; w.x = cvt_pk_bf16(o0[0], o0[1]); w.y = cvt_pk_bf16(o0[2], o0[3]); w.z = cvt_pk_bf16(o1[0], o1[1]); w.w = cvt_pk_bf16(o1[2], o1[3]); *(GAS u32x4*)(qp + 32 * bj) = w; } }
                asm volatile("" ::: "memory"); }
        } else {
            const bool lo = fq < 2; const int jj = 8 * (fq & 1);
            const f32x4 g0 = *(const f32x4*)(qn + NOPE + 8 * fq), g1 = *(const f32x4*)(qn + NOPE + 8 * fq + 4);
            f32x4 cc[2][2], sc[2][2];
#define ROPE_LD(rg_, b_) do { const GAS float* rp = (const GAS float*)rope + (size_t)(pos0 + ((rg_) >> 2) * HALF + ((rg_) & 3) * 16) * 32 + jj; \
                cc[b_][0] = *(const GAS f32x4*)rp; cc[b_][1] = *(const GAS f32x4*)(rp + 4); sc[b_][0] = *(const GAS f32x4*)(rp + 16); sc[b_][1] = *(const GAS f32x4*)(rp + 20); } while (0)
            ROPE_LD(0, 0);
#pragma unroll
            for (int rg = 0; rg < 8; ++rg) { const int ai = rg >> 2, m = rg & 3, bb = rg & 1; const int krow = kr0 + ai * HALF + m * 16;
                if (rg + 1 < 8) { ROPE_LD(rg + 1, (rg + 1) & 1); }
                __builtin_amdgcn_sched_barrier(0);
                const float rq = rqv[ai][m];
#pragma unroll
                for (int bj = 0; bj < 2; ++bj) { const int head = 4 * bj + wc; const f32x4 v0 = acc[ai][bj][m][0] * rq, v1 = acc[ai][bj][m][1] * rq;
                    float ss = xsum_q4(hsum4(v0) + hsum4(v1));
                    const float r2 = __builtin_amdgcn_rsqf(ss * (1.0f / ROPE) + EPS) * QSCALE;
                    const f32x4 y0 = v0 * r2 * g0, y1 = v1 * r2 * g1; f32x4 p0, p1;
#pragma unroll
                    for (int e = 0; e < 4; ++e) { p0[e] = xlane32(y0[e], !lo); p1[e] = xlane32(y1[e], !lo); }
                    const f32x4 o0 = lo ? y0 * cc[bb][0] - p0 * sc[bb][0] : p0 * sc[bb][0] + y0 * cc[bb][0], o1 = lo ? y1 * cc[bb][1] - p1 * sc[bb][1] : p1 * sc[bb][1] + y1 * cc[bb][1];
                    u32x4 w; w.x = cvt_pk_bf16(o0[0], o0[1]); w.y = cvt_pk_bf16(o0[2], o0[3]); w.z = cvt_pk_bf16(o1[0], o1[1]); w.w = cvt_pk_bf16(o1[2], o1[3]);
                    *(GAS u32x4*)(Q + (size_t)krow * QP + head * QKD + NOPE + 8 * fq) = w; }
                asm volatile("" ::: "memory"); }
#undef ROPE_LD
        }
    }
};
struct EpiKV {
    static constexpr bool PERM = true, AFTER_DRAIN = false;
    bf16_t* Kb; bf16_t* Vb; const float* ssqz; const float* kn; const PG8_LAS float* rtab;
    __device__ __forceinline__ void operator()(const f32x4 (&acc)[2][2][4][2], const Unit& u, int wr, int wc, int, int) const {
        int fr, fq; fresh_lane(fr, fq);
        const int kr0 = rowbase(u.pm) + wr * 64 + fr; const bool isk = u.pn < 2; const int head = 4 * (u.pn & 1) + wc;
        f32x4 gk[2][2];
#pragma unroll
        for (int bj = 0; bj < 2; ++bj)
#pragma unroll
            for (int n = 0; n < 2; ++n) gk[bj][n] = isk ? *(const f32x4*)(kn + 32 * bj + 8 * fq + 4 * n) : (f32x4){1.f, 1.f, 1.f, 1.f};
        float rkv[2][4];
        if (rtab) {
#pragma unroll
            for (int ai = 0; ai < 2; ++ai)
#pragma unroll
                for (int m = 0; m < 4; ++m) rkv[ai][m] = rtab[wr * 64 + fr + ai * HALF + m * 16];
        } else {
#pragma unroll
            for (int ai = 0; ai < 2; ++ai) { f32x4 tk[4];
#pragma unroll
                for (int m = 0; m < 4; ++m) { const GAS f32x4* sq = (const GAS f32x4*)(ssqz + (size_t)(kr0 + ai * HALF + m * 16) * SZ + 28); tk[m] = sq[0] + sq[1]; }
#pragma unroll
                for (int m = 0; m < 4; ++m) { const f32x4 t = tk[m]; rkv[ai][m] = __builtin_amdgcn_rsqf(((t[0] + t[1]) + (t[2] + t[3])) * (1.0f / KVLR) + EPS); }
                asm volatile("" ::: "memory"); }
        }
#pragma unroll
        for (int ai = 0; ai < 2; ++ai) {
#pragma unroll
            for (int m = 0; m < 4; ++m) { const int krow = kr0 + ai * HALF + m * 16;
                const float rk = rkv[ai][m];
                const int kb_ = u.pm >> 4, kpos = NMETA + ((u.pm & 15) << 8) + ai * HALF + wr * 64 + m * 16 + fr;
                if (isk) {
                    float ss = 0.f;
#pragma unroll
                    for (int bj = 0; bj < 2; ++bj)
#pragma unroll
                        for (int n = 0; n < 2; ++n) ss += hsum4(acc[ai][bj][m][n]);
                    ss = xsum_q4(ss) * (rk * rk);
                    const float k1 = __builtin_amdgcn_rsqf(ss * (1.0f / NOPE) + EPS) * rk;
#pragma unroll
                    for (int bj = 0; bj < 2; ++bj) { const f32x4 o0 = acc[ai][bj][m][0] * k1 * gk[bj][0], o1 = acc[ai][bj][m][1] * k1 * gk[bj][1];
                        u32x4 w; w.x = cvt_pk_bf16(o0[0], o0[1]); w.y = cvt_pk_bf16(o0[2], o0[3]); w.z = cvt_pk_bf16(o1[0], o1[1]); w.w = cvt_pk_bf16(o1[2], o1[3]);
                        *(GAS u32x4*)((GAS unsigned char*)Kb + kcell(kb_, head, kpos, 4 * bj + fq)) = w; }
                } else {
                    bf16_t* op = Vb + (size_t)krow * VP + head * VD + 8 * fq;
#pragma unroll
                    for (int bj = 0; bj < 2; ++bj) { const f32x4 o0 = acc[ai][bj][m][0] * rk, o1 = acc[ai][bj][m][1] * rk;
                        u32x4 w; w.x = cvt_pk_bf16(o0[0], o0[1]); w.y = cvt_pk_bf16(o0[2], o0[3]); w.z = cvt_pk_bf16(o1[0], o1[1]); w.w = cvt_pk_bf16(o1[2], o1[3]);
                        *(GAS u32x4*)(op + 32 * bj) = w; }
                } }
            asm volatile("" ::: "memory"); }
    }
};
template <bool WT> struct EpiResT {
    static constexpr bool PERM = true, AFTER_DRAIN = true;
    bf16_t* h16; float* ssqh; float* outf;
    __device__ __forceinline__ void prefetch(const Unit& u, int wr, int wc, u32x4 (&pre)[2][4][2]) const {
        int fr, fq; fresh_lane(fr, fq);
        const int col0 = u.pn * BM + wc * 32 + 8 * fq;
#pragma unroll
        for (int ai = 0; ai < 2; ++ai)
#pragma unroll
            for (int m = 0; m < 4; ++m)
#pragma unroll
                for (int bj = 0; bj < 2; ++bj) pre[ai][m][bj] = *(const GAS u32x4*)(h16 + (size_t)(rowbase(u.pm) + ai * HALF + wr * 64 + m * 16 + fr) * D + col0 + bj * HALF);
    }
    __device__ __forceinline__ void fused(const f32x4 (&acc)[2][2][4][2], const Unit& u, int wr, int wc, int, int, PG8_LAS unsigned char* lds, int wid, int, const u32x4 (&pre)[2][4][2]) const {
        int fr, fq; fresh_lane(fr, fq);
        const int col0 = u.pn * BM + wc * 32 + 8 * fq; const bool fin = outf != nullptr;
        const __amdgpu_buffer_rsrc_t rsh = ws_rsrc((unsigned char*)h16), rss = ws_rsrc((unsigned char*)ssqh);
        PG8_LAS float* Pp = (PG8_LAS float*)lds;
#pragma unroll
        for (int ai = 0; ai < 2; ++ai) {
#pragma unroll
            for (int m = 0; m < 4; ++m) { const int r = ai * HALF + wr * 64 + m * 16 + fr; float ss = 0.f;
#pragma unroll
                for (int bj = 0; bj < 2; ++bj) { const u32x4 pw = pre[ai][m][bj];
                    const f32x4 b0 = {__uint_as_float(pw.x << 16), __uint_as_float(pw.x & 0xffff0000u), __uint_as_float(pw.y << 16), __uint_as_float(pw.y & 0xffff0000u)};
                    const f32x4 b1 = {__uint_as_float(pw.z << 16), __uint_as_float(pw.z & 0xffff0000u), __uint_as_float(pw.w << 16), __uint_as_float(pw.w & 0xffff0000u)};
                    const f32x4 o0 = b0 + acc[ai][bj][m][0], o1 = b1 + acc[ai][bj][m][1];
                    if (fin) { GAS f32x4* op = (GAS f32x4*)(outf + (size_t)(u.pm * BM + r) * D + col0 + bj * HALF); op[0] = o0; op[1] = o1; }
                    else { ss += hsum4(o0) + hsum4(o1); u32x4 w; w.x = cvt_pk_bf16(o0[0], o0[1]); w.y = cvt_pk_bf16(o0[2], o0[3]); w.z = cvt_pk_bf16(o1[0], o1[1]); w.w = cvt_pk_bf16(o1[2], o1[3]);
                        if (WT) st16_wt(rsh, ((size_t)(rowbase(u.pm) + r) * D + col0 + bj * HALF) * 2, __builtin_bit_cast(wt_u32x4, w)); else *(GAS u32x4*)(h16 + (size_t)(rowbase(u.pm) + r) * D + col0 + bj * HALF) = w; } }
                if (!fin) { ss = xsum_q4(ss); if (fq == 0) Pp[r * 4 + wc] = ss; } }
            asm volatile("" ::: "memory"); }
        if (!fin) {
            asm volatile("s_waitcnt lgkmcnt(0)" ::: "memory"); __builtin_amdgcn_s_barrier(); asm volatile("" ::: "memory");
            const int t = wid * 64 + fq * 16 + fr;
            if (t < 256) { const f32x4 q = *(const PG8_LAS f32x4*)(Pp + t * 4); const float sv = (q[0] + q[1]) + (q[2] + q[3]);
                if (WT) st4_wt(rss, ((size_t)(rowbase(u.pm) + t) * 4 + u.pn) * 4, __float_as_uint(sv)); else ((GAS float*)ssqh)[(size_t)(rowbase(u.pm) + t) * 4 + u.pn] = sv; }
        }
    }
};
using EpiRes = EpiResT<false>;
struct EpiSwiGLU {
    static constexpr bool PERM = true, AFTER_DRAIN = false;
    bf16_t* act; const float* ssqh; const PG8_LAS float* rst;
    __device__ __forceinline__ void operator()(const f32x4 (&acc)[2][2][4][2], const Unit& u, int wr, int wc, int, int) const {
        int fr, fq; fresh_lane(fr, fq);
        const int kr0 = rowbase(u.pm) + wr * 64 + fr; const __amdgpu_buffer_rsrc_t rsa = ws_rsrc((unsigned char*)act);
        float rsv[2][4];
        if (rst) {
#pragma unroll
            for (int ai = 0; ai < 2; ++ai)
#pragma unroll
                for (int m = 0; m < 4; ++m) rsv[ai][m] = rst[wr * 64 + fr + ai * HALF + m * 16];
        } else {
            f32x4 sqv[2][4];
#pragma unroll
            for (int ai = 0; ai < 2; ++ai)
#pragma unroll
                for (int m = 0; m < 4; ++m) sqv[ai][m] = *(const GAS f32x4*)(ssqh + (size_t)(kr0 + ai * HALF + m * 16) * 4);
#pragma unroll
            for (int ai = 0; ai < 2; ++ai)
#pragma unroll
                for (int m = 0; m < 4; ++m) { const f32x4 sq = sqv[ai][m]; rsv[ai][m] = rsqrtf(((sq[0] + sq[1]) + (sq[2] + sq[3])) * (1.0f / D) + EPS); }
        }
#pragma unroll
        for (int ai = 0; ai < 2; ++ai) { if (!((u.hm >> ai) & 1)) continue;
#pragma unroll
            for (int m = 0; m < 4; ++m) { const int krow = kr0 + ai * HALF + m * 16;
                const float rs = rsv[ai][m];
                const float cneg = -1.4426950408889634f * rs, rs2 = rs * rs;
                f32x4 a[2], t[2], p[2];
#pragma unroll
                for (int n = 0; n < 2; ++n) { t[n] = acc[ai][0][m][n] * cneg; p[n] = acc[ai][0][m][n] * acc[ai][1][m][n]; }
#pragma unroll
                for (int n = 0; n < 2; ++n)
#pragma unroll
                    for (int e = 0; e < 4; ++e) t[n][e] = __builtin_amdgcn_exp2f(t[n][e]);
#pragma unroll
                for (int n = 0; n < 2; ++n) t[n] = t[n] + 1.0f;
#pragma unroll
                for (int n = 0; n < 2; ++n)
#pragma unroll
                    for (int e = 0; e < 4; ++e) t[n][e] = __builtin_amdgcn_rcpf(t[n][e]);
#pragma unroll
                for (int n = 0; n < 2; ++n) a[n] = p[n] * (t[n] * rs2);
                u32x4 w; w.x = cvt_pk_bf16(a[0][0], a[0][1]); w.y = cvt_pk_bf16(a[0][2], a[0][3]); w.z = cvt_pk_bf16(a[1][0], a[1][1]); w.w = cvt_pk_bf16(a[1][2], a[1][3]);
                st16_wt(rsa, ((size_t)krow * FF + u.pn * HALF + wc * 32 + 8 * fq) * 2, __builtin_bit_cast(wt_u32x4, w)); } }
    }
};

#define PG8_KLOOP(H0_, H1_) _Pragma("unroll 1") \
        for (int t = 0; t < nt; t += 2) { \
            const bool last = (t == nt - 2); \
            const char* a1 = cA + (size_t)(t + 1) * kstep; \
            const char* a2 = last ? nA : cA + (size_t)(t + 2) * kstep; const char* b2 = last ? nB : cB + (size_t)(t + 2) * kstep; \
            const char* a3 = a2 + kstep; const char* b3 = b2 + kstep; \
            if (last && has_next) S.a_ready(nxt); \
            if constexpr (SP2) { \
            PG8_LDB(B0, 0, 0); PG8_LDB(B1, 0, 1); PG8_SCHED; PG8_LDA(At, 0, 0); PG8_STAGE(PG8_SA(1, 1), a1 + hstepA, voffA); \
            PG8_WAIT_V(8); PG8_WAIT_L(0); PG8_BAR; if (H0_) { PG8_MMA(0, 0, At, B0); PG8_MMA(0, 1, At, B1); } PG8_BAR; PG8_SCHED; \
            PG8_LDA(At, 0, 1); PG8_STAGE(PG8_SB(0, 0), b2, voffB); PG8_STAGE(PG8_SB(0, 1), b2 + hstepB, voffB); PG8_STAGE(PG8_SA(0, 0), a2, voffA); \
            PG8_WAIT_V(8); PG8_WAIT_L(0); PG8_BAR; if (H1_) { PG8_MMA(1, 0, At, B0); PG8_MMA(1, 1, At, B1); } PG8_BAR; PG8_SCHED; \
            PG8_LDB(B0, 1, 0); PG8_LDB(B1, 1, 1); PG8_SCHED; PG8_LDA(At, 1, 0); PG8_STAGE(PG8_SA(0, 1), a2 + hstepA, voffA); \
            PG8_WAIT_V(8); PG8_WAIT_L(0); PG8_BAR; if (H0_) { PG8_MMA(0, 0, At, B0); PG8_MMA(0, 1, At, B1); } PG8_BAR; PG8_SCHED; \
            PG8_LDA(At, 1, 1); PG8_STAGE(PG8_SB(1, 0), b3, voffB); PG8_STAGE(PG8_SB(1, 1), b3 + hstepB, voffB); PG8_STAGE(PG8_SA(1, 0), a3, voffA); \
            PG8_WAIT_V(8); PG8_WAIT_L(0); PG8_BAR; if (H1_) { PG8_MMA(1, 0, At, B0); PG8_MMA(1, 1, At, B1); } PG8_BAR; PG8_SCHED; \
            } else { \
            PG8_LDB(B0, 0, 0); PG8_SCHED; PG8_LDA(At, 0, 0); PG8_STAGE(PG8_SA(1, 1), a1 + hstepA, voffA); \
            PG8_WAIT_L(8); PG8_BAR; PG8_WAIT_L(0); PG8_MMA(0, 0, At, B0); PG8_BAR; PG8_SCHED; \
            PG8_LDB(B1, 0, 1); PG8_STAGE(PG8_SB(0, 0), b2, voffB); \
            PG8_BAR; PG8_WAIT_L(0); PG8_MMA(0, 1, At, B1); PG8_BAR; \
            PG8_LDA(At, 0, 1); PG8_STAGE(PG8_SA(0, 0), a2, voffA); \
            PG8_BAR; PG8_WAIT_L(0); PG8_MMA(1, 0, At, B0); PG8_BAR; PG8_SCHED; \
            PG8_STAGE(PG8_SB(0, 1), b2 + hstepB, voffB); \
            PG8_WAIT_V(6); PG8_BAR; PG8_MMA(1, 1, At, B1); PG8_BAR; \
            PG8_LDB(B0, 1, 0); PG8_SCHED; PG8_LDA(At, 1, 0); PG8_STAGE(PG8_SA(0, 1), a2 + hstepA, voffA); \
            PG8_WAIT_L(8); PG8_BAR; PG8_WAIT_L(0); PG8_MMA(0, 0, At, B0); PG8_BAR; PG8_SCHED; \
            PG8_LDB(B1, 1, 1); PG8_STAGE(PG8_SB(1, 0), b3, voffB); \
            PG8_BAR; PG8_WAIT_L(0); PG8_MMA(0, 1, At, B1); PG8_BAR; \
            PG8_LDA(At, 1, 1); PG8_STAGE(PG8_SA(1, 0), a3, voffA); \
            PG8_BAR; PG8_WAIT_L(0); PG8_MMA(1, 0, At, B0); PG8_BAR; PG8_SCHED; \
            PG8_STAGE(PG8_SB(1, 1), b3 + hstepB, voffB); \
            PG8_WAIT_V(6); PG8_BAR; PG8_MMA(1, 1, At, B1); PG8_BAR; \
            } \
        }
template <class Epi, class Sched, bool ALIGN_EPI = false, bool SP2 = false, bool HALVES = false>
__device__ __forceinline__ void gemm_phase(PG8_LAS unsigned char* lds, const Gemm g, const Sched& S, const Epi& E, const int wid, volatile PG8_LAS unsigned* stp = nullptr) {
#define GST(i) do { if (stp && threadIdx.x == 0) stp[i] = (unsigned)__builtin_amdgcn_s_memrealtime(); } while (0)
    GST(0);
    int fr_, fq_; fresh_lane(fr_, fq_);
    const int lane = fq_ * 16 + fr_, tid = wid * 64 + lane, wr = wid >> 2, wc = wid & 3, fr = lane & 15, fq = lane >> 4;
    const int K = g.K, nt = K / BK, lda = g.lda;
    unsigned voffA[2], voffB[2];
#pragma unroll
    for (int i = 0; i < 2; ++i) { int R_, C; stage_rc(tid * 16 + i * 8192, R_, C); const int Rb = Epi::PERM ? ((R_ & ~31) + perm32(R_ & 31)) : R_;
        voffA[i] = (unsigned)(R_ * lda + C) * 2u; voffB[i] = (unsigned)(Rb * K + C) * 2u; }
    const size_t kstep = (size_t)(BK * 2);
    const size_t hstepA = (size_t)HALF * lda * 2, hstepB = (size_t)HALF * K * 2, tstepB = 2 * hstepB;
    const unsigned ldsw = (unsigned)wid * 1024u;
    const int aoff = lds_byte(wr * 64 + fr, fq * 8), boff = lds_byte(wc * 32 + fr, fq * 8);
#define PG8_SA(b, h) (((b) * 2 + (h)) * HTB)
#define PG8_SB(b, h) ((4 + (b) * 2 + (h)) * HTB)
#define PG8_STAGE(bufoff, gbase, voff) do { _Pragma("unroll") for (int _i = 0; _i < 2; ++_i) \
        __builtin_amdgcn_global_load_lds((const unsigned*)((const char*)(gbase) + (voff)[_i]), (PG8_LAS unsigned*)(lds + (bufoff) + ldsw + _i * 8192), 16, 0, 0); } while (0)
#define PG8_LDA(dst, b, h) do { _Pragma("unroll") for (int m = 0; m < 4; ++m) _Pragma("unroll") for (int k = 0; k < 2; ++k) dst[m][k] = *(const PG8_LAS bf16x8*)(lds + PG8_SA(b, h) + aoff + m * 2048 + k * 1024); } while (0)
#define PG8_LDB(dst, b, h) do { _Pragma("unroll") for (int n = 0; n < 2; ++n) _Pragma("unroll") for (int k = 0; k < 2; ++k) dst[n][k] = *(const PG8_LAS bf16x8*)(lds + PG8_SB(b, h) + boff + n * 2048 + k * 1024); } while (0)
#define PG8_MMA(ai, bj, At, Bt) do { __builtin_amdgcn_s_setprio(1); _Pragma("unroll") for (int m = 0; m < 4; ++m) _Pragma("unroll") for (int n = 0; n < 2; ++n) _Pragma("unroll") for (int k = 0; k < 2; ++k) \
        acc[ai][bj][m][n] = __builtin_amdgcn_mfma_f32_16x16x32_bf16(Bt[n][k], At[m][k], acc[ai][bj][m][n], 0, 0, 0); __builtin_amdgcn_s_setprio(0); } while (0)
#define PG8_WAIT_V(n) asm volatile("s_waitcnt vmcnt(" #n ")" ::: "memory")
#define PG8_WAIT_L(n) asm volatile("s_waitcnt lgkmcnt(" #n ")" ::: "memory")
#define PG8_BAR __builtin_amdgcn_s_barrier()
#define PG8_SCHED __builtin_amdgcn_sched_barrier(0)
#define PG8_APTR(u_) ((const char*)g.A + ((size_t)rowbase((u_).pm) * lda + (size_t)(u_).pn * g.acolstep) * 2)
#define PG8_BPTR(u_) ((const char*)g.Bt + (size_t)(u_).pn * tstepB)
    Unit cur, nxt; int ui = 0;
    if (!S.next(0, cur)) return;
    f32x4 acc[2][2][4][2];
#pragma unroll
    for (int a = 0; a < 2; ++a)
#pragma unroll
        for (int b = 0; b < 2; ++b)
#pragma unroll
            for (int m = 0; m < 4; ++m)
#pragma unroll
                for (int n = 0; n < 2; ++n) acc[a][b][m][n] = (f32x4){0.f, 0.f, 0.f, 0.f};
    bf16x8 At[4][2], B0[2][2], B1[2][2];
    const char* cA = PG8_APTR(cur); const char* cB = PG8_BPTR(cur);
    S.a_ready(cur);
    if constexpr (SP2) {
        PG8_STAGE(PG8_SB(0, 0), cB, voffB); PG8_STAGE(PG8_SB(0, 1), cB + hstepB, voffB); PG8_STAGE(PG8_SA(0, 0), cA, voffA); PG8_STAGE(PG8_SA(0, 1), cA + hstepA, voffA);
        if (wr == 1) PG8_BAR;
        PG8_WAIT_V(2); PG8_BAR;
        PG8_STAGE(PG8_SB(1, 0), cB + kstep, voffB); PG8_STAGE(PG8_SA(1, 0), cA + kstep, voffA); PG8_STAGE(PG8_SB(1, 1), cB + hstepB + kstep, voffB);
        PG8_WAIT_V(6); PG8_BAR;
    } else {
        PG8_STAGE(PG8_SB(0, 0), cB, voffB); PG8_STAGE(PG8_SA(0, 0), cA, voffA); PG8_STAGE(PG8_SB(0, 1), cB + hstepB, voffB); PG8_STAGE(PG8_SA(0, 1), cA + hstepA, voffA);
        if (wr == 1) PG8_BAR;
        PG8_WAIT_V(4); PG8_BAR;
        PG8_STAGE(PG8_SB(1, 0), cB + kstep, voffB); PG8_STAGE(PG8_SA(1, 0), cA + kstep, voffA); PG8_STAGE(PG8_SB(1, 1), cB + hstepB + kstep, voffB);
        PG8_WAIT_V(6); PG8_BAR;
    }
    GST(1);
    for (;;) {
        const bool has_next = S.next(ui + 1, nxt);
        const char* nA = has_next ? PG8_APTR(nxt) : cA; const char* nB = has_next ? PG8_BPTR(nxt) : cB;
        if constexpr (HALVES) { if (cur.hm == 3) { PG8_KLOOP(true, true) } else if (cur.hm == 1) { PG8_KLOOP(true, false) } else { PG8_KLOOP(false, true) } }
        else { PG8_KLOOP(true, true) }
        if constexpr (ALIGN_EPI) { if (wr == 0) PG8_BAR; }
        GST(2);
        if constexpr (!Epi::AFTER_DRAIN) { E(acc, cur, wr, wc, fr, fq); S.done(cur); }
        GST(3);
        if (!has_next) break;
#pragma unroll
        for (int a = 0; a < 2; ++a)
#pragma unroll
            for (int b = 0; b < 2; ++b)
#pragma unroll
                for (int m = 0; m < 4; ++m)
#pragma unroll
                    for (int n = 0; n < 2; ++n) acc[a][b][m][n] = (f32x4){0.f, 0.f, 0.f, 0.f};
        cur = nxt; cA = nA; cB = nB; ++ui;
        if constexpr (ALIGN_EPI) { if (wr == 1) PG8_BAR; }
    }
    if constexpr (Epi::AFTER_DRAIN) {
        u32x4 pre[2][4][2]; E.prefetch(cur, wr, wc, pre);
        PG8_WAIT_V(0);
        if constexpr (!ALIGN_EPI) { if (wr == 0) PG8_BAR; }
        PG8_BAR;
        GST(4);
        E.fused(acc, cur, wr, wc, fr, fq, lds, wid, lane, pre); S.done(cur);
    } else {
    PG8_WAIT_V(0);
    if constexpr (!ALIGN_EPI) { if (wr == 0) PG8_BAR; }
    PG8_BAR;
    GST(4);
    }
    GST(5);
#undef GST
#undef PG8_SA
#undef PG8_SB
#undef PG8_STAGE
#undef PG8_LDA
#undef PG8_LDB
#undef PG8_MMA
#undef PG8_WAIT_V
#undef PG8_WAIT_L
#undef PG8_BAR
#undef PG8_SCHED
#undef PG8_APTR
#undef PG8_BPTR
}
template <class Epi0, class Epi1, class Sched0, class Sched1>
__device__ __forceinline__ void gemm_phase2(PG8_LAS unsigned char* lds, const Gemm g0, const Gemm g1, const Sched0& S0, const Sched1& S1, const Epi0& E0, const Epi1& E1, const int wid) {
    static_assert(Epi0::PERM && Epi1::PERM && !Epi0::AFTER_DRAIN && !Epi1::AFTER_DRAIN, "gemm_phase2: in-loop PERM epilogues");
    int fr_, fq_; fresh_lane(fr_, fq_);
    const int lane = fq_ * 16 + fr_, tid = wid * 64 + lane, wr = wid >> 2, wc = wid & 3, fr = lane & 15, fq = lane >> 4;
    const int lda = g0.lda;
    unsigned voffA[2], voffB0[2], voffB1[2];
#pragma unroll
    for (int i = 0; i < 2; ++i) { int R_, C; stage_rc(tid * 16 + i * 8192, R_, C); const int Rb = (R_ & ~31) + perm32(R_ & 31);
        voffA[i] = (unsigned)(R_ * lda + C) * 2u; voffB0[i] = (unsigned)(Rb * g0.K + C) * 2u; voffB1[i] = (unsigned)(Rb * g1.K + C) * 2u; }
    const size_t kstep = (size_t)(BK * 2), hstepA = (size_t)HALF * lda * 2;
    const unsigned ldsw = (unsigned)wid * 1024u;
    const int aoff = lds_byte(wr * 64 + fr, fq * 8), boff = lds_byte(wc * 32 + fr, fq * 8);
#define PG8_SA(b, h) (((b) * 2 + (h)) * HTB)
#define PG8_SB(b, h) ((4 + (b) * 2 + (h)) * HTB)
#define PG8_STAGEA(bufoff, gbase) do { _Pragma("unroll") for (int _i = 0; _i < 2; ++_i) \
        __builtin_amdgcn_global_load_lds((const unsigned*)((const char*)(gbase) + voffA[_i]), (PG8_LAS unsigned*)(lds + (bufoff) + ldsw + _i * 8192), 16, 0, 0); } while (0)
#define PG8_STAGEB(bufoff, gbase, sg) do { _Pragma("unroll") for (int _i = 0; _i < 2; ++_i) \
        __builtin_amdgcn_global_load_lds((const unsigned*)((const char*)(gbase) + ((sg) ? voffB1[_i] : voffB0[_i])), (PG8_LAS unsigned*)(lds + (bufoff) + ldsw + _i * 8192), 16, 0, 0); } while (0)
#define PG8_LDA(dst, b, h) do { _Pragma("unroll") for (int m = 0; m < 4; ++m) _Pragma("unroll") for (int k = 0; k < 2; ++k) dst[m][k] = *(const PG8_LAS bf16x8*)(lds + PG8_SA(b, h) + aoff + m * 2048 + k * 1024); } while (0)
#define PG8_LDB(dst, b, h) do { _Pragma("unroll") for (int n = 0; n < 2; ++n) _Pragma("unroll") for (int k = 0; k < 2; ++k) dst[n][k] = *(const PG8_LAS bf16x8*)(lds + PG8_SB(b, h) + boff + n * 2048 + k * 1024); } while (0)
#define PG8_MMA(ai, bj, At, Bt) do { __builtin_amdgcn_s_setprio(1); _Pragma("unroll") for (int m = 0; m < 4; ++m) _Pragma("unroll") for (int n = 0; n < 2; ++n) _Pragma("unroll") for (int k = 0; k < 2; ++k) \
        acc[ai][bj][m][n] = __builtin_amdgcn_mfma_f32_16x16x32_bf16(Bt[n][k], At[m][k], acc[ai][bj][m][n], 0, 0, 0); __builtin_amdgcn_s_setprio(0); } while (0)
#define PG8_WAIT_V(n) asm volatile("s_waitcnt vmcnt(" #n ")" ::: "memory")
#define PG8_WAIT_L(n) asm volatile("s_waitcnt lgkmcnt(" #n ")" ::: "memory")
#define PG8_BAR __builtin_amdgcn_s_barrier()
#define PG8_SCHED __builtin_amdgcn_sched_barrier(0)
#define PG8_APTR(u_, sg) ((const char*)((sg) ? g1.A : g0.A) + ((size_t)rowbase((u_).pm) * lda + (size_t)(u_).pn * ((sg) ? g1.acolstep : g0.acolstep)) * 2)
#define PG8_BPTR(u_, sg) ((const char*)((sg) ? g1.Bt : g0.Bt) + (size_t)(u_).pn * (size_t)(2 * HALF * 2) * ((sg) ? g1.K : g0.K))
    Unit cur, nxt; int cs, ns, i0 = 0, i1 = 0;
    if (S0.next(0, cur)) { cs = 0; i0 = 1; } else if (S1.next(0, cur)) { cs = 1; i1 = 1; } else return;
    f32x4 acc[2][2][4][2];
#pragma unroll
    for (int a = 0; a < 2; ++a)
#pragma unroll
        for (int b = 0; b < 2; ++b)
#pragma unroll
            for (int m = 0; m < 4; ++m)
#pragma unroll
                for (int n = 0; n < 2; ++n) acc[a][b][m][n] = (f32x4){0.f, 0.f, 0.f, 0.f};
    bf16x8 At[4][2], B0[2][2], B1[2][2];
    const char* cA = PG8_APTR(cur, cs); const char* cB = PG8_BPTR(cur, cs);
    { const size_t hB = (size_t)HALF * (cs ? g1.K : g0.K) * 2;
      PG8_STAGEB(PG8_SB(0, 0), cB, cs); PG8_STAGEB(PG8_SB(0, 1), cB + hB, cs); PG8_STAGEA(PG8_SA(0, 0), cA); PG8_STAGEA(PG8_SA(0, 1), cA + hstepA);
      if (wr == 1) PG8_BAR;
      PG8_WAIT_V(2); PG8_BAR;
      PG8_STAGEB(PG8_SB(1, 0), cB + kstep, cs); PG8_STAGEA(PG8_SA(1, 0), cA + kstep); PG8_STAGEB(PG8_SB(1, 1), cB + hB + kstep, cs);
      PG8_WAIT_V(6); PG8_BAR; }
    for (;;) {
        bool has_next;
        if (cs == 0 && S0.next(i0, nxt)) { has_next = true; ns = 0; ++i0; } else if (S1.next(i1, nxt)) { has_next = true; ns = 1; ++i1; } else { has_next = false; ns = cs; }
        const char* nA = has_next ? PG8_APTR(nxt, ns) : cA; const char* nB = has_next ? PG8_BPTR(nxt, ns) : cB;
        const int nt = (cs ? g1.K : g0.K) / BK;
        const size_t hBc = (size_t)HALF * (cs ? g1.K : g0.K) * 2, hBn = (size_t)HALF * (ns ? g1.K : g0.K) * 2;
#pragma unroll 1
        for (int t = 0; t < nt; t += 2) {
            const bool last = (t == nt - 2);
            const char* a1 = cA + (size_t)(t + 1) * kstep;
            const char* a2 = last ? nA : cA + (size_t)(t + 2) * kstep; const char* b2 = last ? nB : cB + (size_t)(t + 2) * kstep;
            const char* a3 = a2 + kstep; const char* b3 = b2 + kstep;
            const int sg2 = last ? ns : cs; const size_t hB2 = last ? hBn : hBc;
            PG8_LDB(B0, 0, 0); PG8_LDB(B1, 0, 1); PG8_SCHED; PG8_LDA(At, 0, 0); PG8_STAGEA(PG8_SA(1, 1), a1 + hstepA);
            PG8_WAIT_V(8); PG8_WAIT_L(0); PG8_BAR; PG8_MMA(0, 0, At, B0); PG8_MMA(0, 1, At, B1); PG8_BAR; PG8_SCHED;
            PG8_LDA(At, 0, 1); PG8_STAGEB(PG8_SB(0, 0), b2, sg2); PG8_STAGEB(PG8_SB(0, 1), b2 + hB2, sg2); PG8_STAGEA(PG8_SA(0, 0), a2);
            PG8_WAIT_V(8); PG8_WAIT_L(0); PG8_BAR; PG8_MMA(1, 0, At, B0); PG8_MMA(1, 1, At, B1); PG8_BAR; PG8_SCHED;
            PG8_LDB(B0, 1, 0); PG8_LDB(B1, 1, 1); PG8_SCHED; PG8_LDA(At, 1, 0); PG8_STAGEA(PG8_SA(0, 1), a2 + hstepA);
            PG8_WAIT_V(8); PG8_WAIT_L(0); PG8_BAR; PG8_MMA(0, 0, At, B0); PG8_MMA(0, 1, At, B1); PG8_BAR; PG8_SCHED;
            PG8_LDA(At, 1, 1); PG8_STAGEB(PG8_SB(1, 0), b3, sg2); PG8_STAGEB(PG8_SB(1, 1), b3 + hB2, sg2); PG8_STAGEA(PG8_SA(1, 0), a3);
            PG8_WAIT_V(8); PG8_WAIT_L(0); PG8_BAR; PG8_MMA(1, 0, At, B0); PG8_MMA(1, 1, At, B1); PG8_BAR; PG8_SCHED;
        }
        if (wr == 0) PG8_BAR;
        if (cs == 0) E0(acc, cur, wr, wc, fr, fq); else E1(acc, cur, wr, wc, fr, fq);
        if (!has_next) break;
#pragma unroll
        for (int a = 0; a < 2; ++a)
#pragma unroll
            for (int b = 0; b < 2; ++b)
#pragma unroll
                for (int m = 0; m < 4; ++m)
#pragma unroll
                    for (int n = 0; n < 2; ++n) acc[a][b][m][n] = (f32x4){0.f, 0.f, 0.f, 0.f};
        cur = nxt; cs = ns; cA = nA; cB = nB;
        if (wr == 1) PG8_BAR;
    }
    PG8_WAIT_V(0);
    PG8_BAR;
#undef PG8_SA
#undef PG8_SB
#undef PG8_STAGEA
#undef PG8_STAGEB
#undef PG8_LDA
#undef PG8_LDB
#undef PG8_MMA
#undef PG8_WAIT_V
#undef PG8_WAIT_L
#undef PG8_BAR
#undef PG8_SCHED
#undef PG8_APTR
#undef PG8_BPTR
}
}
#define PG8_SP2 true
#define PG8_ALIGN true

__device__ __forceinline__ int fresh_lane_id() { unsigned m1 = ~0u; asm volatile("" : "+s"(m1)); return (int)__builtin_amdgcn_mbcnt_hi(m1, __builtin_amdgcn_mbcnt_lo(m1, 0u)); }
namespace attn {
using bf16x8 = __attribute__((ext_vector_type(8))) short;
using s16x4 = __attribute__((ext_vector_type(4))) short;
using f32x16 = __attribute__((ext_vector_type(16))) float;
using u32x4 = __attribute__((ext_vector_type(4))) unsigned;
constexpr int NW = 8, QBLK = 32, QB = 256, KVBLK = 64;
constexpr int KSLOT = 12288, VSLOT = 8192, NSLOT = 3;
constexpr int LDS_K = 0, LDS_V = NSLOT * KSLOT, LDS_WS = LDS_V + NSLOT * VSLOT, LDS_QF = LDS_WS + NW * 64 * 4, QF_BYTES = 6144, LDS_BYTES = LDS_QF + NW * QF_BYTES;
__device__ __forceinline__ int crow(int r, int hi) { return (r & 3) + 8 * (r >> 2) + 4 * hi; }
#define SBAR() __builtin_amdgcn_sched_barrier(0)
__device__ __forceinline__ void cmask(f32x16& p0, f32x16& p1, int jb, int qrel, int hi) {
    const float NEG = -INFINITY; const int kb = 64 * jb - NMETA + 4 * hi;
#pragma unroll
    for (int r = 0; r < 16; ++r) { const int kv = kb + (r & 3) + 8 * (r >> 2); if (kv > qrel) p0[r] = NEG; if (kv + 32 > qrel) p1[r] = NEG; }
}
__device__ __forceinline__ void glds16(const void* gsrc, unsigned lds_dst) { unsigned keep;
    asm volatile("s_mov_b32 %0, m0\n\ts_mov_b32 m0, %2\n\ts_nop 0\n\tglobal_load_lds_dwordx4 %1, off\n\ts_mov_b32 m0, %0" : "=&s"(keep) : "v"(gsrc), "s"(lds_dst) : "memory"); }
__device__ __forceinline__ float max3f(float a, float b, float c) { float r; asm("v_max3_f32 %0, %1, %2, %3" : "=v"(r) : "v"(a), "v"(b), "v"(c)); return r; }
__device__ __forceinline__ float max2f(float a, float b) { float r; asm("v_max_f32_e32 %0, %1, %2" : "=v"(r) : "v"(a), "v"(b)); return r; }
__device__ __forceinline__ float fadd_s(float a, float b) { float r; asm("v_add_f32_e32 %0, %1, %2" : "=v"(r) : "v"(a), "v"(b)); return r; }
__device__ __forceinline__ float fsub_s(float a, float b) { float r; asm("v_sub_f32_e32 %0, %1, %2" : "=v"(r) : "v"(a), "v"(b)); return r; }
typedef float f32x2_t __attribute__((ext_vector_type(2))); typedef __bf16 bf16x2_t __attribute__((ext_vector_type(2)));
__device__ __forceinline__ unsigned cvtpk_s(float lo, float hi) { f32x2_t v = {lo, hi}; bf16x2_t b = __builtin_convertvector(v, bf16x2_t); return __builtin_bit_cast(unsigned, b); }
template <int N> __device__ __forceinline__ void wait_bar() { asm volatile("s_waitcnt vmcnt(%0) lgkmcnt(0)\n\ts_barrier" :: "n"(N) : "memory"); }
#define WAITB(nk, nv) do { if (w2) wait_bar<2 * (nk) + (nv)>(); else wait_bar<(nk) + (nv)>(); } while (0)
typedef __attribute__((address_space(3))) const char* lds_cptr;
typedef short v4i16_t __attribute__((ext_vector_type(4)));
#define LDSV(p) (*(const __attribute__((address_space(3))) bf16x8*)(p))
__device__ __forceinline__ void kload12(bf16x8* kf, lds_cptr kp) {
#pragma unroll
    for (int j = 0; j < 6; ++j) { kf[2 * j] = LDSV(kp + j * 2048); kf[2 * j + 1] = LDSV(kp + j * 2048 + 512); }
}
__device__ __forceinline__ void kload2(bf16x8* kf, lds_cptr kp, int j) { kf[2 * j] = LDSV(kp + j * 2048); kf[2 * j + 1] = LDSV(kp + j * 2048 + 512); }
__device__ __forceinline__ s16x4 vtr(lds_cptr p) { return __builtin_bit_cast(s16x4, __builtin_amdgcn_ds_read_tr16_b64_v4i16((__attribute__((address_space(3))) v4i16_t*)p)); }
__device__ __forceinline__ float rowmax(const f32x16& p0, const f32x16& p1) {
    float a = max3f(p0[0], p0[1], p1[0]), b = max3f(p0[2], p0[3], p1[1]); a = max3f(a, p1[2], p1[3]);
#pragma unroll
    for (int r = 4; r < 16; r += 4) { a = max3f(a, p0[r], p0[r + 1]); b = max3f(b, p0[r + 2], p0[r + 3]); a = max3f(a, p1[r], p1[r + 1]); b = max3f(b, p1[r + 2], p1[r + 3]); }
    const float m = max2f(a, b);
    auto rr = __builtin_amdgcn_permlane32_swap(__float_as_uint(m), __float_as_uint(m), false, false);
    return max2f(__uint_as_float(rr[0]), __uint_as_float(rr[1]));
}
__device__ __forceinline__ void pv(f32x16* o, int vb, bf16x8 pa0, bf16x8 pa1, bf16x8 pa2, bf16x8 pa3) {
#pragma unroll
    for (int d0 = 0; d0 < 2; ++d0) { s16x4 lo[4], hi[4];
#pragma unroll
        for (int ks = 0; ks < 4; ++ks) {
            asm volatile("ds_read_b64_tr_b16 %0,%1 offset:%c2" : "=&v"(lo[ks]) : "v"(vb), "i"(d0 * 4096 + ks * 1024) : "memory");
            asm volatile("ds_read_b64_tr_b16 %0,%1 offset:%c2" : "=&v"(hi[ks]) : "v"(vb), "i"(d0 * 4096 + ks * 1024 + 512) : "memory"); }
        asm volatile("s_waitcnt lgkmcnt(0)" ::: "memory"); SBAR();
#define PK(k) (bf16x8){lo[k][0], lo[k][1], lo[k][2], lo[k][3], hi[k][0], hi[k][1], hi[k][2], hi[k][3]}
        o[d0] = __builtin_amdgcn_mfma_f32_32x32x16_bf16(pa0, PK(0), o[d0], 0, 0, 0);
        o[d0] = __builtin_amdgcn_mfma_f32_32x32x16_bf16(pa1, PK(1), o[d0], 0, 0, 0);
        o[d0] = __builtin_amdgcn_mfma_f32_32x32x16_bf16(pa2, PK(2), o[d0], 0, 0, 0);
        o[d0] = __builtin_amdgcn_mfma_f32_32x32x16_bf16(pa3, PK(3), o[d0], 0, 0, 0);
#undef PK
    }
}
template <int THRL> __device__ __forceinline__ void attn_unit(int b, int h, int qb, const bf16* Q, const bf16* __restrict__ K, const bf16* __restrict__ V, bf16* Y, char* shm, const int wid) {
    const int lane = fresh_lane_id(), r32 = lane & 31, hi = lane >> 5;
    const long krow0 = (long)b * L; const int q0 = NMETA + qb * QB;
    const bf16* Qw = Q + (krow0 + q0 + wid * QBLK) * QP + h * QKD;
    const bf16* Vh = V + krow0 * VP + h * VD; const unsigned char* Kh = (const unsigned char*)K + (size_t)((b * NH + h) * KT_N) * KT_BYTES;
    const unsigned lds0 = (unsigned)(uintptr_t)shm;
    float* wsf = (float*)(shm + LDS_WS) + wid * 64;
    const bool w2 = wid < 4;
    const unsigned char* ksrc = Kh + wid * 1024 + lane * 16;
    const bf16* vsrc = Vh + (long)(16 * (wid & 3) + (lane >> 2)) * VP + (wid >> 2) * 32 + (lane & 3) * 8;
    const unsigned kdst = lds0 + LDS_K + wid * 1024, vdst = lds0 + LDS_V + wid * 1024;
#define KS(sl) ((sl) + ((sl) >> 1))
#define DMA_K(t, sl) do { glds16(ksrc + (size_t)(t) * KT_BYTES, (unsigned)__builtin_amdgcn_readfirstlane(kdst + KS(sl))); \
        if (w2) glds16(ksrc + 8192 + (size_t)(t) * KT_BYTES, (unsigned)__builtin_amdgcn_readfirstlane(kdst + 8192 + KS(sl))); } while (0)
#define DMA_V(t, sl) glds16(vsrc + (long)(t) * KVBLK * VP, (unsigned)__builtin_amdgcn_readfirstlane(vdst + (sl)))
    const int vb0 = (int)(lds0 + LDS_V) + ((lane >> 4) & 1) * 32 + (lane & 3) * 8 + (4 * hi + ((lane & 15) >> 2)) * 64;
    const char* Kbase = shm + LDS_K; bf16x8 kf[12];
    const lds_cptr shm3 = (lds_cptr)shm; const lds_cptr kp0 = shm3 + LDS_K + hi * 1024 + r32 * 16; const lds_cptr vp0 = shm3 + LDS_V + ((lane >> 4) & 1) * 32 + (lane & 3) * 8 + (4 * hi + ((lane & 15) >> 2)) * 64;
    const lds_cptr qfp = shm3 + LDS_QF + wid * QF_BYTES + lane * 16;
#define QF(d0) LDSV(qfp + (d0) * 1024)
    const int NT = 4 * qb + 5;
    DMA_K(0, 0); DMA_V(0, 0); DMA_K(1, VSLOT);
    {
        bf16x8 qt[6];
#pragma unroll
        for (int d0 = 0; d0 < 6; ++d0) qt[d0] = *(const GAS bf16x8*)(&Qw[(long)r32 * QP + d0 * 16 + hi * 8]);
#pragma unroll
        for (int d0 = 0; d0 < 6; ++d0) *(__attribute__((address_space(3))) bf16x8*)(shm3 + LDS_QF + wid * QF_BYTES + lane * 16 + d0 * 1024) = qt[d0];
    }
    float mhat = 0.f, l_reg = 0.f; f32x16 o[2]; o[0] = f32x16{}; o[1] = f32x16{}; f32x16 negm = f32x16{}; asm volatile("" : "+v"(negm));
    const int qrel = wid * QBLK + r32;
#define CMASK(P0, P1, t) do { int jb_ = (t) - (NT - 5); if (jb_ >= 0) cmask(P0, P1, jb_, qrel, hi); } while (0)
    bool resc = false;
#define START(P0, P1) do { const float rm = rowmax(P0, P1); resc = false; \
    { const float dl = rm; mhat = fadd_s(mhat, dl); \
      _Pragma("unroll") for (int r = 0; r < 16; ++r) { P0[r] = fsub_s(P0[r], dl); P1[r] = fsub_s(P1[r], dl); } \
      _Pragma("unroll") for (int r = 0; r < 16; ++r) negm[r] = -mhat; asm volatile("" : "+v"(negm)); } \
    _Pragma("unroll") for (int r = 0; r < 16; ++r) P0[r] = __builtin_amdgcn_exp2f(P0[r]); } while (0)
#define RESC() do { if (resc) { asm volatile("s_waitcnt lgkmcnt(0)" ::: "memory"); \
      _Pragma("unroll") for (int d_ = 0; d_ < 2; ++d_) _Pragma("unroll") for (int r = 0; r < 16; ++r) o[d_][r] *= wsf[crow(r, hi)]; } } while (0)
    f32x16 pA0, pA1, pB0, pB1;
    int sl_prev = 0, sl_cur = 0, sl_next = VSLOT;
#define ROT() do { sl_prev = sl_cur; sl_cur = sl_next; sl_next = (sl_next == (NSLOT - 1) * VSLOT) ? 0 : sl_next + VSLOT; } while (0)
    DMA_K(2, 2 * VSLOT);
    WAITB(2, 1);
    {
        const char* kb = Kbase + hi * 1024 + r32 * 16;
#pragma unroll
        for (int d0 = 0; d0 < 6; ++d0) { const bf16x8 b0 = *reinterpret_cast<const bf16x8*>(kb + d0 * 2048), b1 = *reinterpret_cast<const bf16x8*>(kb + d0 * 2048 + 512); const bf16x8 qv = QF(d0);
            if (d0 == 0) { pA0 = __builtin_amdgcn_mfma_f32_32x32x16_bf16(b0, qv, negm, 0, 0, 0); pA1 = __builtin_amdgcn_mfma_f32_32x32x16_bf16(b1, qv, negm, 0, 0, 0); }
            else { pA0 = __builtin_amdgcn_mfma_f32_32x32x16_bf16(b0, qv, pA0, 0, 0, 0); pA1 = __builtin_amdgcn_mfma_f32_32x32x16_bf16(b1, qv, pA1, 0, 0, 0); } }
    }
    asm volatile("s_nop 15\n\ts_nop 7" : "+v"(pA0), "+v"(pA1)); CMASK(pA0, pA1, 0);
    START(pA0, pA1);
    _Pragma("unroll") for (int r = 0; r < 16; ++r) pA1[r] = __builtin_amdgcn_exp2f(pA1[r]);
    WAITB(0, 0);
    DMA_K(3, 0); DMA_V(1, VSLOT);
    ROT();
    kload12(kf, kp0 + KS(sl_cur));
    WAITB(1, 1);
    s16x4 vlo[8], vhi[8]; u32x4 pw0, pw1, pw2, pw3; bf16x8 qa, qb_;
#define PKW(P, B) cvtpk_s(P[B], P[B + 1])
#define PAF(k) __builtin_bit_cast(bf16x8, pw##k)
#define VFR(i) (bf16x8){vlo[i][0], vlo[i][1], vlo[i][2], vlo[i][3], vhi[i][0], vhi[i][1], vhi[i][2], vhi[i][3]}
#define PIN(x) asm volatile("" : "+v"(x))
#define MX3(a, b, c) __builtin_fmaxf(__builtin_fmaxf((a), (b)), (c))
#define MF(c, a, b, cc) c = __builtin_amdgcn_mfma_f32_32x32x16_bf16(a, b, cc, 0, 0, 0)
#define GAPA(MFS, A0, A1, A2, A3, W0, W1, PW) do { MFS; sacc += A0; sacc += A1; sacc += A2; sacc += A3; PIN(sacc); W0; W1; PIN(PW); SBAR(); } while (0)
#define GAPM(MFS) do { MFS; SBAR(); } while (0)
#define EX(v) __builtin_amdgcn_exp2f(v)
#define GAPB(MFS, X, B) do { MFS; X[B] = EX(X[B]); X[B + 1] = EX(X[B + 1]); X[B + 2] = EX(X[B + 2]); X[B + 3] = EX(X[B + 3]); PIN(X); SBAR(); } while (0)
#define VRD(i) do { vlo[i] = vtr(vp_ + (((i) >> 2) * 4096 + ((i) & 3) * 1024)); vhi[i] = vtr(vp_ + (((i) >> 2) * 4096 + ((i) & 3) * 1024 + 512)); } while (0)
#define KRD(G, j) do { if (G) { kload2(kf, kp0 + KS(sl_next), j); SBAR(); } } while (0)
#define STEP(C0, C1, P0, P1, t, GK, GV, GL) do { SBAR(); \
    const lds_cptr vp_ = vp0 + sl_prev; \
    qa = QF(0); qb_ = QF(1); \
    VRD(0); SBAR(); float sacc = (P0[0] + P0[1]); \
    GAPA(MF(C0, kf[0], qa, negm), P0[2], P0[3], P0[4], P0[5],     pw0[0] = PKW(P0, 0), pw0[1] = PKW(P0, 2), pw0); \
    VRD(4); SBAR(); GAPA(MF(C1, kf[1], qa, negm), P0[6], P0[7], P0[8], P0[9],     pw0[2] = PKW(P0, 4), pw0[3] = PKW(P0, 6), pw0); \
    qa = QF(2); \
    VRD(1); SBAR(); GAPA(MF(C0, kf[2], qb_, C0),  P0[10], P0[11], P0[12], P0[13], pw1[0] = PKW(P0, 8), pw1[1] = PKW(P0, 10), pw1); \
    VRD(5); SBAR(); GAPA(MF(C1, kf[3], qb_, C1),  P0[14], P0[15], P1[0], P1[1],   pw1[2] = PKW(P0, 12), pw1[3] = PKW(P0, 14), pw1); \
    qb_ = QF(3); \
    VRD(2); SBAR(); GAPA(MF(C0, kf[4], qa, C0),   P1[2], P1[3], P1[4], P1[5],     pw2[0] = PKW(P1, 0), pw2[1] = PKW(P1, 2), pw2); \
    VRD(6); SBAR(); GAPA(MF(C1, kf[5], qa, C1),   P1[6], P1[7], P1[8], P1[9],     pw2[2] = PKW(P1, 4), pw2[3] = PKW(P1, 6), pw2); \
    qa = QF(4); \
    VRD(3); SBAR(); GAPA(MF(C0, kf[6], qb_, C0),  P1[10], P1[11], P1[12], P1[13], pw3[0] = PKW(P1, 8), pw3[1] = PKW(P1, 10), pw3); \
    VRD(7); SBAR(); GAPA(MF(C1, kf[7], qb_, C1),  P1[14], P1[15], 0.f, 0.f,       pw3[2] = PKW(P1, 12), pw3[3] = PKW(P1, 14), pw3); \
    qb_ = QF(5); \
    GAPM(MF(C0, kf[8], qa, C0)); GAPM(MF(C1, kf[9], qa, C1)); GAPM(MF(C0, kf[10], qb_, C0)); GAPM(MF(C1, kf[11], qb_, C1)); \
    l_reg += sacc; \
    if (GK) { DMA_K((t) + 3, sl_cur); } if (GV) { DMA_V((t) + 1, sl_next); } \
    CMASK(C0, C1, t); \
    { float a = MX3(C0[0], C0[1], C1[0]), b = MX3(C0[2], C0[3], C1[1]); a = MX3(a, C1[2], C1[3]); \
      _Pragma("unroll") for (int r = 4; r < 16; r += 4) { a = MX3(a, C0[r], C0[r + 1]); b = MX3(b, C0[r + 2], C0[r + 3]); a = MX3(a, C1[r], C1[r + 1]); b = MX3(b, C1[r + 2], C1[r + 3]); } \
      float rm = __builtin_fmaxf(a, b); { auto rr = __builtin_amdgcn_permlane32_swap(__float_as_uint(rm), __float_as_uint(rm), false, false); rm = __builtin_fmaxf(__uint_as_float(rr[0]), __uint_as_float(rr[1])); } \
      resc = false; \
      if (__builtin_expect(__any(rm > (float)THRL), 0)) { const float dl = __builtin_fmaxf(rm, 0.f); mhat += dl; \
        _Pragma("unroll") for (int r = 0; r < 16; ++r) { C0[r] -= dl; C1[r] -= dl; } \
        _Pragma("unroll") for (int r = 0; r < 16; ++r) negm[r] = -mhat; asm volatile("" : "+v"(negm)); \
        const float f = __builtin_amdgcn_exp2f(-dl); l_reg *= f; if (hi == 0) wsf[r32] = f; resc = true; } } \
    SBAR(); \
    GAPB(MF(o[0], PAF(0), VFR(0), o[0]), C0, 0); \
    KRD(GL, 0); GAPB(MF(o[1], PAF(0), VFR(4), o[1]), C0, 4); \
    KRD(GL, 1); GAPB(MF(o[0], PAF(1), VFR(1), o[0]), C0, 8); \
    KRD(GL, 2); GAPB(MF(o[1], PAF(1), VFR(5), o[1]), C0, 12); \
    KRD(GL, 3); GAPB(MF(o[0], PAF(2), VFR(2), o[0]), C1, 0); \
    KRD(GL, 4); GAPB(MF(o[1], PAF(2), VFR(6), o[1]), C1, 4); \
    KRD(GL, 5); GAPB(MF(o[0], PAF(3), VFR(3), o[0]), C1, 8); \
    GAPB(MF(o[1], PAF(3), VFR(7), o[1]), C1, 12); \
    } while (0)
    int t = 1;
#undef CMASK
#define CMASK(P0, P1, t) do {} while (0)
    for (; t + 6 < NT; t += 2) {
        STEP(pB0, pB1, pA0, pA1, t, true, true, true);     WAITB(1, 1); RESC(); ROT();
        STEP(pA0, pA1, pB0, pB1, t + 1, true, true, true); WAITB(1, 1); RESC(); ROT();
    }
#undef CMASK
#define CMASK(P0, P1, t) do { int jb_ = (t) - (NT - 5); if (jb_ >= 0) cmask(P0, P1, jb_, qrel, hi); } while (0)
#define ENDW(tt) do { if ((tt) + 3 < NT) { WAITB(1, 1); } else if ((tt) + 2 < NT) { WAITB(0, 1); } else { WAITB(0, 0); } } while (0)
    for (; t + 1 < NT; t += 2) {
        STEP(pB0, pB1, pA0, pA1, t, (t + 3 < NT), (t + 1 < NT), (t + 1 < NT));       ENDW(t);     RESC(); ROT();
        STEP(pA0, pA1, pB0, pB1, t + 1, (t + 4 < NT), (t + 2 < NT), (t + 2 < NT));   ENDW(t + 1); RESC(); ROT();
    }
    {
        float sacc = pA0[0] + pA0[1]; _Pragma("unroll") for (int r = 2; r < 16; ++r) sacc += pA0[r]; _Pragma("unroll") for (int r = 0; r < 16; ++r) sacc += pA1[r]; l_reg += sacc;
        pw0 = (u32x4){PKW(pA0, 0), PKW(pA0, 2), PKW(pA0, 4), PKW(pA0, 6)}; pw1 = (u32x4){PKW(pA0, 8), PKW(pA0, 10), PKW(pA0, 12), PKW(pA0, 14)};
        pw2 = (u32x4){PKW(pA1, 0), PKW(pA1, 2), PKW(pA1, 4), PKW(pA1, 6)}; pw3 = (u32x4){PKW(pA1, 8), PKW(pA1, 10), PKW(pA1, 12), PKW(pA1, 14)};
        SBAR(); pv(o, vb0 + sl_prev, PAF(0), PAF(1), PAF(2), PAF(3));
    }
#undef PKW
#undef PAF
#undef VFR
#undef PIN
#undef MX3
#undef MF
#undef GAPA
#undef GAPM
#undef GAPB
#undef EX
#undef VRD
#undef KRD
#undef STEP
#undef ENDW
    { auto rr = __builtin_amdgcn_permlane32_swap(__float_as_uint(l_reg), __float_as_uint(l_reg), false, false); l_reg = __uint_as_float(rr[0]) + __uint_as_float(rr[1]); }
    if (hi == 0) wsf[32 + r32] = l_reg; asm volatile("s_waitcnt lgkmcnt(0)" ::: "memory");
    float rli[16];
#pragma unroll
    for (int r = 0; r < 16; ++r) rli[r] = __builtin_amdgcn_rcpf(wsf[32 + crow(r, hi)]);
    bf16* Ow = Y + (krow0 + q0 + wid * QBLK) * YP + POOLW + h * VD; const __amdgpu_buffer_rsrc_t rsy = ws_rsrc((unsigned char*)Y);
    { bf16* stg = (bf16*)(shm + LDS_QF + wid * QF_BYTES);
#pragma unroll
      for (int r = 0; r < 16; ++r) { const int orow = crow(r, hi);
#pragma unroll
          for (int d0 = 0; d0 < 2; ++d0) stg[orow * 64 + d0 * 32 + r32] = f2bf(o[d0][r] * rli[r]); }
      asm volatile("s_waitcnt lgkmcnt(0)" ::: "memory");
#pragma unroll
      for (int i = 0; i < 4; ++i) { const int row = i * 8 + (lane >> 3), ch = lane & 7; const u32x4 v = *(const u32x4*)(stg + row * 64 + ch * 8);
          st16_wt(rsy, (size_t)((Ow - Y) + (long)row * YP + ch * 8) * 2, __builtin_bit_cast(wt_u32x4, v)); } }
    asm volatile("s_waitcnt lgkmcnt(0)\n\ts_barrier" ::: "memory");
#undef DMA_K
#undef DMA_V
#undef KS
#undef QF
#undef CMASK
#undef START
#undef RESC
#undef ROT
}
#undef SBAR
#undef WAITB
#undef LDSV
}

constexpr int NWAVES = 8;
constexpr int NPHASE = 1 + 6 * DEPTH;
constexpr int CW_TMO = 0, CW_CODE = 1, CW_ZM = 64, CW_M4 = 256, CW_M5 = 320, CW_BAR = 4096, CW_ZF = 65536, CW_GRP = 131072, CW_YP = 139264, CW_P3D = 147456;
constexpr int _cw_dummy = 0;
constexpr int RING_OFF = 0, RING_BYTES = 131072, LDSCTL_OFF = RING_BYTES, MISC_OFF = LDSCTL_OFF + 320, RST_OFF = MISC_OFF + 1024  , LDS_BYTES = 147456;
typedef unsigned v4u __attribute__((ext_vector_type(4)));
typedef float f32x4 __attribute__((ext_vector_type(4)));
typedef GAS unsigned gu32;
#define RLX_AGENT __ATOMIC_RELAXED, __HIP_MEMORY_SCOPE_AGENT
#define LDS_WAIT() asm volatile("s_waitcnt lgkmcnt(0)" ::: "memory")
#define VM_WAIT() asm volatile("s_waitcnt vmcnt(0)" ::: "memory")

#define XB_TMO      128
#define XB_XCNT(j)  (256  + 64 * (j))
#define XB_XSUB(j)  (1280 + 64 * (j))
#define XB_XGEN(j)  (2304 + 64 * (j))
#define XB_TOP      3328
#define XB_TOPGEN   3392
#define XCD_BAR_WORDS 3456
#define XB_SPIN_CAP (1u << 18)
__device__ __forceinline__ unsigned xb_ld(unsigned* p)              { return __hip_atomic_load((GAS unsigned*)p, __ATOMIC_RELAXED, __HIP_MEMORY_SCOPE_AGENT); }
__device__ __forceinline__ unsigned xb_add(unsigned* p, unsigned v) { return __hip_atomic_fetch_add((GAS unsigned*)p, v, __ATOMIC_RELAXED, __HIP_MEMORY_SCOPE_AGENT); }
__device__ __forceinline__ unsigned xb_xcc_id() { return (unsigned)__builtin_amdgcn_s_getreg((3 << 11) | 20) & 0xFu; }
#define XB_SPIN(cond, bar) do { unsigned _sp = 0; while (cond) { __builtin_amdgcn_s_sleep(1); \
    if ((++_sp & 255u) == 0u) { if (xb_ld(&(bar)[XB_TMO])) break; if (_sp > XB_SPIN_CAP) { xb_add(&(bar)[XB_TMO], 1u); break; } } } } while (0)
struct XcdBarrier { unsigned* bar; unsigned x; volatile LAS unsigned* st; };
__device__ __forceinline__ XcdBarrier xcd_barrier_post(unsigned* bar, volatile LAS unsigned* st) {
    XcdBarrier b; b.bar = bar; b.x = xb_xcc_id(); b.st = st;
    if (threadIdx.x == 0) (void)xb_add(&bar[XB_XCNT(b.x)], 1u);
    return b;
}
__device__ __forceinline__ void xcd_barrier_complete(unsigned* bar, unsigned x, unsigned& nloc, unsigned& nx) {
    const unsigned G = gridDim.x * gridDim.y * gridDim.z;
    unsigned sum, cnt, mine, sp = 0u;
    for (;;) {
        sum = 0u; cnt = 0u; mine = 0u;
#pragma unroll
        for (unsigned j = 0; j < 16; ++j) { const unsigned c = xb_ld(&bar[XB_XCNT(j)]); sum += c; cnt += (c > 0u) ? 1u : 0u; mine = (j == x) ? c : mine; }
        if (sum == G) break;
        __builtin_amdgcn_s_sleep(1);
        if ((++sp & 255u) == 0u) { if (xb_ld(&bar[XB_TMO])) break; if (sp > XB_SPIN_CAP) { xb_add(&bar[XB_TMO], 1u); break; } }
    }
    nloc = mine > 0u ? mine : 1u; nx = cnt > 0u ? cnt : 1u;
}
__device__ __forceinline__ void xcd_barrier(const XcdBarrier& b) {
    asm volatile("s_waitcnt vmcnt(0)" ::: "memory");
    __syncthreads();
    if (threadIdx.x == 0) {
        unsigned* bar = b.bar; unsigned bx = b.x; asm volatile("" : "+s"(bar), "+s"(bx));
        __builtin_amdgcn_s_waitcnt(0);
        unsigned nloc = b.st[0], nx = b.st[1];
        if (nloc == 0u) { xcd_barrier_complete(bar, bx, nloc, nx); b.st[0] = nloc; b.st[1] = nx; }
        const unsigned old = xb_add(&bar[XB_XSUB(bx)], 1u);
        const unsigned gen = old / nloc;
        if (old + 1u == (gen + 1u) * nloc) {
            __builtin_amdgcn_fence(__ATOMIC_RELEASE, "agent");
            asm volatile("s_waitcnt vmcnt(0)" ::: "memory");
            const unsigned og = xb_add(&bar[XB_TOP], 1u);
            const unsigned tgt = (og / nx + 1u) * nx;
            if (og + 1u != tgt) XB_SPIN(xb_ld(&bar[XB_TOP]) < tgt, bar);
            __builtin_amdgcn_fence(__ATOMIC_ACQUIRE, "agent");
            asm volatile("s_waitcnt vmcnt(0)" ::: "memory");
        } else {
            const unsigned tgt = (gen + 1u) * nx;
            XB_SPIN(xb_ld(&bar[XB_TOP]) < tgt, bar);
            __builtin_amdgcn_fence(__ATOMIC_ACQUIRE, "agent");
            asm volatile("s_waitcnt vmcnt(0)" ::: "memory");
        }
    }
    __syncthreads();
}

__device__ __forceinline__ void group_seam(unsigned* grp, unsigned target, unsigned* bar, unsigned* also = nullptr, unsigned also_target = 0u) {
    asm volatile("s_waitcnt vmcnt(0)" ::: "memory");
    __syncthreads();
    if (threadIdx.x == 0) {
        unsigned* w = grp; unsigned tg = target; asm volatile("" : "+s"(w), "+s"(tg));
        (void)xb_add(w, 1u);
        XB_SPIN(xb_ld(w) < tg, bar);
        if (also) { unsigned* w2 = also; unsigned t2 = also_target; asm volatile("" : "+s"(w2), "+s"(t2)); XB_SPIN(xb_ld(w2) < t2, bar); }
        __builtin_amdgcn_fence(__ATOMIC_ACQUIRE, "agent");
        asm volatile("s_waitcnt vmcnt(0)" ::: "memory");
    }
    __syncthreads();
}

__device__ __forceinline__ void wait_count(unsigned* cw, unsigned target, unsigned* bar) {
    if (threadIdx.x == 0) {
        unsigned* w = cw; unsigned tg = target; asm volatile("" : "+s"(w), "+s"(tg));
        XB_SPIN(xb_ld(w) < tg, bar);
        __builtin_amdgcn_fence(__ATOMIC_ACQUIRE, "agent");
        asm volatile("s_waitcnt vmcnt(0)" ::: "memory");
    }
    __syncthreads();
}

struct Frame {
    LAS unsigned char* lds; volatile LAS unsigned* MISC; gu32* ctl;
    int wave, vcu, G;
    const P& p;
    __device__ __forceinline__ int lane() const { return fresh_lane_id(); }
    __device__ __forceinline__ int tid() const { return wave * 64 + fresh_lane_id(); }
};
__device__ __forceinline__ float wave_sum(float v) {
#pragma unroll
    for (int o = 1; o < 64; o <<= 1) v += __shfl_xor(v, o);
    return v;
}
__device__ __forceinline__ void transpose_item(const float* W, int ldw, int k0, int n0, bf16* dst, int ldt, LAS float* scr, int lane, const float* kgain = nullptr) {
    {
        const int kk0 = lane >> 3, c4 = (lane & 7) * 4; f32x4 v[8]; float gk[8];
#pragma unroll
        for (int i = 0; i < 8; ++i) { v[i] = __builtin_nontemporal_load((const GAS f32x4*)(W + (size_t)(k0 + kk0 + 8 * i) * ldw + n0 + c4)); gk[i] = kgain ? kgain[k0 + kk0 + 8 * i] : 1.0f; }
#pragma unroll
        for (int i = 0; i < 8; ++i) { LAS float* d = scr + (kk0 + 8 * i) * 33 + c4; d[0] = v[i][0] * gk[i]; d[1] = v[i][1] * gk[i]; d[2] = v[i][2] * gk[i]; d[3] = v[i][3] * gk[i]; } }
    LDS_WAIT(); asm volatile("" ::: "memory");
    const int c = lane & 7;
#pragma unroll
    for (int j = 0; j < 4; ++j) { const int n = (lane >> 3) + 8 * j; const LAS float* s = scr + (8 * c) * 33 + n;
        v4u o; o.x = pk2(s[0 * 33], s[1 * 33]); o.y = pk2(s[2 * 33], s[3 * 33]); o.z = pk2(s[4 * 33], s[5 * 33]); o.w = pk2(s[6 * 33], s[7 * 33]);
        *(GAS v4u*)(dst + (size_t)n * ldt + 8 * c) = o; }
    LDS_WAIT(); asm volatile("" ::: "memory");
}
__device__ __forceinline__ int rowmap_q(int n0)  { const int head = n0 / 96, e0 = n0 % 96; return e0 < 64 ? 256 * (head >> 2) + 128 * (e0 >> 5) + 32 * (head & 3) : 512 + 128 * (head >> 2) + 32 * (head & 3); }
__device__ __forceinline__ int rowmap_kv(int n0) { const int head = n0 >> 7, e0 = n0 & 127; return e0 < 64 ? 256 * (head >> 2) + 128 * (e0 >> 5) + 32 * (head & 3) : 512 + 256 * (head >> 2) + 128 * ((e0 - 64) >> 5) + 32 * (head & 3); }
constexpr int IT_IN = 16 * 37, IT_Q = 6 * 24, IT_KV = 4 * 32, IT_P = 4 * 8, IT_OUT = 16 * 32, IT_G = 16 * 88, IT_D = 44 * 32;
constexpr int IT_LAYER = IT_IN + IT_Q + IT_KV + IT_P + IT_OUT + 2 * IT_G + IT_D;
__device__ __forceinline__ void conv_range(const P& p, LAS float* scr, int lo, int hi, int widx, int wcnt, int lane) {
    for (int it = lo + widx; it < hi; it += wcnt) {
        const int l = it / IT_LAYER; int r = it % IT_LAYER; unsigned char* wl = p.ws + WS_W + (size_t)l * WL_BYTES;
        if (r < IT_IN) { const int kb = r / 37, nb = r % 37; transpose_item(p.w_in + (size_t)l * D * INW, INW, 64 * kb, 32 * nb, (bf16*)(wl + WO_IN) + (size_t)(32 * nb) * D + 64 * kb, D, scr, lane, p.attn_g + (size_t)l * D); continue; } r -= IT_IN;
        if (r < IT_Q) { const int kb = r / 24, nb = r % 24; transpose_item(p.w_q_b + (size_t)l * QLR * 768, 768, 64 * kb, 32 * nb, (bf16*)(wl + WO_Q) + (size_t)rowmap_q(32 * nb) * QLR + 64 * kb, QLR, scr, lane); continue; } r -= IT_Q;
        if (r < IT_KV) { const int kb = r / 32, nb = r % 32; transpose_item(p.w_kv_b + (size_t)l * KVLR * 1024, 1024, 64 * kb, 32 * nb, (bf16*)(wl + WO_KV) + (size_t)rowmap_kv(32 * nb) * KVLR + 64 * kb, KVLR, scr, lane); continue; } r -= IT_KV;
        if (r < IT_P) { const int g = r >> 3, kb = (r >> 2) & 1, nb = r & 3; transpose_item(p.w_pool + ((size_t)l * 4 + g) * 128 * 128, 128, 64 * kb, 32 * nb, (bf16*)(wl + WO_P) + (size_t)(g * 128 + 32 * nb) * 128 + 64 * kb, 128, scr, lane); continue; } r -= IT_P;
        if (r < IT_OUT) { const int kb = r / 32, nb = r % 32; transpose_item(p.w_out + (size_t)l * D * D, D, 64 * kb, 32 * nb, (bf16*)(wl + WO_OUT) + (size_t)(32 * nb) * D + 64 * kb, D, scr, lane); continue; } r -= IT_OUT;
        if (r < 2 * IT_G) { const int up = r >= IT_G; if (up) r -= IT_G; const int kb = r / 88, nb = r % 88, f0 = 32 * nb;
            transpose_item((up ? p.w_up : p.w_gate) + (size_t)l * D * FF, FF, 64 * kb, f0, (bf16*)(wl + WO_GU) + (size_t)(256 * (f0 >> 7) + 128 * up + (f0 & 127)) * D + 64 * kb, D, scr, lane, p.ffn_g + (size_t)l * D); continue; } r -= 2 * IT_G;
        { const int kb = r / 32, nb = r % 32; transpose_item(p.w_down + (size_t)l * FF * D, D, 64 * kb, 32 * nb, (bf16*)(wl + WO_D) + (size_t)(32 * nb) * FF + 64 * kb, FF, scr, lane); }
    }
}
constexpr int CV0 = IT_IN + IT_Q + IT_KV + IT_P  , CV1 = CV0 + IT_OUT + IT_G  ,
              CV1B = IT_LAYER  , CV2 = IT_LAYER + CV0 + IT_OUT  , CV3 = CV2 + 2 * IT_G  ,
              CV4 = 2 * IT_LAYER  ;
__device__ __forceinline__ void p0_prologue(Frame& F) {
    const P& p = F.p;
    LAS float* scr = (LAS float*)(F.lds + RING_OFF + F.wave * 16384);
    const int gw = F.vcu * NWAVES + F.wave, NGW = F.G * NWAVES, lane = F.lane();
    conv_range(p, scr, 0, CV0, gw, NGW, lane);
    { const int gt = gw * 64 + lane, NGT = NGW * 64; const v4u z4 = {0u, 0u, 0u, 0u};
      for (int i = gt; i < DEPTH * 96 * D / 8; i += NGT) { const int l = i / (96 * D / 8), o = i % (96 * D / 8); *((GAS v4u*)(p.ws + WS_W + (size_t)l * WL_BYTES + WO_IN + (size_t)INW * D * 2) + o) = z4; }
      for (int i = gt; i < 256 * VP / 8; i += NGT) *((GAS v4u*)(p.ws + WS_V + (size_t)R * VP * 2) + i) = z4;
      for (int i = gt; i < L * 16; i += NGT) { const int pos = i >> 4, j = i & 15; const float inv = 1.0f / powf(10000.0f, (float)(2 * j) / 32.0f); const float ang = (float)pos * inv;
          float* t = (float*)(p.ws + WS_ROPE) + (size_t)pos * 32; t[j] = cosf(ang); t[16 + j] = sinf(ang); } }
    for (int i = gw * 64 + lane; i < NMETA * D; i += NGW * 64) ((GAS float*)(p.ws + WS_MINI + MN_HM))[i] = p.meta[i];
    for (int m0 = gw; m0 < MR; m0 += 4 * NGW) {
        f32x4 v[4][4]; float sq[4];
#pragma unroll
        for (int u = 0; u < 4; ++u) { const int m = m0 + u * NGW < MR ? m0 + u * NGW : m0; const GAS f32x4* xr = (const GAS f32x4*)(p.x + (size_t)m * D) + lane;
#pragma unroll
            for (int j = 0; j < 4; ++j) v[u][j] = __builtin_nontemporal_load(xr + 64 * j); }
#pragma unroll
        for (int u = 0; u < 4; ++u) { float s_ = 0.f;
#pragma unroll
            for (int j = 0; j < 4; ++j) s_ += (v[u][j].x * v[u][j].x + v[u][j].y * v[u][j].y) + (v[u][j].z * v[u][j].z + v[u][j].w * v[u][j].w);
            sq[u] = wave_sum(s_); }
#pragma unroll
        for (int u = 0; u < 4; ++u) { const int m = m0 + u * NGW; if (m < MR) { const int krow = rowbase(m >> 8) + (m & 255);
            GAS unsigned long long* o8 = (GAS unsigned long long*)(p.ws + WS_XN + (size_t)krow * D * 2) + lane;
#pragma unroll
            for (int j = 0; j < 4; ++j) o8[64 * j] = (unsigned long long)pk2(v[u][j].x, v[u][j].y) | ((unsigned long long)pk2(v[u][j].z, v[u][j].w) << 32);
            if (lane == 0) *(GAS f32x4*)(p.ws + WS_SSQH + (size_t)krow * 16) = (f32x4){sq[u], 0.f, 0.f, 0.f}; } }
    }
}

__device__ __forceinline__ void krope_item(unsigned char* ws, const float* kn, int item) {
    const int m = item >> 2, c = item & 3;
    const int krow = rowbase(m >> 8) + (m & 255), pos = NMETA + (((m >> 8) & 15) << 8) + (m & 255);
    const v4u zw = *(const GAS v4u*)(ws + WS_Z + ((size_t)krow * ZP + POOLW + QLR + KVLR + 8 * c) * 2);
    const GAS float* t = (const GAS float*)(ws + WS_ROPE) + (size_t)pos * 32 + 8 * (c & 1);
    const f32x4 c0 = *(const GAS f32x4*)t, c1 = *(const GAS f32x4*)(t + 4), s0 = *(const GAS f32x4*)(t + 16), s1 = *(const GAS f32x4*)(t + 20);
    const f32x4 g0 = *(const f32x4*)(kn + 8 * c), g1 = *(const f32x4*)(kn + 8 * c + 4);
    const float r2 = rsqrtf(((const GAS float*)(ws + WS_SSQZ))[(size_t)krow * SZ + 36] * (1.0f / ROPE) + EPS);
    f32x4 y0 = {__uint_as_float(zw.x << 16), __uint_as_float(zw.x & 0xffff0000u), __uint_as_float(zw.y << 16), __uint_as_float(zw.y & 0xffff0000u)};
    f32x4 y1 = {__uint_as_float(zw.z << 16), __uint_as_float(zw.z & 0xffff0000u), __uint_as_float(zw.w << 16), __uint_as_float(zw.w & 0xffff0000u)};
    y0 = y0 * r2 * g0; y1 = y1 * r2 * g1;
    f32x4 p0, p1;
#pragma unroll
    for (int e = 0; e < 4; ++e) { p0[e] = __shfl_xor(y0[e], 2); p1[e] = __shfl_xor(y1[e], 2); }
    const bool lo = c < 2;
    const f32x4 o0 = lo ? y0 * c0 - p0 * s0 : p0 * s0 + y0 * c0, o1 = lo ? y1 * c1 - p1 * s1 : p1 * s1 + y1 * c1;
    v4u ow; ow.x = pk2(o0[0], o0[1]); ow.y = pk2(o0[2], o0[3]); ow.z = pk2(o1[0], o1[1]); ow.w = pk2(o1[2], o1[3]);
    const int kb_ = m >> 12;
#pragma unroll
    for (int h = 0; h < NH; ++h) *(GAS v4u*)(ws + WS_K + kcell(kb_, h, pos, 8 + c)) = ow;
}
__device__ __forceinline__ void wait_ztiles(unsigned* f0, unsigned* f1, unsigned want0, unsigned want1) {
    if (threadIdx.x == 0) { unsigned sp = 0;
        while (__hip_atomic_load((GAS unsigned*)f0, __ATOMIC_RELAXED, __HIP_MEMORY_SCOPE_AGENT) < want0 || (f1 && __hip_atomic_load((GAS unsigned*)f1, __ATOMIC_RELAXED, __HIP_MEMORY_SCOPE_AGENT) < want1)) { __builtin_amdgcn_s_sleep(2); if (++sp > (1u << 22)) break; }
        __builtin_amdgcn_fence(__ATOMIC_ACQUIRE, "agent"); asm volatile("s_waitcnt vmcnt(0)" ::: "memory"); }
    __syncthreads();
}
typedef short bf16x8_t __attribute__((ext_vector_type(8)));
typedef float f32x16 __attribute__((ext_vector_type(16)));
constexpr int PU_PITCH = 272, PU_B = 272 * PU_PITCH;
__device__ __forceinline__ void pool_unit(LAS unsigned char* lds, unsigned char* ws, unsigned char* wl, const float* pscale, const int wid, int pm, int g) {
    const int lane = fresh_lane_id(), tid = wid * 64 + lane, r32 = lane & 31, hi = lane >> 5;
    const int krow0 = rowbase(pm), w = 2 << g;
    const GAS unsigned char* zb = (const GAS unsigned char*)(ws + WS_Z) + ((size_t)(krow0 - 16) * ZP + 128 * g) * 2;
    const GAS unsigned char* wb = (const GAS unsigned char*)(wl + WO_P) + (size_t)g * 128 * 128 * 2;
    {
        const int ch = tid & 15, r0 = tid >> 4; v4u ut[9], bt[4];
#pragma unroll
        for (int i = 0; i < 9; ++i) { const int row = r0 + 32 * i; ut[i] = row < 272 ? *(const GAS v4u*)(zb + (size_t)row * ZP * 2 + ch * 16) : (v4u){0u, 0u, 0u, 0u}; }
#pragma unroll
        for (int i = 0; i < 4; ++i) bt[i] = *(const GAS v4u*)(wb + (size_t)(r0 + 32 * i) * 256 + ch * 16);
#pragma unroll
        for (int i = 0; i < 9; ++i) { const int row = r0 + 32 * i; if (row < 272) *(LAS v4u*)(lds + row * PU_PITCH + ch * 16) = ut[i]; }
#pragma unroll
        for (int i = 0; i < 4; ++i) *(LAS v4u*)(lds + PU_B + (r0 + 32 * i) * PU_PITCH + ch * 16) = bt[i];
    }
    __syncthreads();
    {
        const float invw = 1.0f / (float)w; float s0 = 0.f, s1 = 0.f;
        const LAS unsigned* ub = (const LAS unsigned*)(lds + (16 + 32 * wid) * PU_PITCH) + lane;
#pragma unroll 1
        for (int i = 1; i < w; ++i) { const unsigned uu = ub[-(i * (PU_PITCH / 4))]; s0 += __uint_as_float(uu << 16); s1 += __uint_as_float(uu & 0xffff0000u); }
        unsigned pk[32];
#pragma unroll
        for (int j = 0; j < 32; ++j) { const unsigned uu = ub[j * (PU_PITCH / 4)]; const float a0 = __uint_as_float(uu << 16), a1 = __uint_as_float(uu & 0xffff0000u);
            s0 += a0; s1 += a1; pk[j] = pk2(s0 * invw - a0, s1 * invw - a1);
            const unsigned uo = ub[(j - (w - 1)) * (PU_PITCH / 4)]; s0 -= __uint_as_float(uo << 16); s1 -= __uint_as_float(uo & 0xffff0000u); }
        __syncthreads();
        LAS unsigned* uw = (LAS unsigned*)(lds + (16 + 32 * wid) * PU_PITCH) + lane;
#pragma unroll
        for (int j = 0; j < 32; ++j) uw[j * (PU_PITCH / 4)] = pk[j];
    }
    __syncthreads();
    f32x16 acc[4];
#pragma unroll
    for (int nb = 0; nb < 4; ++nb)
#pragma unroll
        for (int r = 0; r < 16; ++r) acc[nb][r] = 0.f;
    const LAS unsigned char* pa = lds + (16 + 32 * wid + r32) * PU_PITCH + hi * 16; const LAS unsigned char* wa = lds + PU_B + r32 * PU_PITCH + hi * 16;
#pragma unroll
    for (int s = 0; s < 8; ++s) { const bf16x8_t bfr = *(const LAS bf16x8_t*)(pa + s * 32);
#pragma unroll
        for (int nb = 0; nb < 4; ++nb) { const bf16x8_t afr = *(const LAS bf16x8_t*)(wa + nb * 32 * PU_PITCH + s * 32); acc[nb] = __builtin_amdgcn_mfma_f32_32x32x16_bf16(afr, bfr, acc[nb], 0, 0, 0); } }
    const float* ps = pscale + 128 * g + 4 * hi;
    GAS unsigned char* yb = (GAS unsigned char*)(ws + WS_Y) + ((size_t)(krow0 + 32 * wid + r32) * YP + 128 * g + 4 * hi) * 2;
#pragma unroll
    for (int nb = 0; nb < 4; ++nb)
#pragma unroll
        for (int k4 = 0; k4 < 4; ++k4) { const f32x4 sc = *(const f32x4*)(ps + 32 * nb + 8 * k4);
            pg8::u32x2 o; o.x = pk2(acc[nb][4 * k4] * sc[0], acc[nb][4 * k4 + 1] * sc[1]); o.y = pk2(acc[nb][4 * k4 + 2] * sc[2], acc[nb][4 * k4 + 3] * sc[3]);
            *(GAS pg8::u32x2*)(yb + (32 * nb + 8 * k4) * 2) = o; }
    __syncthreads();
}

namespace mini {
typedef short bf16x8 __attribute__((ext_vector_type(8)));
typedef float f32x4 __attribute__((ext_vector_type(4)));
__device__ __forceinline__ float hs4(f32x4 v) { return (v[0] * v[0] + v[1] * v[1]) + (v[2] * v[2] + v[3] * v[3]); }
__device__ __forceinline__ bf16x8 pack8(f32x4 a0, f32x4 a1) { v4u w; w.x = pk2(a0[0], a0[1]); w.y = pk2(a0[2], a0[3]); w.z = pk2(a1[0], a1[1]); w.w = pk2(a1[2], a1[3]); return __builtin_bit_cast(bf16x8, w); }
template <int NB, int U = 4> __device__ __forceinline__ void acc_steps(const GAS float* A, int lda, const float* gain, const GAS bf16* const (&Bt)[NB], int ldb, int K, int s0, int sstep, int lane, f32x4 (&acc)[NB], float& ssq) {
    const int r = lane & 15, q = lane >> 4;
    const int ns = K / 32;
    for (int sb = s0; sb < ns; sb += U * sstep) {
        f32x4 a0[U], a1[U], g0[U], g1[U]; bf16x8 bfr[U][NB];
#pragma unroll
        for (int u = 0; u < U; ++u) { const int s_ = sb + u * sstep, k = 32 * (s_ < ns ? s_ : s0) + 8 * q;
            a0[u] = *(const GAS f32x4*)(A + (size_t)r * lda + k); a1[u] = *(const GAS f32x4*)(A + (size_t)r * lda + k + 4);
            if (gain) { g0[u] = *(const f32x4*)(gain + k); g1[u] = *(const f32x4*)(gain + k + 4); }
#pragma unroll
            for (int nb = 0; nb < NB; ++nb) bfr[u][nb] = *(const GAS bf16x8*)(Bt[nb] + (size_t)r * ldb + k); }
#pragma unroll
        for (int u = 0; u < U; ++u) { if (sb + u * sstep < ns) {
            ssq += hs4(a0[u]) + hs4(a1[u]);
            if (gain) { a0[u] = a0[u] * g0[u]; a1[u] = a1[u] * g1[u]; }
            const bf16x8 af = pack8(a0[u], a1[u]);
#pragma unroll
            for (int nb = 0; nb < NB; ++nb) acc[nb] = __builtin_amdgcn_mfma_f32_16x16x32_bf16(af, bfr[u][nb], acc[nb], 0, 0, 0); } }
    }
}
template <int NB, bool NORM, int U = 4> __device__ __forceinline__ void chunk_wg(LAS unsigned char* lds, const GAS float* A, int lda, const float* gain, const GAS bf16* const (&Bt)[NB], int ldb, int K, int wid, int lane, f32x4 (&out)[NB]) {
    f32x4 acc[NB]; float ssq = 0.f;
#pragma unroll
    for (int nb = 0; nb < NB; ++nb) acc[nb] = (f32x4){0.f, 0.f, 0.f, 0.f};
    acc_steps<NB, U>(A, lda, gain, Bt, ldb, K, wid, 8, lane, acc, ssq);
    LAS f32x4* red = (LAS f32x4*)lds; LAS float* sq = (LAS float*)(lds + 8 * NB * 64 * 16);
#pragma unroll
    for (int nb = 0; nb < NB; ++nb) red[(wid * NB + nb) * 64 + lane] = acc[nb];
    sq[wid * 64 + lane] = ssq;
    __syncthreads();
    if (wid == 0) {
#pragma unroll
        for (int nb = 0; nb < NB; ++nb) { f32x4 t = red[nb * 64 + lane];
#pragma unroll
            for (int w = 1; w < 8; ++w) t = t + red[(w * NB + nb) * 64 + lane];
            out[nb] = t; }
        if (NORM) { float tot = 0.f;
#pragma unroll
            for (int w = 0; w < 8; ++w)
#pragma unroll
                for (int qq = 0; qq < 4; ++qq) tot += sq[w * 64 + (lane & 15) + 16 * qq];
            const float rs = rsqrtf(tot / (float)K + EPS);
#pragma unroll
            for (int reg = 0; reg < 4; ++reg) { const float rr = __shfl(rs, 4 * (lane >> 4) + reg);
#pragma unroll
                for (int nb = 0; nb < NB; ++nb) out[nb][reg] *= rr; } }
    }
    __syncthreads();
}
__device__ __forceinline__ void publish(unsigned* cnt, int lane) {
    asm volatile("s_waitcnt vmcnt(0)" ::: "memory"); __builtin_amdgcn_fence(__ATOMIC_RELEASE, "agent"); asm volatile("s_waitcnt vmcnt(0)" ::: "memory");
    if (lane == 0) __hip_atomic_fetch_add((GAS unsigned*)cnt, 1u, __ATOMIC_RELAXED, __HIP_MEMORY_SCOPE_AGENT);
}
__device__ __forceinline__ void publish_wt(unsigned* cnt, int lane) {
    asm volatile("s_waitcnt vmcnt(0)" ::: "memory");
    if (lane == 0) __hip_atomic_fetch_add((GAS unsigned*)cnt, 1u, __ATOMIC_RELAXED, __HIP_MEMORY_SCOPE_AGENT);
}
__device__ __forceinline__ void p1_chunk(LAS unsigned char* lds, unsigned char* ws, unsigned char* wl, unsigned* zm_cnt, int chunk, int wid, int lane) {
    const GAS float* HM = (const GAS float*)(ws + WS_MINI + MN_HM); GAS float* ZM = (GAS float*)(ws + WS_MINI + MN_ZM);
    const GAS bf16* const Bt[1] = {(const GAS bf16*)(wl + WO_IN) + (size_t)(16 * chunk) * D}; f32x4 o[1];
    chunk_wg<1, true>(lds, HM, D, nullptr, Bt, D, D, wid, lane, o);
    if (wid == 0) { const int col = 16 * chunk + (lane & 15);
#pragma unroll
        for (int reg = 0; reg < 4; ++reg) { const int r = 4 * (lane >> 4) + reg; ZM[(size_t)r * INW + col] = o[0][reg];
            if (col < POOLW) { const bf16 zb = f2bf(o[0][reg]);
#pragma unroll
                for (int b = 0; b < BATCH; ++b) ((GAS bf16*)(ws + WS_Z))[(size_t)(b * L + r) * ZP + col] = zb; } }
        asm volatile("s_waitcnt vmcnt(0)" ::: "memory"); __builtin_amdgcn_fence(__ATOMIC_RELEASE, "agent"); asm volatile("s_waitcnt vmcnt(0)" ::: "memory");
        if (lane == 0) __hip_atomic_fetch_add((GAS unsigned*)zm_cnt, 1u, __ATOMIC_RELAXED, __HIP_MEMORY_SCOPE_AGENT); }
}
__device__ __forceinline__ void wait_zm(unsigned* zm_cnt, unsigned want) {
    if (threadIdx.x == 0) { unsigned sp = 0;
        while (__hip_atomic_load((GAS unsigned*)zm_cnt, __ATOMIC_RELAXED, __HIP_MEMORY_SCOPE_AGENT) < want) { __builtin_amdgcn_s_sleep(2); if (++sp > (1u << 22)) break; }
        __builtin_amdgcn_fence(__ATOMIC_ACQUIRE, "agent"); asm volatile("s_waitcnt vmcnt(0)" ::: "memory"); }
    __syncthreads();
}
template <int U> __device__ __forceinline__ void res_chunk(LAS unsigned char* lds, unsigned char* ws, const GAS float* A, int K, const GAS bf16* Btw, int chunk, int wid, int lane, unsigned* pub = nullptr) {
    GAS float* HM = (GAS float*)(ws + WS_MINI + MN_HM);
    const GAS bf16* const Bt[1] = {Btw + (size_t)(16 * chunk) * K}; f32x4 o[1];
    chunk_wg<1, false, U>(lds, A, K, nullptr, Bt, K, K, wid, lane, o);
    if (wid == 0) { const int col = 16 * chunk + (lane & 15);
#pragma unroll
        for (int reg = 0; reg < 4; ++reg) { const int r = 4 * (lane >> 4) + reg; const float hv = HM[(size_t)r * D + col] + o[0][reg];
            if (pub) st4_wt(ws_rsrc(ws), WS_MINI + MN_HM + ((size_t)r * D + col) * 4, __float_as_uint(hv)); else HM[(size_t)r * D + col] = hv; }
        if (pub) publish_wt(pub, lane); }
}
__device__ __forceinline__ void ffn_chunk(LAS unsigned char* lds, unsigned char* ws, unsigned char* wl, const float* ffn_g, int chunk, int wid, int lane, unsigned* pub = nullptr) {
    const GAS float* HM = (const GAS float*)(ws + WS_MINI + MN_HM); GAS float* AM = (GAS float*)(ws + WS_MINI + MN_ACT);
    const int f0 = 32 * chunk, row0 = 256 * (f0 >> 7) + (f0 & 127);
    const GAS bf16* const Bt[4] = {(const GAS bf16*)(wl + WO_GU) + (size_t)row0 * D, (const GAS bf16*)(wl + WO_GU) + (size_t)(row0 + 128) * D,
                                   (const GAS bf16*)(wl + WO_GU) + (size_t)(row0 + 16) * D, (const GAS bf16*)(wl + WO_GU) + (size_t)(row0 + 144) * D}; f32x4 o[4];
    chunk_wg<4, true>(lds, HM, D, nullptr, Bt, D, D, wid, lane, o); (void)ffn_g;
    if (wid == 0) {
#pragma unroll
        for (int hh = 0; hh < 2; ++hh) { const int col = f0 + 16 * hh + (lane & 15);
#pragma unroll
            for (int reg = 0; reg < 4; ++reg) { const int r = 4 * (lane >> 4) + reg; const float g = o[2 * hh][reg]; st4_wt(ws_rsrc(ws), WS_MINI + MN_ACT + ((size_t)r * FF + col) * 4, __float_as_uint(g / (1.0f + __expf(-g)) * o[2 * hh + 1][reg])); } }
        if (pub) publish_wt(pub, lane); }
}
__device__ __forceinline__ void head_task(LAS unsigned char* lds, unsigned char* ws, unsigned char* wl, const float* qa, const float* kva, const float* qn, const float* kn, int h, bool need_q, int wid, int lane) {
    const GAS float* ZM = (const GAS float*)(ws + WS_MINI + MN_ZM); const GAS float* rope = (const GAS float*)(ws + WS_ROPE);
    LAS float* QT = (LAS float*)lds; LAS float* KVT = QT + 16 * 96; LAS float* KR = KVT + 16 * 128; LAS float* ST = KR + 16 * 32; LAS float* S = ST + 64;
    const int tid = wid * 64 + lane, r = lane & 15, q = lane >> 4;
    if (need_q && wid < 6) {
        const int e0 = 16 * wid, drow = e0 < 64 ? 256 * (h >> 2) + 128 * (e0 >> 5) + 32 * (h & 3) + (e0 & 31) : 512 + 128 * (h >> 2) + 32 * (h & 3) + (e0 - 64);
        const GAS bf16* const Bt[1] = {(const GAS bf16*)(wl + WO_Q) + (size_t)drow * QLR}; f32x4 acc[1] = {(f32x4){0.f, 0.f, 0.f, 0.f}}; float ssq = 0.f;
        acc_steps<1, 6>(ZM + POOLW, INW, qa, Bt, QLR, QLR, 0, 1, lane, acc, ssq);
        ssq += __shfl_xor(ssq, 16); ssq += __shfl_xor(ssq, 32); const float rs = rsqrtf(ssq / (float)QLR + EPS);
#pragma unroll
        for (int reg = 0; reg < 4; ++reg) QT[(4 * q + reg) * 96 + e0 + r] = acc[0][reg] * __shfl(rs, 4 * q + reg);
    }
    {
        const int e0 = 16 * wid, drow = e0 < 64 ? 256 * (h >> 2) + 128 * (e0 >> 5) + 32 * (h & 3) + (e0 & 31) : 512 + 256 * (h >> 2) + 128 * ((e0 - 64) >> 5) + 32 * (h & 3) + ((e0 - 64) & 31);
        const GAS bf16* const Bt[1] = {(const GAS bf16*)(wl + WO_KV) + (size_t)drow * KVLR}; f32x4 acc[1] = {(f32x4){0.f, 0.f, 0.f, 0.f}}; float ssq = 0.f;
        acc_steps<1, 8>(ZM + POOLW + QLR, INW, kva, Bt, KVLR, KVLR, 0, 1, lane, acc, ssq);
        ssq += __shfl_xor(ssq, 16); ssq += __shfl_xor(ssq, 32); const float rs = rsqrtf(ssq / (float)KVLR + EPS);
#pragma unroll
        for (int reg = 0; reg < 4; ++reg) KVT[(4 * q + reg) * 128 + e0 + r] = acc[0][reg] * __shfl(rs, 4 * q + reg);
    }
    {
        const int rr = tid >> 5, e = tid & 31; KR[rr * 32 + e] = ZM[(size_t)rr * INW + POOLW + QLR + KVLR + e]; }
    __syncthreads();
    if (tid < 256) { const int rr = tid >> 4, sub = tid & 15; float s0 = 0.f, s1 = 0.f, s2 = 0.f, s3 = 0.f;
#pragma unroll
        for (int i = 0; i < 4; ++i) { const float a = QT[rr * 96 + sub + 16 * i], b = KVT[rr * 128 + sub + 16 * i]; s0 += a * a; s2 += b * b; }
#pragma unroll
        for (int i = 0; i < 2; ++i) { const float a = QT[rr * 96 + 64 + sub + 16 * i], b = KR[rr * 32 + sub + 16 * i]; s1 += a * a; s3 += b * b; }
#pragma unroll
        for (int o = 1; o < 16; o <<= 1) { s0 += __shfl_xor(s0, o); s1 += __shfl_xor(s1, o); s2 += __shfl_xor(s2, o); s3 += __shfl_xor(s3, o); }
        if (sub == 0) { ST[rr * 4 + 0] = rsqrtf(s0 / 64.f + EPS); ST[rr * 4 + 1] = rsqrtf(s1 / 32.f + EPS); ST[rr * 4 + 2] = rsqrtf(s2 / 64.f + EPS); ST[rr * 4 + 3] = rsqrtf(s3 / 32.f + EPS); } }
    __syncthreads();
    float qv[3], kvv[3];
    { const int rr = tid >> 5, e = tid & 31; const GAS float* t = rope + (size_t)rr * 32;
      qv[0] = QT[rr * 96 + e] * ST[rr * 4 + 0] * qn[e] * QSCALE; qv[1] = QT[rr * 96 + 32 + e] * ST[rr * 4 + 0] * qn[32 + e] * QSCALE;
      kvv[0] = KVT[rr * 128 + e] * ST[rr * 4 + 2] * kn[e]; kvv[1] = KVT[rr * 128 + 32 + e] * ST[rr * 4 + 2] * kn[32 + e];
      const int j = e & 15; const float c = t[j], sn = t[16 + j];
      const float q1 = QT[rr * 96 + 64 + j] * ST[rr * 4 + 1] * qn[64 + j], q2 = QT[rr * 96 + 80 + j] * ST[rr * 4 + 1] * qn[80 + j];
      const float k1 = KR[rr * 32 + j] * ST[rr * 4 + 3] * kn[64 + j], k2 = KR[rr * 32 + 16 + j] * ST[rr * 4 + 3] * kn[80 + j];
      qv[2] = (e < 16 ? q1 * c - q2 * sn : q1 * sn + q2 * c) * QSCALE; kvv[2] = e < 16 ? k1 * c - k2 * sn : k1 * sn + k2 * c; }
    __syncthreads();
    { const int rr = tid >> 5, e = tid & 31;
#pragma unroll
      for (int i = 0; i < 3; ++i) { QT[rr * 96 + 32 * i + e] = qv[i]; if (i < 2) KVT[rr * 128 + 32 * i + e] = kvv[i]; else KR[rr * 32 + e] = kvv[2]; } }
    __syncthreads();
    if (tid < 320) {
        const bool isk = tid < 192; const int u_ = isk ? tid : tid - 192, rr = isk ? u_ / 12 : u_ >> 3, ch = isk ? u_ % 12 : u_ & 7;
        const LAS float* src = isk ? (ch < 8 ? KVT + rr * 128 + 8 * ch : KR + rr * 32 + 8 * (ch - 8)) : KVT + rr * 128 + 64 + 8 * ch;
        v4u w; w.x = pk2(src[0], src[1]); w.y = pk2(src[2], src[3]); w.z = pk2(src[4], src[5]); w.w = pk2(src[6], src[7]);
#pragma unroll
        for (int b = 0; b < BATCH; ++b) { if (isk) *(GAS v4u*)(ws + WS_K + kcell(b, h, rr, ch)) = w; else *(GAS v4u*)(ws + WS_V + ((size_t)(b * L + rr) * VP + h * VD + 8 * ch) * 2) = w; } }
    if (need_q) {
        if (tid < 256) { const int rr = tid >> 4, j = tid & 15; float sc = 0.f;
            for (int e = 0; e < 64; ++e) sc += QT[rr * 96 + e] * KVT[j * 128 + e];
            for (int e = 0; e < 32; ++e) sc += QT[rr * 96 + 64 + e] * KR[j * 32 + e];
            S[rr * 16 + j] = j <= rr ? sc : -INFINITY; }
        __syncthreads();
        float pj = 0.f;
        if (tid < 256) { const int rr = tid >> 4, j = tid & 15; float m = -INFINITY; for (int jj = 0; jj < 16; ++jj) m = fmaxf(m, S[rr * 16 + jj]);
            float l = 0.f; for (int jj = 0; jj < 16; ++jj) l += exp2f(S[rr * 16 + jj] - m);
            pj = exp2f(S[rr * 16 + j] - m) / l; }
        __syncthreads();
        if (tid < 256) S[tid] = pj;
        __syncthreads();
        { GAS float* YM = (GAS float*)(ws + WS_MINI + MN_YM);
#pragma unroll
          for (int i = 0; i < 2; ++i) { const int idx = tid + 512 * i, rr = idx >> 6, d = idx & 63; float o = 0.f;
              for (int j = 0; j < 16; ++j) o += S[rr * 16 + j] * KVT[j * 128 + 64 + d];
              YM[(size_t)rr * D + POOLW + h * VD + d] = o; } }
    }
    __syncthreads();
}
__device__ __forceinline__ void pool_task(LAS unsigned char* lds, unsigned char* ws, unsigned char* wl, const float* pscale, int wid, int lane) {
    const GAS float* ZM = (const GAS float*)(ws + WS_MINI + MN_ZM); GAS float* YM = (GAS float*)(ws + WS_MINI + MN_YM);
    LAS float* PM = (LAS float*)lds; LAS float* UM = PM + 16 * 516; const int tid = wid * 64 + lane;
    { f32x4 t[4];
#pragma unroll
      for (int i = 0; i < 4; ++i) { const int idx = tid + 512 * i, rr = idx >> 7, c4 = (idx & 127) * 4; t[i] = *(const GAS f32x4*)(ZM + (size_t)rr * INW + c4); }
#pragma unroll
      for (int i = 0; i < 4; ++i) { const int idx = tid + 512 * i, rr = idx >> 7, c4 = (idx & 127) * 4; *(LAS f32x4*)(UM + rr * 516 + c4) = t[i]; } }
    __syncthreads();
    for (int idx = tid; idx < 16 * POOLW; idx += NWAVES * 64) { const int rr = idx >> 9, c = idx & 511, w = 2 << (c >> 7), cnt = rr + 1 < w ? rr + 1 : w; float s2 = 0.f;
        for (int i = 0; i < cnt; ++i) s2 += UM[(rr - i) * 516 + c];
        PM[rr * 516 + c] = s2 / (float)cnt - UM[rr * 516 + c]; }
    __syncthreads();
    const int r = lane & 15, q = lane >> 4;
    for (int ch = wid; ch < 32; ch += NWAVES) { const int g = ch >> 3, n0 = 16 * (ch & 7);
        f32x4 acc = {0.f, 0.f, 0.f, 0.f};
#pragma unroll
        for (int s_ = 0; s_ < 4; ++s_) { const int k = 32 * s_ + 8 * q; const LAS float* pa = PM + r * 516 + 128 * g + k;
            const f32x4 a0 = *(const LAS f32x4*)pa, a1 = *(const LAS f32x4*)(pa + 4);
            const bf16x8 bfr = *(const GAS bf16x8*)((const GAS bf16*)(wl + WO_P) + (size_t)(g * 128 + n0 + r) * 128 + k);
            acc = __builtin_amdgcn_mfma_f32_16x16x32_bf16(pack8(a0, a1), bfr, acc, 0, 0, 0); }
        const int col = 128 * g + n0 + r; const float sc = pscale[col];
#pragma unroll
        for (int reg = 0; reg < 4; ++reg) YM[(size_t)(4 * q + reg) * D + col] = acc[reg] * sc; }
    __syncthreads();
}
}

struct Args { P p; int ph_lo, ph_hi, li, pad; };
__global__ void __launch_bounds__(NWAVES * 64, 2) mega_fwd(const Args args) {
    extern __shared__ __attribute__((aligned(16))) unsigned char lds[];
    Frame F{nullptr, nullptr, nullptr, 0, 0, 0, args.p};
    F.lds = (LAS unsigned char*)lds; F.MISC = (volatile LAS unsigned*)(F.lds + MISC_OFF);
    F.wave = __builtin_amdgcn_readfirstlane((int)threadIdx.x >> 6);
    F.G = gridDim.x; { const int bx = blockIdx.x; F.vcu = (F.G % 8 == 0) ? (bx % 8) * (F.G / 8) + bx / 8 : bx; }
    F.ctl = (gu32*)(args.p.ws + WS_CTL);
    const P& p = F.p;
    for (int u = (int)threadIdx.x; u < (LDS_BYTES - LDSCTL_OFF) / 4; u += NWAVES * 64) ((LAS unsigned*)(F.lds + LDSCTL_OFF))[u] = 0u;
    __syncthreads();
    XcdBarrier bar = xcd_barrier_post((unsigned*)(F.ctl + CW_BAR) + args.li * XCD_BAR_WORDS, F.MISC + 8);
    const int lo = args.ph_lo, hi = args.ph_hi;
#define IN(k) (lo <= (k) && (k) < hi)
#define STAMP(k) do { if (MK_PROBE >= 0 && blockIdx.x == 0 && threadIdx.x == 0) F.MISC[16 + (k)] = (unsigned)__builtin_amdgcn_s_memrealtime(); } while (0)
#define SEAM(k) do { if ((IN(k) && IN((k) + 1)) || ((MK_PROBE >= 0 || MK_PA >= 0) && (k) == NPHASE - 1)) xcd_barrier(bar); STAMP((k) + 1); } while (0)
#define GSEAM(k, n, ...) do { if (IN(k) && IN((k) + 1)) { const int gb_ = (int)blockIdx.x; if (F.G != 256) xcd_barrier(bar); else group_seam((unsigned*)(F.ctl + CW_GRP) + 64 * (8 * (gb_ & 7) + ((gb_ >> 3) & 7)), 4u * (unsigned)(n), bar.bar, ##__VA_ARGS__); } STAMP((k) + 1); } while (0)
    STAMP(0);
#define PST(id) do { if (MK_PA >= 0 && l == 0) { __syncthreads(); if ((int)blockIdx.x == MK_PBLK && threadIdx.x == 0) F.MISC[40 + (id)] = (unsigned)__builtin_amdgcn_s_memrealtime(); } } while (0)
    if (IN(0)) { p0_prologue(F); SEAM(0); }
#define PHASE_LOCALS unsigned char* ws = p.ws; int wv = F.wave, vcu = F.vcu, bid = (int)blockIdx.x, li = l; \
    asm volatile("" : "+s"(ws), "+s"(wv), "+s"(vcu), "+s"(bid), "+s"(li)); unsigned char* const wl = ws + WS_W + (size_t)li * WL_BYTES; (void)wl; (void)vcu; (void)bid; (void)wv
#pragma unroll 1
    for (int l = 0; l < DEPTH; ++l) {
        const int pb = 1 + 6 * l;
        if (IN(pb)) {
            PHASE_LOCALS;
            pg8::Gemm g{(const bf16*)(ws + WS_XN), D, 0, (const bf16*)(wl + WO_IN), D}; pg8::StaticOrder S; S.init(64, 5, F.G, bid);
            unsigned* const zflag = (unsigned*)(ws + WS_CTL) + CW_ZF + 64 * 128 * li;
            pg8::EpiZ E{(bf16*)(ws + WS_Z), (float*)(ws + WS_SSQZ), (const float*)(ws + WS_SSQH), p.qa_g + (size_t)li * QLR, p.kva_g + (size_t)li * KVLR, ws, zflag};
            unsigned* const zm_cnt = (unsigned*)(ws + WS_CTL) + CW_ZM + 64 * li;
            if (MK_MINI && bid >= 128 && bid < 128 + INW / 16) mini::p1_chunk(F.lds + RING_OFF, ws, wl, zm_cnt, bid - 128, wv, fresh_lane_id());
            pg8::gemm_phase<pg8::EpiZ, pg8::StaticOrder, PG8_ALIGN, PG8_SP2>(F.lds + RING_OFF, g, S, E, wv);
            if (MK_MINI && bid >= 210 && bid < 219) {
                mini::wait_zm(zm_cnt, INW / 16);
                if (bid < 218) mini::head_task(F.lds + RING_OFF, ws, wl, p.qa_g + (size_t)li * QLR, p.kva_g + (size_t)li * KVLR, p.qn_g + (size_t)li * QKD, p.kn_g + (size_t)li * QKD, bid - 210, li + 1 < DEPTH, wv, fresh_lane_id());
                else if (li + 1 < DEPTH) mini::pool_task(F.lds + RING_OFF, ws, wl, p.pool_scale + (size_t)li * POOLW, wv, fresh_lane_id());
            } else if (bid >= 64) {
                const int rank = bid < 128 ? bid - 64 : bid >= 219 ? 72 + bid - 219 : bid >= 202 ? 64 + bid - 202 : 109 + bid - 128;
                for (int ui = rank; ui < 256; ui += 183) { if (ui >= 183 && rank >= 73) break; const int pm = ui >> 2, g = ui & 3, pn = g >> 1;
                    if (pm & 15) wait_ztiles(zflag + 64 * (2 * pm + pn), zflag + 64 * (2 * (pm - 1) + pn), 8u, 8u); else wait_ztiles(zflag + 64 * (2 * pm + pn), zm_cnt, 8u, (unsigned)(INW / 16));
                    pool_unit(F.lds + RING_OFF, ws, wl, p.pool_scale + (size_t)li * POOLW, wv, pm, g); }
                if (rank >= 73) conv_range(p, (LAS float*)(F.lds + RING_OFF + wv * 16384), li == 0 ? CV0 : CV2, li == 0 ? CV1 : CV3, (rank - 73) * NWAVES + wv, 110 * NWAVES, fresh_lane_id()); }
            GSEAM(pb, 3 * l + 1);
        }
        if (IN(pb + 1)) {
            PHASE_LOCALS;
            PST(0);
            if (bid >= 192) { const int t_ = wv * 64 + fresh_lane_id(), pm_ = 8 * (bid & 7) + ((bid >> 3) & 7);
                for (int j = t_; j < 1024; j += NWAVES * 64) krope_item(ws, p.kn_g + (size_t)li * QKD + NOPE, pm_ * 1024 + j); }
            PST(1); PST(2);
            { pg8::Gemm gq{(const bf16*)(ws + WS_Z) + POOLW, ZP, 0, (const bf16*)(wl + WO_Q), QLR}, gkv{(const bf16*)(ws + WS_Z) + POOLW + QLR, ZP, 0, (const bf16*)(wl + WO_KV), KVLR};
              pg8::StaticOrder Sq, Skv; Sq.init(64, 3, F.G, bid); Skv.init(64, 4, F.G, bid);
              LAS float* rqt = nullptr; LAS float* rkt = nullptr;
              if (F.G == 256) {
                  rqt = (LAS float*)(F.lds + RST_OFF); rkt = rqt + 256; const int t_ = wv * 64 + fresh_lane_id();
                  if (t_ < 256) { const GAS pg8::f32x4* sq = (const GAS pg8::f32x4*)(ws + WS_SSQZ + ((size_t)(rowbase(8 * (bid & 7) + ((bid >> 3) & 7)) + t_) * SZ + 16) * 4);
                      const pg8::f32x4 a_ = sq[0] + sq[1] + sq[2], b_ = sq[3] + sq[4];
                      rqt[t_] = __builtin_amdgcn_rsqf(((a_[0] + a_[1]) + (a_[2] + a_[3])) * (1.0f / QLR) + EPS); rkt[t_] = __builtin_amdgcn_rsqf(((b_[0] + b_[1]) + (b_[2] + b_[3])) * (1.0f / KVLR) + EPS); }
                  LDS_WAIT(); }
              pg8::EpiQ Eq{(bf16*)(ws + WS_Q), (const float*)(ws + WS_SSQZ), p.qn_g + (size_t)li * QKD, (const float*)(ws + WS_ROPE), rqt};
              pg8::EpiKV Ekv{(bf16*)(ws + WS_K), (bf16*)(ws + WS_V), (const float*)(ws + WS_SSQZ), p.kn_g + (size_t)li * QKD, rkt};
              pg8::gemm_phase2(F.lds + RING_OFF, gq, gkv, Sq, Skv, Eq, Ekv, wv); }
            PST(3);
            PST(4);
            if (li == 0 && bid < 128) conv_range(p, (LAS float*)(F.lds + RING_OFF + wv * 16384), CV1, CV1 + 128 * NWAVES, bid * NWAVES + wv, 128 * NWAVES, fresh_lane_id());
            if (bid >= 192) conv_range(p, (LAS float*)(F.lds + RING_OFF + wv * 16384), li == 0 ? CV1 + 128 * NWAVES : CV3, li == 0 ? CV1B : CV4, (bid - 192) * NWAVES + wv, (F.G - 192) * NWAVES, fresh_lane_id());
            PST(5);
            SEAM(pb + 1);
            PST(6);
        }
        if (IN(pb + 2)) {
            PHASE_LOCALS;
            const int bh = vcu >> 3, sq = vcu & 7;
#pragma unroll 1
            for (int i = 0; i < 2; ++i)
                attn::attn_unit<8>(bh >> 3, bh & 7, i == 0 ? 15 - sq : sq, (const bf16*)(ws + WS_Q), (const bf16*)(ws + WS_K), (const bf16*)(ws + WS_V), (bf16*)(ws + WS_Y), (char*)lds + RING_OFF, wv);
            if (F.G != 256) SEAM(pb + 2);
            else if (IN(pb + 2) && IN(pb + 3)) {
                asm volatile("s_waitcnt vmcnt(0)" ::: "memory"); __syncthreads();
                if (threadIdx.x == 0) { unsigned* yp = (unsigned*)(F.ctl + CW_YP) + 64 * 16 * (bh >> 3);
                    __hip_atomic_fetch_add((GAS unsigned*)(yp + 64 * (15 - sq)), 1u, RLX_AGENT); __hip_atomic_fetch_add((GAS unsigned*)(yp + 64 * sq), 1u, RLX_AGENT);
                    __hip_atomic_fetch_add((GAS unsigned*)((unsigned*)(F.ctl + CW_P3D)), 1u, RLX_AGENT); }
                STAMP(pb + 3);
            }
        }
        if (IN(pb + 3)) {
            PHASE_LOCALS;
            PST(7);
            pg8::Gemm g{(const bf16*)(ws + WS_Y), YP, 0, (const bf16*)(wl + WO_OUT), D}; pg8::StaticOrder S; S.init(64, 4, F.G, bid);
            if (F.G == 256 && IN(pb + 2)) wait_count((unsigned*)(F.ctl + CW_YP) + 64 * (8 * (bid & 7) + ((bid >> 3) & 7)), 8u * (unsigned)(li + 1), bar.bar);
            pg8::EpiResT<true> E{(bf16*)(ws + WS_XN), (float*)(ws + WS_SSQH), nullptr};
            pg8::gemm_phase<pg8::EpiResT<true>, pg8::StaticOrder, false, PG8_SP2>(F.lds + RING_OFF, g, S, E, wv);
            PST(8);
            PST(9);
            GSEAM(pb + 3, 3 * l + 2, IN(pb + 2) ? (unsigned*)(F.ctl + CW_P3D) : nullptr, 256u * (unsigned)(l + 1));
            PST(10);
        }
        if (IN(pb + 4)) {
            PHASE_LOCALS;
            unsigned* const m4 = (unsigned*)(ws + WS_CTL) + CW_M4; unsigned* const m5 = (unsigned*)(ws + WS_CTL) + CW_M5;
            if (MK_MINI && li + 1 < DEPTH && bid >= 216) for (int c = bid - 216; c < 64; c += 40) mini::res_chunk<4>(F.lds + RING_OFF, ws, (const GAS float*)(ws + WS_MINI + MN_YM), D, (const GAS bf16*)(wl + WO_OUT), c, wv, fresh_lane_id(), m4);
            pg8::Gemm g{(const bf16*)(ws + WS_XN), D, 0, (const bf16*)(wl + WO_GU), D}; pg8::StaticOrder S; S.init(64, 22, F.G, bid, li == 0 ? 0 : 128);
            LAS float* rst = nullptr;
            if (F.G == 256) {
                rst = (LAS float*)(F.lds + RST_OFF); const int t_ = wv * 64 + fresh_lane_id();
                if (t_ < 256) { const pg8::f32x4 sq = *(const GAS pg8::f32x4*)(ws + WS_SSQH + (size_t)(rowbase(8 * (bid & 7) + ((bid >> 3) & 7)) + t_) * 16); rst[t_] = rsqrtf(((sq[0] + sq[1]) + (sq[2] + sq[3])) * (1.0f / D) + EPS); }
                LDS_WAIT(); }
            pg8::EpiSwiGLU E{(bf16*)(ws + WS_ACT), (const float*)(ws + WS_SSQH), rst};
            pg8::gemm_phase<pg8::EpiSwiGLU, pg8::StaticOrder, PG8_ALIGN, PG8_SP2, true>(F.lds + RING_OFF, g, S, E, wv);
            if (li + 1 < DEPTH && bid >= 128) {
                if (MK_MINI) { mini::wait_zm(m4, 64u);
                    if (bid < 128 + FF / 32) mini::ffn_chunk(F.lds + RING_OFF, ws, wl, p.ffn_g + (size_t)li * D, bid - 128, wv, fresh_lane_id(), m5); }
                if (bid < 192) { if (MK_MINI) { mini::wait_zm(m5, (unsigned)(FF / 32)); mini::res_chunk<6>(F.lds + RING_OFF, ws, (const GAS float*)(ws + WS_MINI + MN_ACT), FF, (const GAS bf16*)(wl + WO_D), bid - 128, wv, fresh_lane_id()); } }
                else conv_range(p, (LAS float*)(F.lds + RING_OFF + wv * 16384), CV1B, CV2, (bid - 192) * NWAVES + wv, (F.G - 192) * NWAVES, fresh_lane_id());
            }
            GSEAM(pb + 4, 3 * l + 3);
        }
        if (IN(pb + 5)) {
            PHASE_LOCALS;
            pg8::Gemm g{(const bf16*)(ws + WS_ACT), FF, 0, (const bf16*)(wl + WO_D), FF}; pg8::StaticOrder S; S.init(64, 4, F.G, bid);
            pg8::EpiResT<true> E{(bf16*)(ws + WS_XN), (float*)(ws + WS_SSQH), li + 1 < DEPTH ? nullptr : p.out};
            pg8::gemm_phase<pg8::EpiResT<true>, pg8::StaticOrder, false, PG8_SP2>(F.lds + RING_OFF, g, S, E, wv);
            SEAM(pb + 5);
        }
    }
    if (MK_PA >= 0 && (int)blockIdx.x == MK_PBLK && threadIdx.x == 0) p.out[0] += (float)(F.MISC[40 + MK_PA] - F.MISC[40 + MK_PB]) * 0.01f;
    if (MK_PROBE >= 0 && blockIdx.x == 0 && threadIdx.x == 0) { const unsigned t1 = MK_PROBE == 100 ? F.MISC[16 + NPHASE] : F.MISC[16 + MK_PROBE + 1], t0 = MK_PROBE == 100 ? F.MISC[16] : F.MISC[16 + MK_PROBE];
        p.out[0] += (float)(t1 - t0) * 0.01f; }
#undef IN
#undef SEAM
#undef GSEAM
}

extern "C" void kernel_launch(void* const* d_in, const int* in_sizes, int n_in, void* d_out, int out_size, void* d_ws, size_t ws_size, hipStream_t stream) {
    static int grid = 0;
    if (grid == 0) {
        if (n_in != 17 || in_sizes[0] != MR * D || out_size != MR * D || ws_size < WS_END) { fprintf(stderr, "kernel_launch: unexpected shapes (n_in %d, ws %zu)\n", n_in, ws_size); grid = -1; return; }
        int dev = 0, cus = 0;
        if (hipGetDevice(&dev) != hipSuccess || hipDeviceGetAttribute(&cus, hipDeviceAttributeMultiprocessorCount, dev) != hipSuccess) { grid = -1; return; }
        if (hipFuncSetAttribute((const void*)mega_fwd, hipFuncAttributeMaxDynamicSharedMemorySize, LDS_BYTES) != hipSuccess) { fprintf(stderr, "kernel_launch: hipFuncSetAttribute failed\n"); grid = -1; return; }
        (void)hipGetLastError();
        grid = cus;
        if (grid != 256) fprintf(stderr, "kernel_launch: %d CUs (built for 256)\n", grid);
    }
    if (grid < 0) return;
    P p{}; const float** f = &p.x; for (int i = 0; i < 17; ++i) f[i] = (const float*)d_in[i];
    p.out = (float*)d_out; p.ws = (unsigned char*)d_ws;
    (void)hipMemsetAsync((char*)d_ws + WS_CTL, 0, CTL_ZERO_BYTES, stream);
    Args a{}; a.p = p;
    int nl = 0;
    auto mega = [&](int lo, int hi) { a.ph_lo = lo; a.ph_hi = hi; a.li = nl++; hipLaunchKernelGGL(mega_fwd, dim3(grid), dim3(NWAVES * 64), LDS_BYTES, stream, a); };
    mega(0, NPHASE);

}
```
